# Optimizing an MI355X kernel written in HIP

```python
import math
import jax, jax.numpy as jnp
from jax import lax
import numpy as np

D_MODEL = 1024
BATCH = 4
SEQ = 4096
DEPTH = 2

GRID_W = 64
GLA_HEADS = 4
GLA_DK = 64
GLA_DV = 128
GLA_RANK = 16
GLA_TAU = 16.0
GLA_CHUNK = 64
NA_HEADS = 8
NA_DH = 64
WIN_H = 8
WIN_W = 16
Q_BLOCK_W = 16
K_BLOCK_W = 32
N_EXPERTS = 32
N_GROUPS = 4
EXPERTS_PER_GROUP = N_EXPERTS // N_GROUPS
TOP_K = 2
D_EXPERT = 512
MOE_BLOCK = 128
GLA_QK_W = GLA_HEADS * GLA_DK
GLA_V_W = GLA_HEADS * GLA_DV
NA_W = NA_HEADS * NA_DH
MIX_W = GLA_V_W + NA_W
IN_W = 2 * GLA_QK_W + 2 * GLA_V_W + 2 * GLA_RANK + 3 * NA_W
EPS = 1e-6
NEG = -1e30

kernel_name = "hybrid_gla_natten_grouped_moe_encoder"


def _split_points():
    widths = [GLA_QK_W, GLA_QK_W, GLA_V_W, GLA_V_W, GLA_RANK, GLA_RANK, NA_W, NA_W, NA_W]
    pts, acc = [], 0
    for w in widths[:-1]:
        acc += w
        pts.append(acc)
    return pts


def rms_norm(x, g):
    xf = x.astype(jnp.float32)
    y = xf * lax.rsqrt(jnp.mean(xf * xf, axis=-1, keepdims=True) + EPS)
    return (y * g.astype(jnp.float32)).astype(x.dtype)


def _heads(t, n):
    b, s, _ = t.shape
    return t.reshape(b, s, n, -1).transpose(0, 2, 1, 3)


def gla_scan(q, k, v, log_a, strict):
    B, H, T, dk = q.shape
    dv = v.shape[-1]
    C = GLA_CHUNK
    nc = T // C

    def chunks(t):
        return jnp.moveaxis(t.reshape(B, H, nc, C, t.shape[-1]), 2, 0)

    qc, kc, vc, ac = chunks(q), chunks(k), chunks(v), chunks(log_a)
    bc = jnp.cumsum(ac, axis=-2)
    mask = jnp.tril(jnp.ones((C, C), dtype=bool), -1 if strict else 0)

    def step(S, inp):
        q_, k_, v_, b_ = inp
        diff = b_[:, :, :, None, :] - b_[:, :, None, :, :]
        decay = jnp.exp(jnp.where(mask[:, :, None], diff, -jnp.inf))
        scores = jnp.sum(q_[:, :, :, None, :] * k_[:, :, None, :, :] * decay, axis=-1)
        o = (jnp.einsum('bhij,bhje->bhie', scores, v_)
             + jnp.einsum('bhid,bhde->bhie', q_ * jnp.exp(b_), S))
        b_last = b_[:, :, -1:, :]
        S_new = (jnp.exp(b_last[:, :, 0, :])[..., None] * S
                 + jnp.einsum('bhjd,bhje->bhde', k_ * jnp.exp(b_last - b_), v_))
        return S_new, o

    S0 = jnp.zeros((B, H, dk, dv), jnp.float32)
    _, o = lax.scan(step, S0, (qc, kc, vc, bc))
    return jnp.moveaxis(o, 0, 2).reshape(B, H, T, dv)


def _na_indices(rows):
    kh = min(WIN_H, rows)
    r = np.arange(rows)
    row_start = np.clip(r - kh // 2, 0, rows - kh)
    key_rows = row_start[:, None] + np.arange(kh)
    n_cb = GRID_W // Q_BLOCK_W
    q_cols = np.arange(n_cb)[:, None] * Q_BLOCK_W + np.arange(Q_BLOCK_W)
    col_start = np.clip(q_cols - WIN_W // 2, 0, GRID_W - WIN_W)
    blk_start = np.clip(np.arange(n_cb) * Q_BLOCK_W - WIN_W // 2, 0, GRID_W - K_BLOCK_W)
    key_cols = blk_start[:, None] + np.arange(K_BLOCK_W)
    col_ok = ((key_cols[:, None, :] >= col_start[:, :, None])
              & (key_cols[:, None, :] < col_start[:, :, None] + WIN_W))
    L = kh * K_BLOCK_W
    tok = (key_rows[:, None, :, None] * GRID_W + key_cols[None, :, None, :]).reshape(rows, n_cb, L)
    mask = np.broadcast_to(col_ok[:, :, None, :], (n_cb, Q_BLOCK_W, kh, K_BLOCK_W)).reshape(n_cb, Q_BLOCK_W, L)
    rel_r = key_rows - r[:, None] + WIN_H - 1
    rel_c = np.clip(key_cols[:, None, :] - q_cols[:, :, None] + WIN_W - 1, 0, 2 * WIN_W - 2)
    full = (rows, n_cb, Q_BLOCK_W, kh, K_BLOCK_W)
    ri = np.broadcast_to(rel_r[:, None, None, :, None], full).reshape(rows, n_cb, Q_BLOCK_W, L)
    ci = np.broadcast_to(rel_c[None, :, :, None, :], full).reshape(rows, n_cb, Q_BLOCK_W, L)
    return tok, mask, ri, ci


def neighborhood_attention(q, k, v, rpb):
    B, H, T, dh = q.shape
    rows = T // GRID_W
    tok, mask, ri, ci = _na_indices(rows)
    n_cb = GRID_W // Q_BLOCK_W
    qb = q.reshape(B, H, rows, n_cb, Q_BLOCK_W, dh)
    kg = k[:, :, tok]
    vg = v[:, :, tok]
    s = jnp.einsum('bhrnqd,bhrnkd->bhrnqk', qb, kg).astype(jnp.float32) * (dh ** -0.5)
    bias = rpb.astype(jnp.float32)[:, ri, ci]
    s = jnp.where(mask[None, None, None], s + bias[None], NEG)
    p = jax.nn.softmax(s, axis=-1)
    o = jnp.einsum('bhrnqk,bhrnkd->bhrnqd', p.astype(v.dtype), vg)
    return o.reshape(B, H, T, dh)


def mixer(h, w_in, gate_w, gate_b, gla_norm, q_norm, k_norm, rpb, w_out):
    B, T, _ = h.shape
    f32 = jnp.float32
    proj = h @ w_in
    qg, kg, vg, gg, lf, lb, qn, kn, vn = jnp.split(proj, _split_points(), axis=-1)
    q = _heads(qg, GLA_HEADS).astype(f32) * (GLA_DK ** -0.5)
    k = _heads(kg, GLA_HEADS).astype(f32)
    v = _heads(vg, GLA_HEADS).astype(f32)
    la_f = _heads(jax.nn.log_sigmoid((lf @ gate_w[0] + gate_b[0]).astype(f32)) / GLA_TAU, GLA_HEADS)
    la_b = _heads(jax.nn.log_sigmoid((lb @ gate_w[1] + gate_b[1]).astype(f32)) / GLA_TAU, GLA_HEADS)
    o_f = gla_scan(q, k, v, la_f, False)
    flip = lambda t: jnp.flip(t, axis=2)
    o_b = flip(gla_scan(flip(q), flip(k), flip(v), flip(la_b), True))
    o_gla = rms_norm(o_f + o_b, gla_norm)
    o_gla = o_gla.transpose(0, 2, 1, 3).reshape(B, T, GLA_V_W) * jax.nn.silu(gg.astype(f32))
    qh = rms_norm(_heads(qn, NA_HEADS), q_norm)
    kh = rms_norm(_heads(kn, NA_HEADS), k_norm)
    vh = _heads(vn, NA_HEADS)
    o_na = neighborhood_attention(qh, kh, vh, rpb).transpose(0, 2, 1, 3).reshape(B, T, NA_W)
    cat = jnp.concatenate([o_gla.astype(h.dtype), o_na.astype(h.dtype)], axis=-1)
    return cat @ w_out


def grouped_moe(h, router_w, router_b, w1, w3, w2):
    N, D = h.shape
    f32 = jnp.float32
    scores = jax.nn.sigmoid(h.astype(f32) @ router_w.astype(f32))
    sel = scores + router_b.astype(f32)
    grp = sel.reshape(N, N_GROUPS, EXPERTS_PER_GROUP)
    group_score = lax.top_k(grp, TOP_K)[0].sum(-1)
    best = jnp.argmax(group_score, axis=-1)
    in_grp = jnp.take_along_axis(grp, best[:, None, None], axis=1)[:, 0]
    _, local = lax.top_k(in_grp, TOP_K)
    eidx = best[:, None] * EXPERTS_PER_GROUP + local
    gw = jnp.take_along_axis(scores, eidx, axis=1)
    gw = gw / jnp.sum(gw, axis=-1, keepdims=True)
    M = N * TOP_K
    flat_e = eidx.reshape(-1)
    flat_tok = jnp.repeat(jnp.arange(N, dtype=jnp.int32), TOP_K)
    order = jnp.argsort(flat_e)
    sorted_e = flat_e[order]
    sorted_tok = flat_tok[order]
    sorted_w = gw.reshape(-1)[order]
    counts = jnp.bincount(flat_e, length=N_EXPERTS)
    padded = (counts + MOE_BLOCK - 1) // MOE_BLOCK * MOE_BLOCK
    pad_end = jnp.cumsum(padded)
    pad_start = pad_end - padded
    start = jnp.cumsum(counts) - counts
    dest = pad_start[sorted_e] + (jnp.arange(M) - start[sorted_e])
    P = (-(-M // MOE_BLOCK) + N_EXPERTS) * MOE_BLOCK
    NB = P // MOE_BLOCK
    buf_tok = jnp.full((P,), N, jnp.int32).at[dest].set(sorted_tok)
    h_pad = jnp.concatenate([h, jnp.zeros((1, D), h.dtype)], axis=0)
    xb = h_pad[buf_tok].reshape(NB, MOE_BLOCK, D)
    blk_e = jnp.minimum(jnp.searchsorted(pad_end, jnp.arange(NB) * MOE_BLOCK, side='right'), N_EXPERTS - 1)

    def expert_block(args):
        xblk, e = args
        return (jax.nn.silu(xblk @ w1[e]) * (xblk @ w3[e])) @ w2[e]

    y = lax.map(expert_block, (xb, blk_e)).reshape(P, D)
    y_assign = y[dest].astype(f32) * sorted_w[:, None]
    out = jax.ops.segment_sum(y_assign, sorted_tok, num_segments=N)
    return out.astype(h.dtype)


def setup_inputs(seed: int = 0) -> dict:
    key = jax.random.key(seed)
    ks = jax.random.split(key, 20)
    nrm = lambda k, s: jax.random.normal(k, s, jnp.float32)
    D = D_MODEL
    return {
        "x": nrm(ks[0], (BATCH, SEQ, D)),
        "c": nrm(ks[1], (BATCH, D)),
        "w_ada": nrm(ks[2], (DEPTH, D, 6 * D)) * (0.5 * D ** -0.5),
        "b_ada": nrm(ks[3], (DEPTH, 6 * D)) * 0.02,
        "attn_norm": 1.0 + 0.05 * nrm(ks[4], (DEPTH, D)),
        "ffn_norm": 1.0 + 0.05 * nrm(ks[5], (DEPTH, D)),
        "w_in": nrm(ks[6], (DEPTH, D, IN_W)) * D ** -0.5,
        "gla_gate_w": nrm(ks[7], (DEPTH, 2, GLA_RANK, GLA_QK_W)) * GLA_RANK ** -0.5,
        "gla_gate_b": 0.1 * nrm(ks[8], (DEPTH, 2, GLA_QK_W)),
        "gla_out_norm": 1.0 + 0.05 * nrm(ks[9], (DEPTH, GLA_DV)),
        "na_q_norm": 1.0 + 0.05 * nrm(ks[10], (DEPTH, NA_DH)),
        "na_k_norm": 1.0 + 0.05 * nrm(ks[11], (DEPTH, NA_DH)),
        "na_rpb": 0.02 * nrm(ks[12], (DEPTH, NA_HEADS, 2 * WIN_H - 1, 2 * WIN_W - 1)),
        "w_out": nrm(ks[13], (DEPTH, MIX_W, D)) * MIX_W ** -0.5,
        "router_w": nrm(ks[14], (D, N_EXPERTS)) * D ** -0.5,
        "router_b": 0.01 * nrm(ks[15], (N_EXPERTS,)),
        "w1": nrm(ks[16], (DEPTH, N_EXPERTS, D, D_EXPERT)) * D ** -0.5,
        "w3": nrm(ks[17], (DEPTH, N_EXPERTS, D, D_EXPERT)) * D ** -0.5,
        "w2": nrm(ks[18], (DEPTH, N_EXPERTS, D_EXPERT, D)) * D_EXPERT ** -0.5,
    }


def reference(x, c, w_ada, b_ada, attn_norm, ffn_norm, w_in, gla_gate_w, gla_gate_b,
              gla_out_norm, na_q_norm, na_k_norm, na_rpb, w_out, router_w, router_b,
              w1, w3, w2):
    B, T, D = x.shape
    c_act = jax.nn.silu(c)
    for l in range(DEPTH):
        mod = c_act @ w_ada[l] + b_ada[l]
        sh1, sc1, g1, sh2, sc2, g2 = jnp.split(mod, 6, axis=-1)
        h = rms_norm(x, attn_norm[l]) * (1.0 + sc1[:, None]) + sh1[:, None]
        x = x + g1[:, None] * mixer(h, w_in[l], gla_gate_w[l], gla_gate_b[l], gla_out_norm[l],
                                    na_q_norm[l], na_k_norm[l], na_rpb[l], w_out[l])
        h = rms_norm(x, ffn_norm[l]) * (1.0 + sc2[:, None]) + sh2[:, None]
        y = grouped_moe(h.reshape(B * T, D), router_w, router_b, w1[l], w3[l], w2[l])
        x = x + g2[:, None] * y.reshape(B, T, D)
    return x
```

```cpp
#include <hip/hip_runtime.h>
#include <cstdio>
#include <cstdint>

#ifndef MK_PER_PHASE
#define MK_PER_PHASE 0
#endif

#define LAS __attribute__((address_space(3)))
#define GAS __attribute__((address_space(1)))
typedef unsigned short bf16;
typedef short bf16x8 __attribute__((ext_vector_type(8)));
typedef float f32x4 __attribute__((ext_vector_type(4)));
typedef float f32x2 __attribute__((ext_vector_type(2)));
typedef unsigned u32x4 __attribute__((ext_vector_type(4)));
typedef unsigned u32x2 __attribute__((ext_vector_type(2)));
typedef GAS unsigned gu32;

constexpr int NB = 4, T = 4096, D = 1024, NTOK = NB * T, DEPTH = 2, INW = 3104, NPROJ = 3072, MODW = 6144;
constexpr int NE = 32, DE = 512, LCAP = 16384;
constexpr float EPS = 1e-6f;
constexpr int NPHASES = 20;

constexpr size_t MiB = 1u << 20;
constexpr size_t WS_CTL = 0, CTL_ZERO_BYTES = 1 * MiB;
constexpr size_t WS_MOD = 1 * MiB;
constexpr size_t WS_LFB = 2 * MiB;
constexpr size_t WS_TOKINFO = 4 * MiB;
constexpr size_t WS_GDEC = 4 * MiB + 512 * 1024;
constexpr size_t WS_LISTS = 5 * MiB;
constexpr size_t WS_WIN = 8 * MiB;
constexpr size_t WS_WOUT = 20 * MiB;
constexpr size_t WS_W13 = 24 * MiB;
constexpr size_t WS_W2 = 152 * MiB;
constexpr size_t WS_XN = 216 * MiB;
constexpr size_t WS_X = 248 * MiB;
constexpr size_t WS_QG = 312 * MiB, WS_KG = 320 * MiB, WS_VG = 328 * MiB, WS_GG = 344 * MiB, WS_QN = 360 * MiB, WS_KN = 376 * MiB, WS_VN = 392 * MiB;
constexpr size_t WS_U = 408 * MiB;
constexpr size_t WS_H = 312 * MiB;
constexpr size_t WS_Y = 352 * MiB;
constexpr size_t WS_END = 472 * MiB;
constexpr int CW_BAR = 4096, CW_CNT = 16384;

constexpr int SCR_BYTES = 139264;
constexpr int LDSCTL_OFF = SCR_BYTES, MISC_OFF = LDSCTL_OFF + 320, TAB_OFF = LDSCTL_OFF + 1024;
constexpr int LDS_BYTES = 147456;

#define RLX_AGENT __ATOMIC_RELAXED, __HIP_MEMORY_SCOPE_AGENT
__device__ __forceinline__ unsigned f2bf(float f) { unsigned u = __builtin_bit_cast(unsigned, f); return (u + 0x7fffu + ((u >> 16) & 1u)) >> 16; }
__device__ __forceinline__ unsigned pk2(float lo, float hi) { return f2bf(lo) | (f2bf(hi) << 16); }
__device__ __forceinline__ float bf_lo(unsigned w) { return __builtin_bit_cast(float, w << 16); }
__device__ __forceinline__ float bf_hi(unsigned w) { return __builtin_bit_cast(float, w & 0xffff0000u); }
__device__ __forceinline__ float bf2f(bf16 b) { return __builtin_bit_cast(float, (unsigned)b << 16); }
__device__ __forceinline__ unsigned cvt_pk_bf16(float lo, float hi) { unsigned r; asm volatile("v_cvt_pk_bf16_f32 %0, %1, %2" : "=v"(r) : "v"(lo), "v"(hi)); return r; }
__device__ __forceinline__ float wave_sum(float v) {
#pragma unroll
    for (int o = 1; o < 64; o <<= 1) v += __shfl_xor(v, o);
    return v;
}
__device__ __forceinline__ float sigmoidf_(float x) { return 1.0f / (1.0f + __expf(-x)); }
__device__ __forceinline__ float logsigf_(float z) { return fminf(z, 0.f) - log1pf(expf(-fabsf(z))); }

struct Ctx {
    LAS unsigned char* lds;
    int tid, lane, wave, vcu, G, bx;
    const float *x_in, *c, *w_ada, *b_ada, *attn_norm, *ffn_norm, *w_in, *gate_w, *gate_b, *gla_norm, *q_norm, *k_norm, *rpb, *w_out, *router_w, *router_b, *w1, *w3, *w2;
    float* out;
    gu32* ctl;
    float *mod, *lfb, *gdec, *X, *U;
    unsigned* tokinfo; int* lists;
    bf16 *win_t, *wout_t, *w13_t, *w2_t, *XN, *QG, *KG, *VG, *GG, *QN, *KN, *VN, *H, *Y;
};

struct Args { const float* in[19]; float* out; unsigned char* ws; int ph_lo, ph_hi; };
struct Base { LAS unsigned char* lds; int tid, lane, wave, vcu, G; };
typedef __attribute__((address_space(4))) const Args CArgs;
__device__ __forceinline__ CArgs* kargs() { CArgs* p = (CArgs*)__builtin_amdgcn_kernarg_segment_ptr(); asm volatile("" : "+s"(p)); return p; }
__device__ __forceinline__ Ctx make_ctx(const Base& B) {
    CArgs* A = kargs(); Ctx F;
    { int t = B.tid; asm volatile("" : "+v"(t)); F.tid = t; F.lane = t & 63; F.wave = __builtin_amdgcn_readfirstlane(t >> 6); }
    { int v = B.vcu, g = B.G; asm volatile("" : "+s"(v), "+s"(g)); F.vcu = v; F.G = g; int bx = (int)blockIdx.x; asm volatile("" : "+s"(bx)); F.bx = bx; }
    { LAS unsigned char* lp = B.lds; asm volatile("" : "+s"(lp)); F.lds = lp; }
    F.x_in = A->in[0]; F.c = A->in[1]; F.w_ada = A->in[2]; F.b_ada = A->in[3]; F.attn_norm = A->in[4]; F.ffn_norm = A->in[5]; F.w_in = A->in[6];
    F.gate_w = A->in[7]; F.gate_b = A->in[8]; F.gla_norm = A->in[9]; F.q_norm = A->in[10]; F.k_norm = A->in[11]; F.rpb = A->in[12]; F.w_out = A->in[13];
    F.router_w = A->in[14]; F.router_b = A->in[15]; F.w1 = A->in[16]; F.w3 = A->in[17]; F.w2 = A->in[18];
    F.out = A->out;
    unsigned char* ws = A->ws;
    F.ctl = (gu32*)(ws + WS_CTL);
    F.mod = (float*)(ws + WS_MOD); F.lfb = (float*)(ws + WS_LFB); F.gdec = (float*)(ws + WS_GDEC); F.X = (float*)(ws + WS_X); F.U = (float*)(ws + WS_U);
    F.tokinfo = (unsigned*)(ws + WS_TOKINFO); F.lists = (int*)(ws + WS_LISTS);
    F.win_t = (bf16*)(ws + WS_WIN); F.wout_t = (bf16*)(ws + WS_WOUT); F.w13_t = (bf16*)(ws + WS_W13); F.w2_t = (bf16*)(ws + WS_W2);
    F.XN = (bf16*)(ws + WS_XN); F.QG = (bf16*)(ws + WS_QG); F.KG = (bf16*)(ws + WS_KG); F.VG = (bf16*)(ws + WS_VG); F.GG = (bf16*)(ws + WS_GG);
    F.QN = (bf16*)(ws + WS_QN); F.KN = (bf16*)(ws + WS_KN); F.VN = (bf16*)(ws + WS_VN); F.H = (bf16*)(ws + WS_H); F.Y = (bf16*)(ws + WS_Y);
    return F;
}

namespace pg8 {
constexpr int BM = 256, BK = 64, HALF = 128, HTB = HALF * BK * 2, STAGE_BYTES = 8 * HTB;
__host__ __device__ __forceinline__ int lds_byte(int r, int c) { const int st = (r >> 4) * 2 + (c >> 5), rr = r & 15, cc = c & 31, ob = rr * 64 + cc * 2; return st * 1024 + (ob ^ (((ob >> 9) & 1) << 5)); }
__host__ __device__ __forceinline__ void stage_rc(int b, int& R, int& C) { const int st = b / 1024, sb = b % 1024, swz = sb ^ (((sb >> 9) & 1) << 5); R = (st >> 1) * 16 + swz / 64; C = (st & 1) * 32 + (swz % 64) / 2; }
__host__ __device__ __forceinline__ int perm32(int rho) { const int n = rho >> 4, i = rho & 15; return 8 * (i >> 2) + 4 * n + (i & 3); }

struct Unit { int rowbase, pn, e, posbase, cnt; };

template <class Epi, class Sched>
__device__ __forceinline__ void gemm_phase(LAS unsigned char* lds, const int K, const Sched& S, const Epi& E, const int tid) {
    const int wid = __builtin_amdgcn_readfirstlane(tid >> 6), lane = tid & 63, wr = wid >> 2, wc = wid & 3, fr = lane & 15, fq = lane >> 4;
    const int nt = K / BK;
    int R0, C0, R1, C1; stage_rc(tid * 16, R0, C0); stage_rc(tid * 16 + 8192, R1, C1);
    const int Rb0 = Epi::PERM ? ((R0 & ~31) + perm32(R0 & 31)) : R0, Rb1 = Epi::PERM ? ((R1 & ~31) + perm32(R1 & 31)) : R1;
    const unsigned vb0 = (unsigned)(Rb0 * K + C0) * 2u, vb1 = (unsigned)(Rb1 * K + C1) * 2u;
    const size_t kstep = (size_t)(BK * 2);
    const size_t hstepB = (size_t)HALF * K * 2;
    const unsigned ldsw = (unsigned)wid * 1024u;
    const int aoff = lds_byte(wr * 64 + fr, fq * 8), boff = lds_byte(wc * 32 + fr, fq * 8);
#define PG8_SA(b, h) (((b) * 2 + (h)) * HTB)
#define PG8_SB(b, h) ((4 + (b) * 2 + (h)) * HTB)
#define PG8_STAGE2(bufoff, gbase, o0, o1) do { \
        __builtin_amdgcn_global_load_lds((const unsigned*)((const char*)(gbase) + (o0)), (LAS unsigned*)(lds + (bufoff) + ldsw), 16, 0, 0); \
        __builtin_amdgcn_global_load_lds((const unsigned*)((const char*)(gbase) + (o1)), (LAS unsigned*)(lds + (bufoff) + ldsw + 8192), 16, 0, 0); } while (0)
#define PG8_LDA(dst, b, h) do { _Pragma("unroll") for (int m = 0; m < 4; ++m) _Pragma("unroll") for (int k = 0; k < 2; ++k) dst[m][k] = *(const LAS bf16x8*)(lds + PG8_SA(b, h) + aoff + m * 2048 + k * 1024); } while (0)
#define PG8_LDB(dst, b, h) do { _Pragma("unroll") for (int n = 0; n < 2; ++n) _Pragma("unroll") for (int k = 0; k < 2; ++k) dst[n][k] = *(const LAS bf16x8*)(lds + PG8_SB(b, h) + boff + n * 2048 + k * 1024); } while (0)
#define PG8_MMA(ai, bj, At, Bt) do { __builtin_amdgcn_s_setprio(1); _Pragma("unroll") for (int m = 0; m < 4; ++m) _Pragma("unroll") for (int n = 0; n < 2; ++n) _Pragma("unroll") for (int k = 0; k < 2; ++k) \
        acc[ai][bj][m][n] = __builtin_amdgcn_mfma_f32_16x16x32_bf16(Bt[n][k], At[m][k], acc[ai][bj][m][n], 0, 0, 0); __builtin_amdgcn_s_setprio(0); } while (0)
#define PG8_WAIT_V(n) asm volatile("s_waitcnt vmcnt(" #n ")" ::: "memory")
#define PG8_WAIT_L(n) asm volatile("s_waitcnt lgkmcnt(" #n ")" ::: "memory")
#define PG8_BAR __builtin_amdgcn_s_barrier()
#define PG8_SCHED __builtin_amdgcn_sched_barrier(0)
    Unit cur, nxt; int ui = 0;
    if (!S.next(0, cur)) return;
    f32x4 acc[2][2][4][2];
#pragma unroll
    for (int a = 0; a < 2; ++a)
#pragma unroll
        for (int b = 0; b < 2; ++b)
#pragma unroll
            for (int m = 0; m < 4; ++m)
#pragma unroll
                for (int n = 0; n < 2; ++n) acc[a][b][m][n] = (f32x4){0.f, 0.f, 0.f, 0.f};
    bf16x8 At[4][2], B0[2][2], B1[2][2];
    const char* cA = S.Abase(cur); const char* cB = S.Bbase(cur);
    unsigned ca0 = S.aoff(cur, 0, R0, C0), ca1 = S.aoff(cur, 0, R1, C1), ca2 = S.aoff(cur, 1, R0, C0), ca3 = S.aoff(cur, 1, R1, C1);
    PG8_STAGE2(PG8_SB(0, 0), cB, vb0, vb1); PG8_STAGE2(PG8_SB(0, 1), cB + hstepB, vb0, vb1); PG8_STAGE2(PG8_SA(0, 0), cA, ca0, ca1); PG8_STAGE2(PG8_SA(0, 1), cA, ca2, ca3);
    if (wr == 1) PG8_BAR;
    PG8_WAIT_V(2); PG8_BAR;
    PG8_STAGE2(PG8_SB(1, 0), cB + kstep, vb0, vb1); PG8_STAGE2(PG8_SA(1, 0), cA + kstep, ca0, ca1); PG8_STAGE2(PG8_SB(1, 1), cB + hstepB + kstep, vb0, vb1);
    PG8_WAIT_V(6); PG8_BAR;
    for (;;) {
        const bool has_next = S.next(ui + 1, nxt);
        const char* nA = has_next ? S.Abase(nxt) : cA; const char* nB = has_next ? S.Bbase(nxt) : cB;
        unsigned na0 = ca0, na1 = ca1, na2 = ca2, na3 = ca3;
        if (has_next) { na0 = S.aoff(nxt, 0, R0, C0); na1 = S.aoff(nxt, 0, R1, C1); na2 = S.aoff(nxt, 1, R0, C0); na3 = S.aoff(nxt, 1, R1, C1); }
        for (int t = 0; t < nt; t += 2) {
            const bool last = (t == nt - 2);
            const char* a1 = cA + (size_t)(t + 1) * kstep;
            const char* a2 = last ? nA : cA + (size_t)(t + 2) * kstep; const char* b2 = last ? nB : cB + (size_t)(t + 2) * kstep;
            const char* a3 = a2 + kstep; const char* b3 = b2 + kstep;
            const unsigned s0 = last ? na0 : ca0, s1 = last ? na1 : ca1, s2 = last ? na2 : ca2, s3 = last ? na3 : ca3;
            PG8_LDB(B0, 0, 0); PG8_LDB(B1, 0, 1); PG8_SCHED; PG8_LDA(At, 0, 0); PG8_STAGE2(PG8_SA(1, 1), a1, ca2, ca3);
            PG8_WAIT_V(8); PG8_WAIT_L(0); PG8_BAR; PG8_MMA(0, 0, At, B0); PG8_MMA(0, 1, At, B1); PG8_BAR; PG8_SCHED;
            PG8_LDA(At, 0, 1); PG8_STAGE2(PG8_SB(0, 0), b2, vb0, vb1); PG8_STAGE2(PG8_SB(0, 1), b2 + hstepB, vb0, vb1); PG8_STAGE2(PG8_SA(0, 0), a2, s0, s1);
            PG8_WAIT_V(8); PG8_WAIT_L(0); PG8_BAR; PG8_MMA(1, 0, At, B0); PG8_MMA(1, 1, At, B1); PG8_BAR; PG8_SCHED;
            PG8_LDB(B0, 1, 0); PG8_LDB(B1, 1, 1); PG8_SCHED; PG8_LDA(At, 1, 0); PG8_STAGE2(PG8_SA(0, 1), a2, s2, s3);
            PG8_WAIT_V(8); PG8_WAIT_L(0); PG8_BAR; PG8_MMA(0, 0, At, B0); PG8_MMA(0, 1, At, B1); PG8_BAR; PG8_SCHED;
            PG8_LDA(At, 1, 1); PG8_STAGE2(PG8_SB(1, 0), b3, vb0, vb1); PG8_STAGE2(PG8_SB(1, 1), b3 + hstepB, vb0, vb1); PG8_STAGE2(PG8_SA(1, 0), a3, s0, s1);
            PG8_WAIT_V(8); PG8_WAIT_L(0); PG8_BAR; PG8_MMA(1, 0, At, B0); PG8_MMA(1, 1, At, B1); PG8_BAR; PG8_SCHED;
        }
        if (wr == 0) PG8_BAR;
        E(acc, cur, wr, wc, fr, fq);
        if (!has_next) break;
#pragma unroll
        for (int a = 0; a < 2; ++a)
#pragma unroll
            for (int b = 0; b < 2; ++b)
#pragma unroll
                for (int m = 0; m < 4; ++m)
#pragma unroll
                    for (int n = 0; n < 2; ++n) acc[a][b][m][n] = (f32x4){0.f, 0.f, 0.f, 0.f};
        cur = nxt; cA = nA; cB = nB; ca0 = na0; ca1 = na1; ca2 = na2; ca3 = na3; ++ui;
        if (wr == 1) PG8_BAR;
    }
    PG8_WAIT_V(0);
    PG8_BAR;
#undef PG8_SA
#undef PG8_SB
#undef PG8_STAGE2
#undef PG8_LDA
#undef PG8_LDB
#undef PG8_MMA
#undef PG8_WAIT_V
#undef PG8_WAIT_L
#undef PG8_BAR
#undef PG8_SCHED
}

struct DenseSched {
    const char* A; const char* Bt; int K, nM, nN, nwg, G, c;
    __device__ __forceinline__ void init(const void* A_, const void* Bt_, int M, int N, int K_, int G_, int c_) { A = (const char*)A_; Bt = (const char*)Bt_; K = K_; nM = M / BM; nN = N / BM; nwg = nM * nN; G = G_; c = c_; }
    __device__ __forceinline__ bool next(int i, Unit& u) const {
        const long L = (long)i * G + c; if (L >= nwg) return false;
        int wgid = (int)L; { const int q = nwg / 8, r = nwg % 8, xcd = wgid % 8, off = wgid / 8; wgid = (xcd < r ? xcd * (q + 1) : r * (q + 1) + (xcd - r) * q) + off; }
        const int nig = 8 * nN, gid = wgid / nig, fm = gid * 8, gsz = (nM - fm) < 8 ? (nM - fm) : 8;
        const int pm = fm + ((wgid % nig) % gsz); u.pn = (wgid % nig) / gsz; u.rowbase = pm * BM; u.e = 0; u.posbase = 0; u.cnt = 0; return true;
    }
    __device__ __forceinline__ const char* Abase(const Unit& u) const { return A + (size_t)u.rowbase * K * 2; }
    __device__ __forceinline__ const char* Bbase(const Unit& u) const { return Bt + (size_t)u.pn * BM * K * 2; }
    __device__ __forceinline__ unsigned aoff(const Unit&, int half, int R, int C) const { return (unsigned)((half * HALF + R) * K + C) * 2u; }
};
template <bool GATHER>
struct MoeSched {
    const char* A; const char* Bt; int K; const int* lists; const LAS int* TS; const LAS int* CN; int G, c;
    __device__ __forceinline__ bool next(int i, Unit& u) const {
        const int L = i * G + c; const int TT = __builtin_amdgcn_readfirstlane(TS[32]);
        if (L >= TT * 4) return false;
        const int mt = L >> 2; int e = 0;
        while (e < 31 && __builtin_amdgcn_readfirstlane(TS[e + 1]) <= mt) ++e;
        u.e = e; u.rowbase = mt * BM; u.pn = L & 3; u.posbase = (mt - __builtin_amdgcn_readfirstlane(TS[e])) * BM; u.cnt = __builtin_amdgcn_readfirstlane(CN[e]); return true;
    }
    __device__ __forceinline__ const char* Abase(const Unit& u) const { return GATHER ? A : A + (size_t)u.rowbase * K * 2; }
    __device__ __forceinline__ const char* Bbase(const Unit& u) const { return Bt + ((size_t)u.e * 1024 + (size_t)u.pn * BM) * K * 2; }
    __device__ __forceinline__ unsigned aoff(const Unit& u, int half, int R, int C) const {
        if (GATHER) { const int pos = u.posbase + half * HALF + R; const int tok = pos < u.cnt ? lists[u.e * LCAP + pos] : 0; return (unsigned)(tok * K + C) * 2u; }
        return (unsigned)((half * HALF + R) * K + C) * 2u;
    }
};
}

typedef f32x4 AccT[2][2][4][2];
struct EpiInProj {
    static constexpr bool PERM = true;
    bf16 *QG, *KG, *VG, *GG, *QN, *KN, *VN; const float *qnw, *knw;
    __device__ __forceinline__ void operator()(const AccT& acc, const pg8::Unit& u, int wr, int wc, int fr, int fq) const {
        const int pn = u.pn; const int row0 = u.rowbase + wr * 64 + fr;
        if (pn >= 6 && pn < 10) {
            const bool isq = pn < 8; bf16* O = isq ? QN : KN; const float* nw = isq ? qnw : knw; const float sc = isq ? 0.125f : 1.0f;
            f32x4 w[2][2];
#pragma unroll
            for (int bj = 0; bj < 2; ++bj)
#pragma unroll
                for (int n = 0; n < 2; ++n) w[bj][n] = *(const f32x4*)(nw + 32 * bj + 8 * fq + 4 * n) * sc;
#pragma unroll
            for (int ai = 0; ai < 2; ++ai)
#pragma unroll
                for (int m = 0; m < 4; ++m) {
                    float ss = 0.f;
#pragma unroll
                    for (int bj = 0; bj < 2; ++bj)
#pragma unroll
                        for (int n = 0; n < 2; ++n) { const f32x4 v = acc[ai][bj][m][n]; ss += (v[0] * v[0] + v[1] * v[1]) + (v[2] * v[2] + v[3] * v[3]); }
                    ss += __shfl_xor(ss, 16); ss += __shfl_xor(ss, 32);
                    const float rstd = 1.0f / sqrtf(ss * (1.0f / 64.0f) + EPS);
                    bf16* rowp = O + (size_t)(row0 + ai * 128 + m * 16) * 512 + ((pn & 1) * 4 + wc) * 64 + 8 * fq;
#pragma unroll
                    for (int bj = 0; bj < 2; ++bj) { const f32x4 v0 = acc[ai][bj][m][0] * rstd * w[bj][0], v1 = acc[ai][bj][m][1] * rstd * w[bj][1];
                        u32x4 o; o.x = cvt_pk_bf16(v0[0], v0[1]); o.y = cvt_pk_bf16(v0[2], v0[3]); o.z = cvt_pk_bf16(v1[0], v1[1]); o.w = cvt_pk_bf16(v1[2], v1[3]);
                        *(u32x4*)(rowp + bj * 32) = o; }
                }
        } else {
            bf16* O; int ldc, colt; float sc = 1.0f;
            if (pn == 0) { O = QG; ldc = 256; colt = 0; sc = 0.125f; }
            else if (pn == 1) { O = KG; ldc = 256; colt = 0; }
            else if (pn < 4) { O = VG; ldc = 512; colt = (pn - 2) * 256; }
            else if (pn < 6) { O = GG; ldc = 512; colt = (pn - 4) * 256; }
            else { O = VN; ldc = 512; colt = (pn - 10) * 256; }
            const int col0 = colt + wc * 32 + 8 * fq;
#pragma unroll
            for (int ai = 0; ai < 2; ++ai)
#pragma unroll
                for (int m = 0; m < 4; ++m) { bf16* rowp = O + (size_t)(row0 + ai * 128 + m * 16) * ldc + col0;
#pragma unroll
                    for (int bj = 0; bj < 2; ++bj) { const f32x4 v0 = acc[ai][bj][m][0] * sc, v1 = acc[ai][bj][m][1] * sc;
                        u32x4 o; o.x = cvt_pk_bf16(v0[0], v0[1]); o.y = cvt_pk_bf16(v0[2], v0[3]); o.z = cvt_pk_bf16(v1[0], v1[1]); o.w = cvt_pk_bf16(v1[2], v1[3]);
                        *(u32x4*)(rowp + bj * 128) = o; } }
        }
    }
};
struct EpiResid {
    static constexpr bool PERM = false;
    const float* base; float* X; const float* g1;
    __device__ __forceinline__ void operator()(const AccT& acc, const pg8::Unit& u, int wr, int wc, int fr, int fq) const {
        const int row0 = u.rowbase + wr * 64 + fr, col0 = u.pn * 256 + wc * 32 + 4 * fq; const int b = u.rowbase >> 12;
        f32x4 g[2][2];
#pragma unroll
        for (int bj = 0; bj < 2; ++bj)
#pragma unroll
            for (int n = 0; n < 2; ++n) g[bj][n] = *(const f32x4*)(g1 + (size_t)b * MODW + col0 + bj * 128 + n * 16);
#pragma unroll
        for (int ai = 0; ai < 2; ++ai)
#pragma unroll
            for (int m = 0; m < 4; ++m) { const size_t off = (size_t)(row0 + ai * 128 + m * 16) * D + col0;
#pragma unroll
                for (int bj = 0; bj < 2; ++bj)
#pragma unroll
                    for (int n = 0; n < 2; ++n) { const f32x4 bs = *(const f32x4*)(base + off + bj * 128 + n * 16);
                        *(f32x4*)(X + off + bj * 128 + n * 16) = bs + g[bj][n] * acc[ai][bj][m][n]; } }
    }
};
struct EpiSwiGLU {
    static constexpr bool PERM = true;
    bf16* H;
    __device__ __forceinline__ void operator()(const AccT& acc, const pg8::Unit& u, int wr, int wc, int fr, int fq) const {
        const int row0 = u.rowbase + wr * 64 + fr, col0 = u.pn * 128 + wc * 32 + 8 * fq;
#pragma unroll
        for (int ai = 0; ai < 2; ++ai)
#pragma unroll
            for (int m = 0; m < 4; ++m) { bf16* rowp = H + (size_t)(row0 + ai * 128 + m * 16) * DE + col0;
                float r[8];
#pragma unroll
                for (int n = 0; n < 2; ++n)
#pragma unroll
                    for (int i = 0; i < 4; ++i) { const float a = acc[ai][0][m][n][i], b = acc[ai][1][m][n][i]; r[n * 4 + i] = a * sigmoidf_(a) * b; }
                u32x4 o; o.x = cvt_pk_bf16(r[0], r[1]); o.y = cvt_pk_bf16(r[2], r[3]); o.z = cvt_pk_bf16(r[4], r[5]); o.w = cvt_pk_bf16(r[6], r[7]);
                *(u32x4*)rowp = o; }
    }
};
struct EpiY {
    static constexpr bool PERM = true;
    bf16* Y;
    __device__ __forceinline__ void operator()(const AccT& acc, const pg8::Unit& u, int wr, int wc, int fr, int fq) const {
        const int row0 = u.rowbase + wr * 64 + fr, col0 = u.pn * 256 + wc * 32 + 8 * fq;
#pragma unroll
        for (int ai = 0; ai < 2; ++ai)
#pragma unroll
            for (int m = 0; m < 4; ++m) { bf16* rowp = Y + (size_t)(row0 + ai * 128 + m * 16) * D + col0;
#pragma unroll
                for (int bj = 0; bj < 2; ++bj) { const f32x4 v0 = acc[ai][bj][m][0], v1 = acc[ai][bj][m][1];
                    u32x4 o; o.x = cvt_pk_bf16(v0[0], v0[1]); o.y = cvt_pk_bf16(v0[2], v0[3]); o.z = cvt_pk_bf16(v1[0], v1[1]); o.w = cvt_pk_bf16(v1[2], v1[3]);
                    *(u32x4*)(rowp + bj * 128) = o; } }
    }
};

#define XB_TMO      128
#define XB_XCNT(j)  (256  + 64 * (j))
#define XB_XSUB(j)  (1280 + 64 * (j))
#define XB_XGEN(j)  (2304 + 64 * (j))
#define XB_TOP      3328
#define XB_TOPGEN   3392
#define XCD_BAR_WORDS 3456
#define XB_SPIN_CAP (1u << 18)
__device__ __forceinline__ unsigned xb_ld(unsigned* p)              { return __hip_atomic_load(p, __ATOMIC_RELAXED, __HIP_MEMORY_SCOPE_AGENT); }
__device__ __forceinline__ unsigned xb_add(unsigned* p, unsigned v) { return __hip_atomic_fetch_add(p, v, __ATOMIC_RELAXED, __HIP_MEMORY_SCOPE_AGENT); }
__device__ __forceinline__ unsigned xb_xcc_id() { return (unsigned)__builtin_amdgcn_s_getreg((3 << 11) | 20) & 0xFu; }
#define XB_SPIN(cond, bar) do { unsigned _sp = 0; while (cond) { __builtin_amdgcn_s_sleep(1); \
    if ((++_sp & 255u) == 0u) { if (xb_ld(&(bar)[XB_TMO])) break; if (_sp > XB_SPIN_CAP) { atomicAdd(&(bar)[XB_TMO], 1u); break; } } } } while (0)
struct XcdBarrier { unsigned* bar; unsigned x; volatile LAS unsigned* st; };
__device__ __forceinline__ XcdBarrier xcd_barrier_post(unsigned* bar, volatile LAS unsigned* st) {
    XcdBarrier b; b.bar = bar; b.x = xb_xcc_id(); b.st = st;
    if (threadIdx.x == 0) (void)xb_add(&bar[XB_XCNT(b.x)], 1u);
    return b;
}
__device__ __forceinline__ void xcd_barrier_complete(unsigned* bar, unsigned x, unsigned& nloc, unsigned& nx) {
    const unsigned G = gridDim.x * gridDim.y * gridDim.z;
    unsigned sum, cnt, mine, sp = 0u;
    for (;;) {
        sum = 0u; cnt = 0u; mine = 0u;
#pragma unroll
        for (unsigned j = 0; j < 16; ++j) { const unsigned c = xb_ld(&bar[XB_XCNT(j)]); sum += c; cnt += (c > 0u) ? 1u : 0u; mine = (j == x) ? c : mine; }
        if (sum == G) break;
        __builtin_amdgcn_s_sleep(1);
        if ((++sp & 255u) == 0u) { if (xb_ld(&bar[XB_TMO])) break; if (sp > XB_SPIN_CAP) { atomicAdd(&bar[XB_TMO], 1u); break; } }
    }
    nloc = mine > 0u ? mine : 1u; nx = cnt > 0u ? cnt : 1u;
}
__device__ __forceinline__ void xcd_barrier(const XcdBarrier& b) {
    asm volatile("s_waitcnt vmcnt(0)" ::: "memory");
    __syncthreads();
    if (threadIdx.x == 0) {
        unsigned* bar = b.bar;
        __builtin_amdgcn_s_waitcnt(0);
        unsigned nloc = b.st[0], nx = b.st[1];
        if (nloc == 0u) { xcd_barrier_complete(bar, b.x, nloc, nx); b.st[0] = nloc; b.st[1] = nx; }
        const unsigned old = xb_add(&bar[XB_XSUB(b.x)], 1u);
        const unsigned gen = old / nloc;
        if (old + 1u == (gen + 1u) * nloc) {
            __builtin_amdgcn_fence(__ATOMIC_RELEASE, "agent");
            asm volatile("s_waitcnt vmcnt(0)" ::: "memory");
            const unsigned og = xb_add(&bar[XB_TOP], 1u);
            const unsigned tg = og / nx;
            if (og + 1u == (tg + 1u) * nx) xb_add(&bar[XB_TOPGEN], 1u);
            else XB_SPIN(xb_ld(&bar[XB_TOPGEN]) == tg, bar);
            __builtin_amdgcn_fence(__ATOMIC_ACQUIRE, "agent");
            xb_add(&bar[XB_XGEN(b.x)], 1u);
            asm volatile("s_waitcnt vmcnt(0)" ::: "memory");
        } else {
            XB_SPIN(xb_ld(&bar[XB_XGEN(b.x)]) == gen, bar);
            __builtin_amdgcn_fence(__ATOMIC_ACQUIRE, "agent");
            asm volatile("s_waitcnt vmcnt(0)" ::: "memory");
        }
    }
    __syncthreads();
}

__device__ __forceinline__ void transpose_item(const float* W, int K, int N, bf16* WT, int drow0, int k0, int n0, LAS float* scr, int lane) {
#pragma unroll 8
    for (int i = 0; i < 32; ++i) { const int kk = 2 * i + (lane >> 5); scr[kk * 33 + (lane & 31)] = W[(size_t)(k0 + kk) * N + n0 + (lane & 31)]; }
    asm volatile("s_waitcnt lgkmcnt(0)" ::: "memory");
    const int c = lane & 7;
#pragma unroll
    for (int j = 0; j < 4; ++j) { const int n = (lane >> 3) + 8 * j; const LAS float* s = scr + (8 * c) * 33 + n;
        u32x4 o; o.x = pk2(s[0 * 33], s[1 * 33]); o.y = pk2(s[2 * 33], s[3 * 33]); o.z = pk2(s[4 * 33], s[5 * 33]); o.w = pk2(s[6 * 33], s[7 * 33]);
        *(u32x4*)(WT + (size_t)(drow0 + n) * K + k0 + 8 * c) = o; }
    asm volatile("s_waitcnt lgkmcnt(0)" ::: "memory");
}
__device__ __forceinline__ void phase_p0(const Ctx& F) {
    {
        LAS float* cact = (LAS float*)F.lds;
        LAS float* part = (LAS float*)(F.lds + 16384);
        for (int i = F.tid; i < NB * D; i += 512) { const int b = i >> 10, k = i & 1023; const float cv = F.c[i]; cact[k * 4 + b] = cv * sigmoidf_(cv); }
        __syncthreads();
        for (int item = F.vcu; item < 192; item += F.G) {
            const int l = item / 96, n0 = (item % 96) * 64;
            const float* W = F.w_ada + (size_t)l * D * MODW + n0 + F.lane;
            float a0 = 0.f, a1 = 0.f, a2 = 0.f, a3 = 0.f; const int k0 = F.wave * 128;
#pragma unroll 8
            for (int k = 0; k < 128; ++k) { const float w = W[(size_t)(k0 + k) * MODW]; const f32x4 cv = *(const LAS f32x4*)(cact + (k0 + k) * 4);
                a0 += cv[0] * w; a1 += cv[1] * w; a2 += cv[2] * w; a3 += cv[3] * w; }
            part[(F.wave * 4 + 0) * 64 + F.lane] = a0; part[(F.wave * 4 + 1) * 64 + F.lane] = a1; part[(F.wave * 4 + 2) * 64 + F.lane] = a2; part[(F.wave * 4 + 3) * 64 + F.lane] = a3;
            __syncthreads();
            if (F.tid < 256) { const int b = F.tid >> 6, ln = F.tid & 63; float s = 0.f;
#pragma unroll
                for (int w = 0; w < 8; ++w) s += part[(w * 4 + b) * 64 + ln];
                F.mod[(size_t)(l * 4 + b) * MODW + n0 + ln] = s + F.b_ada[l * MODW + n0 + ln]; }
            __syncthreads();
        }
    }
    {
        LAS float* scr = (LAS float*)(F.lds + 32768 + F.wave * 10240);
        const int gw = F.vcu * 8 + F.wave, NGW = F.G * 8;
        constexpr int I_IN = 2 * 16 * 97, I_OUT = 2 * 16 * 32, I_W1 = 2 * 32 * 256, I_W2 = 2 * 32 * 256;
        constexpr int NITEMS = I_IN + I_OUT + 2 * I_W1 + I_W2;
        for (int it = gw; it < NITEMS; it += NGW) {
            int r = it;
            if (r < I_IN) {
                const int l = r / 1552, q = r % 1552, kb = q / 97, nb = q % 97; if (nb == 48) continue;
                const int n0 = 32 * nb; int drow0;
                if (n0 < 1536) drow0 = n0;
                else { const int np = n0 - 32, t = np >> 8, cl = np & 255;
                    if (t >= 6 && t < 10) { const int hh = cl >> 6, d0 = cl & 63; drow0 = t * 256 + (d0 >> 5) * 128 + hh * 32; } else drow0 = np; }
                transpose_item(F.w_in + (size_t)l * D * INW, D, INW, F.win_t + (size_t)l * NPROJ * D, drow0, kb * 64, n0, scr, F.lane); continue; }
            r -= I_IN;
            if (r < I_OUT) { const int l = r / 512, q = r % 512, kb = q / 32, nb = q % 32;
                transpose_item(F.w_out + (size_t)l * D * D, D, D, F.wout_t + (size_t)l * D * D, 32 * nb, kb * 64, 32 * nb, scr, F.lane); continue; }
            r -= I_OUT;
            if (r < 2 * I_W1) { const int which = r / I_W1; const int q = r % I_W1; const int le = q / 256, qq = q % 256, kb = qq / 16, nb = qq % 16; const int n0 = 32 * nb;
                const float* src = (which ? F.w3 : F.w1) + (size_t)le * D * DE;
                transpose_item(src, D, DE, F.w13_t + (size_t)le * 1024 * D, (n0 >> 7) * 256 + which * 128 + (n0 & 127), kb * 64, n0, scr, F.lane); continue; }
            r -= 2 * I_W1;
            { const int le = r / 256, qq = r % 256, kb = qq / 32, nb = qq % 32;
              transpose_item(F.w2 + (size_t)le * DE * D, DE, D, F.w2_t + (size_t)le * D * DE, 32 * nb, kb * 64, 32 * nb, scr, F.lane); }
        }
    }
}

__device__ __forceinline__ void moe_tables(const Ctx& F, int lp) {
    LAS int* TS = (LAS int*)(F.lds + TAB_OFF); LAS int* CN = TS + 40;
    if (F.tid == 0) { int acc = 0;
        for (int e = 0; e < NE; ++e) { const int c = (int)__hip_atomic_load((unsigned*)(F.ctl + CW_CNT + (lp * 32 + e) * 64), RLX_AGENT); CN[e] = c; TS[e] = acc; acc += (c + 255) >> 8; }
        TS[32] = acc; }
    __syncthreads();
}

template <int MODE>
__device__ __forceinline__ void prepass(const Ctx& F, int l) {
    LAS float* tile = (LAS float*)F.lds;
    LAS float* part = (LAS float*)(F.lds + 65536);
    LAS float* scl = (LAS float*)(F.lds + 98304);
    LAS float* sel = scl + 512;
    const LAS int* TS = (const LAS int*)(F.lds + TAB_OFF);
    const bool comb = (MODE == 2) || (MODE == 0 && l > 0);
    const int lp = (MODE == 2) ? DEPTH - 1 : l - 1;
    if (comb) moe_tables(F, lp);
    const int e = F.tid & 31, kg = F.tid >> 5;
    float rw[64];
    if (MODE != 2) {
        const float* W32 = (MODE == 0) ? F.w_in + (size_t)l * D * INW + 1536 : F.router_w; const int wst = (MODE == 0) ? INW : 32;
#pragma unroll
        for (int i = 0; i < 64; ++i) rw[i] = W32[(size_t)(kg * 64 + i) * wst + e];
    }
    const float* nw = ((MODE == 0) ? F.attn_norm : F.ffn_norm) + l * D;
    for (int grp = F.vcu; grp < NTOK / 16; grp += F.G) {
        for (int tt = 0; tt < 2; ++tt) {
            const int m = grp * 16 + F.wave * 2 + tt; const int b = m >> 12;
            const float* src = (MODE == 0 && l == 0) ? F.x_in : F.X;
            f32x4 v[4];
#pragma unroll
            for (int j = 0; j < 4; ++j) v[j] = *(const f32x4*)(src + (size_t)m * D + 256 * j + 4 * F.lane);
            if (comb) {
                const unsigned* ti = F.tokinfo + (size_t)m * 8;
                const unsigned e0 = ti[0], p0 = ti[1], e1 = ti[2], p1 = ti[3]; const float gw0 = __builtin_bit_cast(float, ti[4]), gw1 = __builtin_bit_cast(float, ti[5]);
                const size_t s0 = (size_t)TS[e0] * 256 + p0, s1 = (size_t)TS[e1] * 256 + p1;
                const float* g2 = F.mod + (size_t)(lp * 4 + b) * MODW + 5 * D;
                float* dst = (MODE == 2) ? F.out : F.X;
#pragma unroll
                for (int j = 0; j < 4; ++j) {
                    const u32x2 y0 = *(const u32x2*)(F.Y + s0 * D + 256 * j + 4 * F.lane), y1 = *(const u32x2*)(F.Y + s1 * D + 256 * j + 4 * F.lane);
                    const f32x4 g = *(const f32x4*)(g2 + 256 * j + 4 * F.lane);
                    v[j][0] += g[0] * (gw0 * bf_lo(y0.x) + gw1 * bf_lo(y1.x)); v[j][1] += g[1] * (gw0 * bf_hi(y0.x) + gw1 * bf_hi(y1.x));
                    v[j][2] += g[2] * (gw0 * bf_lo(y0.y) + gw1 * bf_lo(y1.y)); v[j][3] += g[3] * (gw0 * bf_hi(y0.y) + gw1 * bf_hi(y1.y));
                    *(f32x4*)(dst + (size_t)m * D + 256 * j + 4 * F.lane) = v[j];
                }
            }
            if (MODE != 2) {
                float ss = 0.f;
#pragma unroll
                for (int j = 0; j < 4; ++j) ss += (v[j][0] * v[j][0] + v[j][1] * v[j][1]) + (v[j][2] * v[j][2] + v[j][3] * v[j][3]);
                const float rstd = 1.0f / sqrtf(wave_sum(ss) * (1.0f / D) + EPS);
                const float* scp = F.mod + (size_t)(l * 4 + b) * MODW + ((MODE == 0) ? 1 : 4) * D;
                const float* shp = F.mod + (size_t)(l * 4 + b) * MODW + ((MODE == 0) ? 0 : 3) * D;
#pragma unroll
                for (int j = 0; j < 4; ++j) {
                    const int k = 256 * j + 4 * F.lane;
                    const f32x4 w = *(const f32x4*)(nw + k), sc = *(const f32x4*)(scp + k), sh = *(const f32x4*)(shp + k);
                    f32x4 h;
#pragma unroll
                    for (int i = 0; i < 4; ++i) h[i] = (v[j][i] * rstd) * w[i] * (1.0f + sc[i]) + sh[i];
                    u32x2 o; o.x = pk2(h[0], h[1]); o.y = pk2(h[2], h[3]);
                    *(u32x2*)(F.XN + (size_t)m * D + k) = o;
                    *(LAS f32x4*)(tile + (F.wave * 2 + tt) * 1024 + k) = h;
                }
            }
        }
        if (MODE != 2) {
            __syncthreads();
            for (int tok = 0; tok < 16; ++tok) {
                float p = 0.f;
#pragma unroll
                for (int i4 = 0; i4 < 16; ++i4) { const f32x4 hv = *(const LAS f32x4*)(tile + tok * 1024 + kg * 64 + i4 * 4);
                    p += hv[0] * rw[4 * i4] + hv[1] * rw[4 * i4 + 1] + hv[2] * rw[4 * i4 + 2] + hv[3] * rw[4 * i4 + 3]; }
                part[(tok * 16 + kg) * 32 + e] = p;
            }
            __syncthreads();
            {
                const int tok = F.tid >> 5; const int m = grp * 16 + tok; float logit = 0.f;
#pragma unroll
                for (int g = 0; g < 16; ++g) logit += part[(tok * 16 + g) * 32 + e];
                if (MODE == 0) F.lfb[(size_t)m * 32 + e] = logit;
                else {
                    const float s = 1.0f / (1.0f + expf(-logit));
                    scl[tok * 32 + e] = s; sel[tok * 32 + e] = s + F.router_b[e];
                    __syncthreads();
                    if (e == 0) {
                        const LAS float* sv = sel + tok * 32;
                        float gbest = -3.0e38f; int best = 0;
                        for (int g = 0; g < 4; ++g) { float m1 = -3.0e38f, m2 = -3.0e38f;
                            for (int i = 0; i < 8; ++i) { const float x = sv[g * 8 + i]; if (x > m1) { m2 = m1; m1 = x; } else if (x > m2) m2 = x; }
                            const float gs = m1 + m2; if (gs > gbest) { gbest = gs; best = g; } }
                        int i1 = 0; float v1 = sv[best * 8];
                        for (int i = 1; i < 8; ++i) { const float x = sv[best * 8 + i]; if (x > v1) { v1 = x; i1 = i; } }
                        int i2 = -1; float v2 = -3.0e38f;
                        for (int i = 0; i < 8; ++i) { const float x = sv[best * 8 + i]; if (i != i1 && x > v2) { v2 = x; i2 = i; } }
                        const int e0 = best * 8 + i1, e1 = best * 8 + i2;
                        float gw0 = scl[tok * 32 + e0], gw1 = scl[tok * 32 + e1]; const float gsum = gw0 + gw1; gw0 /= gsum; gw1 /= gsum;
                        const unsigned p0 = __hip_atomic_fetch_add((unsigned*)(F.ctl + CW_CNT + (l * 32 + e0) * 64), 1u, RLX_AGENT);
                        const unsigned p1 = __hip_atomic_fetch_add((unsigned*)(F.ctl + CW_CNT + (l * 32 + e1) * 64), 1u, RLX_AGENT);
                        F.lists[e0 * LCAP + p0] = m; F.lists[e1 * LCAP + p1] = m;
                        unsigned* ti = F.tokinfo + (size_t)m * 8;
                        ti[0] = (unsigned)e0; ti[1] = p0; ti[2] = (unsigned)e1; ti[3] = p1; ti[4] = __builtin_bit_cast(unsigned, gw0); ti[5] = __builtin_bit_cast(unsigned, gw1);
                    }
                }
            }
            __syncthreads();
        }
    }
}

__device__ __forceinline__ void gla_front(const Ctx& F, int l, int h, int m0, LAS float* BF, LAS float* BR, LAS float* LFBT, LAS float* GWT, LAS float* GBT) {
    { const int tok = F.tid >> 3, c4 = F.tid & 7; *(LAS f32x4*)(LFBT + tok * 32 + c4 * 4) = *(const f32x4*)(F.lfb + (size_t)(m0 + tok) * 32 + c4 * 4); }
#pragma unroll
    for (int k = 0; k < 4; ++k) { const int idx = F.tid + 512 * k; const int dir = idx >> 10, r = (idx >> 6) & 15, d = idx & 63;
        GWT[idx] = F.gate_w[(size_t)((l * 2 + dir) * 16 + r) * 256 + h * 64 + d]; }
    if (F.tid < 128) { const int dir = F.tid >> 6, d = F.tid & 63; GBT[F.tid] = F.gate_b[(l * 2 + dir) * 256 + h * 64 + d]; }
    __syncthreads();
    for (int k = 0; k < 16; ++k) { const int idx = F.tid + 512 * k; const int dir = idx >> 12, i = (idx >> 6) & 63, d = idx & 63;
        float z = GBT[dir * 64 + d];
#pragma unroll
        for (int r = 0; r < 16; ++r) z += LFBT[i * 32 + dir * 16 + r] * GWT[(dir * 16 + r) * 64 + d];
        const float la = logsigf_(z) * (1.0f / 16.0f);
        (dir ? BR : BF)[i * 64 + d] = la; }
    __syncthreads();
    if (F.tid < 64) { const int d = F.tid; float run = 0.f; for (int i = 0; i < 64; ++i) { run += BF[i * 64 + d]; BF[i * 64 + d] = run; } }
    else if (F.tid < 128) { const int d = F.tid - 64; float run = 0.f; for (int i = 63; i >= 0; --i) { run += BR[i * 64 + d]; BR[i * 64 + d] = run; } }
    __syncthreads();
}
__device__ __forceinline__ void gla_a_item(const Ctx& F, int l, int it) {
    const int b = it >> 8, h = (it >> 6) & 3, c = it & 63, bh = b * 4 + h, m0 = b * T + c * 64;
    LAS float* BF = (LAS float*)F.lds; LAS float* BR = (LAS float*)(F.lds + 16384);
    LAS float* LFBT = (LAS float*)(F.lds + 32768); LAS float* GWT = (LAS float*)(F.lds + 40960); LAS float* GBT = (LAS float*)(F.lds + 49152);
    LAS bf16* KRAW = (LAS bf16*)(F.lds + 49664); LAS bf16* VRAW = (LAS bf16*)(F.lds + 57856);
    LAS float* KF = (LAS float*)(F.lds + 74240); LAS float* KB = (LAS float*)(F.lds + 90624);
    { const int tok = F.tid >> 3, ch = F.tid & 7; *(LAS u32x4*)(KRAW + tok * 64 + ch * 8) = *(const u32x4*)(F.KG + (size_t)(m0 + tok) * 256 + h * 64 + ch * 8); }
#pragma unroll
    for (int k = 0; k < 2; ++k) { const int idx = F.tid + 512 * k; const int tok = idx >> 4, ch = idx & 15;
        *(LAS u32x4*)(VRAW + tok * 128 + ch * 8) = *(const u32x4*)(F.VG + (size_t)(m0 + tok) * 512 + h * 128 + ch * 8); }
    gla_front(F, l, h, m0, BF, BR, LFBT, GWT, GBT);
#pragma unroll
    for (int k = 0; k < 8; ++k) { const int idx = F.tid + 512 * k; const int j = idx >> 6, d = idx & 63; const float kv = bf2f(KRAW[idx]);
        KF[idx] = kv * expf(BF[63 * 64 + d] - BF[j * 64 + d]); KB[idx] = kv * expf(BR[d] - BR[j * 64 + d]); }
    if (F.tid < 128) { const int dir = F.tid >> 6, d = F.tid & 63; F.gdec[(size_t)((bh * 2 + dir) * 64 + c) * 64 + d] = expf(dir ? BR[d] : BF[63 * 64 + d]); }
    __syncthreads();
    {
        const int dir = F.tid >> 8, tt = F.tid & 255, db = tt >> 4, eb = tt & 15;
        const LAS float* src = dir ? KB : KF;
        float acc[4][8];
#pragma unroll
        for (int a = 0; a < 4; ++a)
#pragma unroll
            for (int q = 0; q < 8; ++q) acc[a][q] = 0.f;
        for (int j = 0; j < 64; ++j) {
            const f32x4 kd = *(const LAS f32x4*)(src + j * 64 + db * 4); const u32x4 vv = *(const LAS u32x4*)(VRAW + j * 128 + eb * 8);
            float ve[8]; ve[0] = bf_lo(vv.x); ve[1] = bf_hi(vv.x); ve[2] = bf_lo(vv.y); ve[3] = bf_hi(vv.y); ve[4] = bf_lo(vv.z); ve[5] = bf_hi(vv.z); ve[6] = bf_lo(vv.w); ve[7] = bf_hi(vv.w);
#pragma unroll
            for (int a = 0; a < 4; ++a)
#pragma unroll
                for (int q = 0; q < 8; ++q) acc[a][q] += kd[a] * ve[q];
        }
        float* Ub = F.U + ((size_t)((bh * 2 + dir) * 64 + c) * 64) * 128;
#pragma unroll
        for (int a = 0; a < 4; ++a) { float* p = Ub + (size_t)(db * 4 + a) * 128 + eb * 8;
            *(f32x4*)p = (f32x4){acc[a][0], acc[a][1], acc[a][2], acc[a][3]}; *(f32x4*)(p + 4) = (f32x4){acc[a][4], acc[a][5], acc[a][6], acc[a][7]}; }
    }
    __syncthreads();
}
__device__ __forceinline__ void gla_b(const Ctx& F) {
    for (int id = F.vcu * 512 + F.tid; id < 32 * 2048; id += F.G * 512) {
        const int s = id >> 11, q4 = id & 2047, d = q4 >> 5, dir = s & 1;
        float* base = F.U + (size_t)s * 64 * 8192 + 4 * q4; const float* gd = F.gdec + (size_t)s * 64 * 64 + d;
        f32x4 S = (f32x4){0.f, 0.f, 0.f, 0.f};
#pragma unroll 8
        for (int step = 0; step < 64; ++step) { const int c = dir ? 63 - step : step;
            const f32x4 u = *(const f32x4*)(base + (size_t)c * 8192); const float g = gd[c * 64];
            *(f32x4*)(base + (size_t)c * 8192) = S; S = S * g + u; }
    }
}
__device__ __forceinline__ void gla_c_item(const Ctx& F, int l, int it) {
    const int b = it >> 8, h = (it >> 6) & 3, c = it & 63, bh = b * 4 + h, m0 = b * T + c * 64;
    LAS float* BF = (LAS float*)F.lds; LAS float* BR = (LAS float*)(F.lds + 17408); LAS float* P = BF;
    LAS float* LFBT = (LAS float*)(F.lds + 34816); LAS float* GWT = (LAS float*)(F.lds + 43008); LAS float* GBT = (LAS float*)(F.lds + 51200);
    LAS float* QF = (LAS float*)(F.lds + 51712); LAS float* QB = (LAS float*)(F.lds + 69120); LAS float* KF = (LAS float*)(F.lds + 86528); LAS float* KB = (LAS float*)(F.lds + 103936);
    LAS float* SST = KF;
    LAS bf16* VRAW = (LAS bf16*)(F.lds + 121344);
#pragma unroll
    for (int k = 0; k < 2; ++k) { const int idx = F.tid + 512 * k; const int tok = idx >> 4, ch = idx & 15;
        *(LAS u32x4*)(VRAW + tok * 128 + ch * 8) = *(const u32x4*)(F.VG + (size_t)(m0 + tok) * 512 + h * 128 + ch * 8); }
    gla_front(F, l, h, m0, BF, BR, LFBT, GWT, GBT);
#pragma unroll
    for (int k = 0; k < 8; ++k) { const int idx = F.tid + 512 * k; const int i = idx >> 6, d = idx & 63;
        const float qv = bf2f(F.QG[(size_t)(m0 + i) * 256 + h * 64 + d]), kv = bf2f(F.KG[(size_t)(m0 + i) * 256 + h * 64 + d]);
        const float bfv = BF[idx], brv = BR[idx];
        QF[i * 68 + d] = qv * expf(bfv); KF[i * 68 + d] = kv * expf(-bfv); QB[i * 68 + d] = qv * expf(brv); KB[i * 68 + d] = kv * expf(-brv); }
    __syncthreads();
    {
        float pf[8], pb[8];
#pragma unroll
        for (int ii = 0; ii < 8; ++ii) { pf[ii] = 0.f; pb[ii] = 0.f; }
        for (int d4 = 0; d4 < 16; ++d4) {
            const f32x4 kf4 = *(const LAS f32x4*)(KF + F.lane * 68 + d4 * 4), kb4 = *(const LAS f32x4*)(KB + F.lane * 68 + d4 * 4);
#pragma unroll
            for (int ii = 0; ii < 8; ++ii) { const f32x4 qf4 = *(const LAS f32x4*)(QF + (F.wave * 8 + ii) * 68 + d4 * 4), qb4 = *(const LAS f32x4*)(QB + (F.wave * 8 + ii) * 68 + d4 * 4);
                pf[ii] += (qf4[0] * kf4[0] + qf4[1] * kf4[1]) + (qf4[2] * kf4[2] + qf4[3] * kf4[3]);
                pb[ii] += (qb4[0] * kb4[0] + qb4[1] * kb4[1]) + (qb4[2] * kb4[2] + qb4[3] * kb4[3]); }
        }
        __syncthreads();
#pragma unroll
        for (int ii = 0; ii < 8; ++ii) { const int i = F.wave * 8 + ii; P[i * 68 + F.lane] = (F.lane <= i) ? pf[ii] : pb[ii]; }
    }
    __syncthreads();
    const int ib = F.tid >> 5, e4 = F.tid & 31;
    f32x4 acc[4];
#pragma unroll
    for (int ii = 0; ii < 4; ++ii) acc[ii] = (f32x4){0.f, 0.f, 0.f, 0.f};
#pragma unroll
    for (int k = 0; k < 4; ++k) { const int idx = F.tid + 512 * k; *(LAS f32x4*)(SST + idx * 4) = *(const f32x4*)(F.U + ((size_t)((bh * 2 + 0) * 64 + c) * 8192) + idx * 4); }
    for (int j4 = 0; j4 < 16; ++j4) {
        f32x4 p4[4];
#pragma unroll
        for (int ii = 0; ii < 4; ++ii) p4[ii] = *(const LAS f32x4*)(P + (ib * 4 + ii) * 68 + j4 * 4);
#pragma unroll
        for (int jj = 0; jj < 4; ++jj) { const u32x2 vv = *(const LAS u32x2*)(VRAW + (j4 * 4 + jj) * 128 + e4 * 4);
            const f32x4 v4 = (f32x4){bf_lo(vv.x), bf_hi(vv.x), bf_lo(vv.y), bf_hi(vv.y)};
#pragma unroll
            for (int ii = 0; ii < 4; ++ii) acc[ii] += v4 * p4[ii][jj]; }
    }
    __syncthreads();
    for (int d4 = 0; d4 < 16; ++d4) {
        f32x4 q4[4];
#pragma unroll
        for (int ii = 0; ii < 4; ++ii) q4[ii] = *(const LAS f32x4*)(QF + (ib * 4 + ii) * 68 + d4 * 4);
#pragma unroll
        for (int dd = 0; dd < 4; ++dd) { const f32x4 s4 = *(const LAS f32x4*)(SST + (d4 * 4 + dd) * 128 + e4 * 4);
#pragma unroll
            for (int ii = 0; ii < 4; ++ii) acc[ii] += s4 * q4[ii][dd]; }
    }
    __syncthreads();
#pragma unroll
    for (int k = 0; k < 4; ++k) { const int idx = F.tid + 512 * k; *(LAS f32x4*)(SST + idx * 4) = *(const f32x4*)(F.U + ((size_t)((bh * 2 + 1) * 64 + c) * 8192) + idx * 4); }
    __syncthreads();
    for (int d4 = 0; d4 < 16; ++d4) {
        f32x4 q4[4];
#pragma unroll
        for (int ii = 0; ii < 4; ++ii) q4[ii] = *(const LAS f32x4*)(QB + (ib * 4 + ii) * 68 + d4 * 4);
#pragma unroll
        for (int dd = 0; dd < 4; ++dd) { const f32x4 s4 = *(const LAS f32x4*)(SST + (d4 * 4 + dd) * 128 + e4 * 4);
#pragma unroll
            for (int ii = 0; ii < 4; ++ii) acc[ii] += s4 * q4[ii][dd]; }
    }
    const f32x4 gn = *(const f32x4*)(F.gla_norm + l * 128 + e4 * 4);
#pragma unroll
    for (int ii = 0; ii < 4; ++ii) {
        float ss = (acc[ii][0] * acc[ii][0] + acc[ii][1] * acc[ii][1]) + (acc[ii][2] * acc[ii][2] + acc[ii][3] * acc[ii][3]);
        ss += __shfl_xor(ss, 1); ss += __shfl_xor(ss, 2); ss += __shfl_xor(ss, 4); ss += __shfl_xor(ss, 8); ss += __shfl_xor(ss, 16);
        const float rstd = 1.0f / sqrtf(ss * (1.0f / 128.0f) + EPS);
        const int m = m0 + ib * 4 + ii;
        const u32x2 gg = *(const u32x2*)(F.GG + (size_t)m * 512 + h * 128 + e4 * 4);
        const float g0 = bf_lo(gg.x), g1 = bf_hi(gg.x), g2 = bf_lo(gg.y), g3 = bf_hi(gg.y);
        const float o0 = acc[ii][0] * rstd * gn[0] * (g0 * sigmoidf_(g0)), o1 = acc[ii][1] * rstd * gn[1] * (g1 * sigmoidf_(g1));
        const float o2 = acc[ii][2] * rstd * gn[2] * (g2 * sigmoidf_(g2)), o3 = acc[ii][3] * rstd * gn[3] * (g3 * sigmoidf_(g3));
        u32x2 o; o.x = pk2(o0, o1); o.y = pk2(o2, o3);
        *(u32x2*)(F.XN + (size_t)m * D + h * 128 + e4 * 4) = o;
    }
    __syncthreads();
}

__device__ __forceinline__ void natten_item(const Ctx& F, int l, int it) {
    const int b = it >> 9, hh = (it >> 6) & 7, r = it & 63;
    const int rs = min(max(r - 4, 0), 56); const int tok0 = b * T + rs * 64;
    LAS bf16* KT = (LAS bf16*)F.lds; LAS bf16* VT = (LAS bf16*)(F.lds + 65536); LAS float* RPB = (LAS float*)(F.lds + 131072);
#pragma unroll
    for (int k = 0; k < 8; ++k) { const int idx = F.tid + 512 * k; const int kk = idx >> 3, ch = idx & 7;
        *(LAS u32x4*)(KT + kk * 64 + ch * 8) = *(const u32x4*)(F.KN + (size_t)(tok0 + kk) * 512 + hh * 64 + ch * 8);
        *(LAS u32x4*)(VT + kk * 64 + ch * 8) = *(const u32x4*)(F.VN + (size_t)(tok0 + kk) * 512 + hh * 64 + ch * 8); }
    if (F.tid < 465) RPB[F.tid] = F.rpb[(size_t)(l * 8 + hh) * 465 + F.tid];
    __syncthreads();
    const int i = F.tid >> 3, dc = F.tid & 7; const int m = b * T + r * 64 + i; const int cs = min(max(i - 8, 0), 48);
    float qf[8];
    { const u32x4 q8 = *(const u32x4*)(F.QN + (size_t)m * 512 + hh * 64 + dc * 8);
      qf[0] = bf_lo(q8.x); qf[1] = bf_hi(q8.x); qf[2] = bf_lo(q8.y); qf[3] = bf_hi(q8.y); qf[4] = bf_lo(q8.z); qf[5] = bf_hi(q8.z); qf[6] = bf_lo(q8.w); qf[7] = bf_hi(q8.w); }
    float sc[16];
    const bool b4 = (dc & 4) != 0, b2 = (dc & 2) != 0, b1 = (dc & 1) != 0;
#pragma unroll
    for (int g = 0; g < 16; ++g) {
        float p[8];
#pragma unroll
        for (int t = 0; t < 8; ++t) { const int key = (g >> 1) * 64 + cs + (g & 1) * 8 + t; const u32x4 k8 = *(const LAS u32x4*)(KT + key * 64 + dc * 8);
            p[t] = (qf[0] * bf_lo(k8.x) + qf[1] * bf_hi(k8.x)) + (qf[2] * bf_lo(k8.y) + qf[3] * bf_hi(k8.y)) + (qf[4] * bf_lo(k8.z) + qf[5] * bf_hi(k8.z)) + (qf[6] * bf_lo(k8.w) + qf[7] * bf_hi(k8.w)); }
        float p4[4], p2[2];
#pragma unroll
        for (int t = 0; t < 4; ++t) { const float snd = b4 ? p[t] : p[t + 4]; const float rcv = __shfl_xor(snd, 4); p4[t] = (b4 ? p[t + 4] : p[t]) + rcv; }
#pragma unroll
        for (int t = 0; t < 2; ++t) { const float snd = b2 ? p4[t] : p4[t + 2]; const float rcv = __shfl_xor(snd, 2); p2[t] = (b2 ? p4[t + 2] : p4[t]) + rcv; }
        const float snd = b1 ? p2[0] : p2[1]; const float rcv = __shfl_xor(snd, 1); const float s = (b1 ? p2[1] : p2[0]) + rcv;
        const int kr = g >> 1, cc = (g & 1) * 8 + dc;
        sc[g] = s + RPB[(rs + kr - r + 7) * 31 + (cs + cc - i + 15)];
    }
    float mx = sc[0];
#pragma unroll
    for (int g = 1; g < 16; ++g) mx = fmaxf(mx, sc[g]);
    mx = fmaxf(mx, __shfl_xor(mx, 1)); mx = fmaxf(mx, __shfl_xor(mx, 2)); mx = fmaxf(mx, __shfl_xor(mx, 4));
    float sum = 0.f;
#pragma unroll
    for (int g = 0; g < 16; ++g) { sc[g] = expf(sc[g] - mx); sum += sc[g]; }
    sum += __shfl_xor(sum, 1); sum += __shfl_xor(sum, 2); sum += __shfl_xor(sum, 4);
    const float inv = 1.0f / sum;
    float o[8];
#pragma unroll
    for (int q = 0; q < 8; ++q) o[q] = 0.f;
    const int lbase = F.lane & ~7;
#pragma unroll
    for (int g = 0; g < 16; ++g)
#pragma unroll
        for (int t = 0; t < 8; ++t) { const float pk = __shfl(sc[g], lbase + t); const int key = (g >> 1) * 64 + cs + (g & 1) * 8 + t;
            const u32x4 v8 = *(const LAS u32x4*)(VT + key * 64 + dc * 8);
            o[0] += pk * bf_lo(v8.x); o[1] += pk * bf_hi(v8.x); o[2] += pk * bf_lo(v8.y); o[3] += pk * bf_hi(v8.y);
            o[4] += pk * bf_lo(v8.z); o[5] += pk * bf_hi(v8.z); o[6] += pk * bf_lo(v8.w); o[7] += pk * bf_hi(v8.w); }
    u32x4 ov; ov.x = pk2(o[0] * inv, o[1] * inv); ov.y = pk2(o[2] * inv, o[3] * inv); ov.z = pk2(o[4] * inv, o[5] * inv); ov.w = pk2(o[6] * inv, o[7] * inv);
    *(u32x4*)(F.XN + (size_t)m * D + 512 + hh * 64 + dc * 8) = ov;
    __syncthreads();
}

__global__ void __launch_bounds__(512, 2) fwd_kernel(Args args) {
    extern __shared__ __attribute__((aligned(16))) unsigned char lds_raw[];
    Base B;
    B.lds = (LAS unsigned char*)lds_raw;
    B.tid = threadIdx.x; B.lane = B.tid & 63; B.wave = __builtin_amdgcn_readfirstlane(B.tid >> 6);
    B.G = gridDim.x; { const int bx = blockIdx.x; B.vcu = (B.G % 8 == 0) ? (bx % 8) * (B.G / 8) + bx / 8 : bx; }
    for (int u = B.tid; u < (LDS_BYTES - LDSCTL_OFF) / 4; u += 512) ((LAS unsigned*)(B.lds + LDSCTL_OFF))[u] = 0u;
    __syncthreads();
    volatile LAS unsigned* MISC = (volatile LAS unsigned*)(B.lds + MISC_OFF);
    unsigned* const barw = (unsigned*)(args.ws + WS_CTL) + CW_BAR;
    XcdBarrier bar; bar.bar = barw; bar.x = 0; bar.st = nullptr;
    const bool multi = (args.ph_hi - args.ph_lo) > 1;
    if (multi) bar = xcd_barrier_post(barw, MISC + 8);

#ifndef PHM
#define PHM 0xfff
#endif
#define PH_EN(bit) ((PHM >> (bit)) & 1)
    for (int ph = args.ph_lo; ph < args.ph_hi; ++ph) {
        if (ph == 0) { if (PH_EN(0)) { const Ctx F = make_ctx(B); phase_p0(F); } }
        else if (ph == NPHASES - 1) { if (PH_EN(1)) { const Ctx F = make_ctx(B); prepass<2>(F, 0); } }
        else {
            const int l = (ph - 1) / 9, sp = (ph - 1) % 9;
            if (sp == 0) { if (PH_EN(2)) { const Ctx F = make_ctx(B); prepass<0>(F, l); } }
            else if (sp == 1) { if (PH_EN(3)) { const Ctx F = make_ctx(B);
                pg8::DenseSched S; S.init(F.XN, F.win_t + (size_t)l * NPROJ * D, NTOK, NPROJ, D, F.G, F.bx);
                EpiInProj E{F.QG, F.KG, F.VG, F.GG, F.QN, F.KN, F.VN, F.q_norm + l * 64, F.k_norm + l * 64};
                pg8::gemm_phase<EpiInProj, pg8::DenseSched>(F.lds, D, S, E, F.tid);
            } } else if (sp == 2) { const Ctx F = make_ctx(B);
                for (int it = F.vcu; it < 3072; it += F.G) { if (it < 1024) { if (PH_EN(4)) gla_a_item(F, l, it); } else { if (PH_EN(5)) natten_item(F, l, it - 1024); } }
            } else if (sp == 3) { if (PH_EN(6)) { const Ctx F = make_ctx(B); gla_b(F); } }
            else if (sp == 4) { if (PH_EN(7)) { const Ctx F = make_ctx(B); for (int it = F.vcu; it < 1024; it += F.G) gla_c_item(F, l, it); } }
            else if (sp == 5) { if (PH_EN(8)) { const Ctx F = make_ctx(B);
                pg8::DenseSched S; S.init(F.XN, F.wout_t + (size_t)l * D * D, NTOK, D, D, F.G, F.bx);
                EpiResid E{l == 0 ? F.x_in : F.X, F.X, F.mod + (size_t)(l * 4) * MODW + 2 * D};
                pg8::gemm_phase<EpiResid, pg8::DenseSched>(F.lds, D, S, E, F.tid);
            } } else if (sp == 6) { if (PH_EN(9)) { const Ctx F = make_ctx(B); prepass<1>(F, l); } }
            else if (sp == 7) { if (PH_EN(10)) { const Ctx F = make_ctx(B);
                moe_tables(F, l);
                pg8::MoeSched<true> S; S.A = (const char*)F.XN; S.Bt = (const char*)(F.w13_t + (size_t)l * NE * 1024 * D); S.K = D; S.lists = F.lists;
                S.TS = (const LAS int*)(F.lds + TAB_OFF); S.CN = S.TS + 40; S.G = F.G; S.c = F.vcu;
                EpiSwiGLU E{F.H};
                pg8::gemm_phase<EpiSwiGLU, pg8::MoeSched<true>>(F.lds, D, S, E, F.tid);
            } } else { if (PH_EN(11)) { const Ctx F = make_ctx(B);
                moe_tables(F, l);
                pg8::MoeSched<false> S; S.A = (const char*)F.H; S.Bt = (const char*)(F.w2_t + (size_t)l * NE * D * DE); S.K = DE; S.lists = F.lists;
                S.TS = (const LAS int*)(F.lds + TAB_OFF); S.CN = S.TS + 40; S.G = F.G; S.c = F.vcu;
                EpiY E{F.Y};
                pg8::gemm_phase<EpiY, pg8::MoeSched<false>>(F.lds, DE, S, E, F.tid);
            } }
        }
        if (ph + 1 < args.ph_hi) xcd_barrier(bar);
    }
}

extern "C" void kernel_launch(void* const* d_in, const int* in_sizes, int n_in, void* d_out, int out_size, void* d_ws, size_t ws_size, hipStream_t stream) {
    static int grid = 0;
    if (grid == 0) {
        if (n_in != 19 || in_sizes[0] != NTOK * D || out_size != NTOK * D || ws_size < WS_END) {
            fprintf(stderr, "kernel_launch: unexpected shapes (n_in %d, in0 %d, out %d, ws %zu, need %zu); nothing launched\n", n_in, n_in > 0 ? in_sizes[0] : -1, out_size, ws_size, (size_t)WS_END); grid = -1; return; }
        int dev = 0, cus = 0;
        if (hipGetDevice(&dev) != hipSuccess || hipDeviceGetAttribute(&cus, hipDeviceAttributeMultiprocessorCount, dev) != hipSuccess) { fprintf(stderr, "kernel_launch: device query failed\n"); grid = -1; return; }
        if (hipFuncSetAttribute((const void*)fwd_kernel, hipFuncAttributeMaxDynamicSharedMemorySize, LDS_BYTES) != hipSuccess) { fprintf(stderr, "kernel_launch: hipFuncSetAttribute failed\n"); grid = -1; return; }
        (void)hipGetLastError();
        grid = cus;
    }
    if (grid < 0) return;
    if (hipMemsetAsync((char*)d_ws + WS_CTL, 0, CTL_ZERO_BYTES, stream) != hipSuccess) { fprintf(stderr, "kernel_launch: memset failed\n"); return; }
    Args a{};
    for (int i = 0; i < 19; ++i) a.in[i] = (const float*)d_in[i];
    a.out = (float*)d_out; a.ws = (unsigned char*)d_ws;
#if MK_PER_PHASE
    for (int ph = 0; ph < NPHASES; ++ph) { a.ph_lo = ph; a.ph_hi = ph + 1; hipLaunchKernelGGL(fwd_kernel, dim3(grid), dim3(512), LDS_BYTES, stream, a); }
#else
    a.ph_lo = 0; a.ph_hi = NPHASES;
    hipLaunchKernelGGL(fwd_kernel, dim3(grid), dim3(512), LDS_BYTES, stream, a);
#endif
    const hipError_t le = hipPeekAtLastError();
    if (le != hipSuccess) fprintf(stderr, "kernel_launch: launch failed: %s\n", hipGetErrorName(le));
}
```

```cpp
#include <hip/hip_runtime.h>
#include <cstdio>
#include <cstdint>

#ifndef MK_PER_PHASE
#define MK_PER_PHASE 0
#endif

#define LAS __attribute__((address_space(3)))
#define GAS __attribute__((address_space(1)))
typedef unsigned short bf16;
typedef short bf16x8 __attribute__((ext_vector_type(8)));
typedef float f32x4 __attribute__((ext_vector_type(4)));
typedef float f32x2 __attribute__((ext_vector_type(2)));
typedef unsigned u32x4 __attribute__((ext_vector_type(4)));
typedef unsigned u32x2 __attribute__((ext_vector_type(2)));
typedef GAS unsigned gu32;

constexpr int NB = 4, T = 4096, D = 1024, NTOK = NB * T, DEPTH = 2, INW = 3104, NPROJ = 3072, MODW = 6144;
constexpr int NE = 32, DE = 512, LCAP = 16384;
constexpr float EPS = 1e-6f;
constexpr int NPHASES = 20;

constexpr size_t MiB = 1u << 20;
constexpr size_t WS_CTL = 0, CTL_ZERO_BYTES = 1 * MiB;
constexpr size_t WS_MOD = 1 * MiB;
constexpr size_t WS_LFB = 2 * MiB;
constexpr size_t WS_TOKINFO = 4 * MiB;
constexpr size_t WS_GDEC = 4 * MiB + 512 * 1024;
constexpr size_t WS_LISTS = 5 * MiB;
constexpr size_t WS_WIN = 8 * MiB;
constexpr size_t WS_WOUT = 20 * MiB;
constexpr size_t WS_W13 = 24 * MiB;
constexpr size_t WS_W2 = 152 * MiB;
constexpr size_t WS_XN = 216 * MiB;
constexpr size_t WS_X = 248 * MiB;
constexpr size_t WS_QG = 312 * MiB, WS_KG = 320 * MiB, WS_VG = 328 * MiB, WS_GG = 344 * MiB, WS_QN = 360 * MiB, WS_KN = 376 * MiB, WS_VN = 392 * MiB;
constexpr size_t WS_U = 408 * MiB;
constexpr size_t WS_H = 312 * MiB;
constexpr size_t WS_Y = 352 * MiB;
constexpr size_t WS_SP = 472 * MiB;
constexpr size_t WS_END = 504 * MiB;
constexpr int CW_BAR = 4096, CW_CNT = 16384;

constexpr int SCR_BYTES = 155648;
constexpr int LDSCTL_OFF = SCR_BYTES, MISC_OFF = LDSCTL_OFF + 320, TAB_OFF = LDSCTL_OFF + 1024;
constexpr int LDS_BYTES = 163840;

#define RLX_AGENT __ATOMIC_RELAXED, __HIP_MEMORY_SCOPE_AGENT
__device__ __forceinline__ unsigned f2bf(float f) { unsigned u = __builtin_bit_cast(unsigned, f); return (u + 0x7fffu + ((u >> 16) & 1u)) >> 16; }
__device__ __forceinline__ unsigned pk2(float lo, float hi) { return f2bf(lo) | (f2bf(hi) << 16); }
__device__ __forceinline__ float bf_lo(unsigned w) { return __builtin_bit_cast(float, w << 16); }
__device__ __forceinline__ float bf_hi(unsigned w) { return __builtin_bit_cast(float, w & 0xffff0000u); }
__device__ __forceinline__ float bf2f(bf16 b) { return __builtin_bit_cast(float, (unsigned)b << 16); }
__device__ __forceinline__ unsigned cvt_pk_bf16(float lo, float hi) { unsigned r; asm volatile("v_cvt_pk_bf16_f32 %0, %1, %2" : "=v"(r) : "v"(lo), "v"(hi)); return r; }
__device__ __forceinline__ float wave_sum(float v) {
#pragma unroll
    for (int o = 1; o < 64; o <<= 1) v += __shfl_xor(v, o);
    return v;
}
__device__ __forceinline__ float sigmoidf_(float x) { return 1.0f / (1.0f + __expf(-x)); }
__device__ __forceinline__ float logsigf_(float z) { return fminf(z, 0.f) - log1pf(expf(-fabsf(z))); }


typedef short s16x4 __attribute__((ext_vector_type(4)));
typedef __bf16 bf16x2_t __attribute__((ext_vector_type(2)));
__device__ __forceinline__ unsigned cvtpk(float lo, float hi) { f32x2 v = {lo, hi}; bf16x2_t b = __builtin_convertvector(v, bf16x2_t); return __builtin_bit_cast(unsigned, b); }
__device__ __forceinline__ f32x4 mfma16(bf16x8 a, bf16x8 b, f32x4 c) { return __builtin_amdgcn_mfma_f32_16x16x32_bf16(a, b, c, 0, 0, 0); }
__device__ __forceinline__ s16x4 tr16(const LAS void* p) { return __builtin_amdgcn_ds_read_tr16_b64_v4i16((LAS s16x4*)p); }
__device__ __forceinline__ bf16x8 cat8(s16x4 lo, s16x4 hi) { return __builtin_shufflevector(lo, hi, 0, 1, 2, 3, 4, 5, 6, 7); }
__device__ __forceinline__ bf16x8 pack8(f32x4 a, f32x4 b) { u32x4 p; p.x = cvtpk(a[0], a[1]); p.y = cvtpk(a[2], a[3]); p.z = cvtpk(b[0], b[1]); p.w = cvtpk(b[2], b[3]); return __builtin_bit_cast(bf16x8, p); }

struct Ctx {
    LAS unsigned char* lds;
    int tid, lane, wave, vcu, G, bx;
    const float *x_in, *c, *w_ada, *b_ada, *attn_norm, *ffn_norm, *w_in, *gate_w, *gate_b, *gla_norm, *q_norm, *k_norm, *rpb, *w_out, *router_w, *router_b, *w1, *w3, *w2;
    float* out;
    gu32* ctl;
    float *mod, *lfb, *gdec, *X, *U; bf16* SP;
    unsigned* tokinfo; int* lists;
    bf16 *win_t, *wout_t, *w13_t, *w2_t, *XN, *QG, *KG, *VG, *GG, *QN, *KN, *VN, *H, *Y;
};

struct Args { const float* in[19]; float* out; unsigned char* ws; int ph_lo, ph_hi; };
struct Base { LAS unsigned char* lds; int tid, lane, wave, vcu, G; };
typedef __attribute__((address_space(4))) const Args CArgs;
__device__ __forceinline__ CArgs* kargs() { CArgs* p = (CArgs*)__builtin_amdgcn_kernarg_segment_ptr(); asm volatile("" : "+s"(p)); return p; }
__device__ __forceinline__ Ctx make_ctx(const Base& B) {
    CArgs* A = kargs(); Ctx F;
    { int t = B.tid; asm volatile("" : "+v"(t)); F.tid = t; F.lane = t & 63; F.wave = __builtin_amdgcn_readfirstlane(t >> 6); }
    { int v = B.vcu, g = B.G; asm volatile("" : "+s"(v), "+s"(g)); F.vcu = v; F.G = g; int bx = (int)blockIdx.x; asm volatile("" : "+s"(bx)); F.bx = bx; }
    { LAS unsigned char* lp = B.lds; asm volatile("" : "+s"(lp)); F.lds = lp; }
    F.x_in = A->in[0]; F.c = A->in[1]; F.w_ada = A->in[2]; F.b_ada = A->in[3]; F.attn_norm = A->in[4]; F.ffn_norm = A->in[5]; F.w_in = A->in[6];
    F.gate_w = A->in[7]; F.gate_b = A->in[8]; F.gla_norm = A->in[9]; F.q_norm = A->in[10]; F.k_norm = A->in[11]; F.rpb = A->in[12]; F.w_out = A->in[13];
    F.router_w = A->in[14]; F.router_b = A->in[15]; F.w1 = A->in[16]; F.w3 = A->in[17]; F.w2 = A->in[18];
    F.out = A->out;
    unsigned char* ws = A->ws;
    F.ctl = (gu32*)(ws + WS_CTL);
    F.mod = (float*)(ws + WS_MOD); F.lfb = (float*)(ws + WS_LFB); F.gdec = (float*)(ws + WS_GDEC); F.X = (float*)(ws + WS_X); F.U = (float*)(ws + WS_U); F.SP = (bf16*)(ws + WS_SP);
    F.tokinfo = (unsigned*)(ws + WS_TOKINFO); F.lists = (int*)(ws + WS_LISTS);
    F.win_t = (bf16*)(ws + WS_WIN); F.wout_t = (bf16*)(ws + WS_WOUT); F.w13_t = (bf16*)(ws + WS_W13); F.w2_t = (bf16*)(ws + WS_W2);
    F.XN = (bf16*)(ws + WS_XN); F.QG = (bf16*)(ws + WS_QG); F.KG = (bf16*)(ws + WS_KG); F.VG = (bf16*)(ws + WS_VG); F.GG = (bf16*)(ws + WS_GG);
    F.QN = (bf16*)(ws + WS_QN); F.KN = (bf16*)(ws + WS_KN); F.VN = (bf16*)(ws + WS_VN); F.H = (bf16*)(ws + WS_H); F.Y = (bf16*)(ws + WS_Y);
    return F;
}

namespace pg8 {
constexpr int BM = 256, BK = 64, HALF = 128, HTB = HALF * BK * 2, STAGE_BYTES = 8 * HTB;
__host__ __device__ __forceinline__ int lds_byte(int r, int c) { const int st = (r >> 4) * 2 + (c >> 5), rr = r & 15, cc = c & 31, ob = rr * 64 + cc * 2; return st * 1024 + (ob ^ (((ob >> 9) & 1) << 5)); }
__host__ __device__ __forceinline__ void stage_rc(int b, int& R, int& C) { const int st = b / 1024, sb = b % 1024, swz = sb ^ (((sb >> 9) & 1) << 5); R = (st >> 1) * 16 + swz / 64; C = (st & 1) * 32 + (swz % 64) / 2; }
__host__ __device__ __forceinline__ int perm32(int rho) { const int n = rho >> 4, i = rho & 15; return 8 * (i >> 2) + 4 * n + (i & 3); }

struct Unit { int rowbase, pn, e, posbase, cnt; };

template <class Epi, class Sched>
__device__ __forceinline__ void gemm_phase(LAS unsigned char* lds, const int K, const Sched& S, const Epi& E, const int tid) {
    const int wid = __builtin_amdgcn_readfirstlane(tid >> 6), lane = tid & 63, wr = wid >> 2, wc = wid & 3, fr = lane & 15, fq = lane >> 4;
    const int nt = K / BK;
    int R0, C0, R1, C1; stage_rc(tid * 16, R0, C0); stage_rc(tid * 16 + 8192, R1, C1);
    const int Rb0 = Epi::PERM ? ((R0 & ~31) + perm32(R0 & 31)) : R0, Rb1 = Epi::PERM ? ((R1 & ~31) + perm32(R1 & 31)) : R1;
    const unsigned vb0 = (unsigned)(Rb0 * K + C0) * 2u, vb1 = (unsigned)(Rb1 * K + C1) * 2u;
    const size_t kstep = (size_t)(BK * 2);
    const size_t hstepB = (size_t)HALF * K * 2;
    const unsigned ldsw = (unsigned)wid * 1024u;
    const int aoff = lds_byte(wr * 64 + fr, fq * 8), boff = lds_byte(wc * 32 + fr, fq * 8);
#define PG8_SA(b, h) (((b) * 2 + (h)) * HTB)
#define PG8_SB(b, h) ((4 + (b) * 2 + (h)) * HTB)
#define PG8_STAGE2(bufoff, gbase, o0, o1) do { \
        __builtin_amdgcn_global_load_lds((const unsigned*)((const char*)(gbase) + (o0)), (LAS unsigned*)(lds + (bufoff) + ldsw), 16, 0, 0); \
        __builtin_amdgcn_global_load_lds((const unsigned*)((const char*)(gbase) + (o1)), (LAS unsigned*)(lds + (bufoff) + ldsw + 8192), 16, 0, 0); } while (0)
#define PG8_LDA(dst, b, h) do { _Pragma("unroll") for (int m = 0; m < 4; ++m) _Pragma("unroll") for (int k = 0; k < 2; ++k) dst[m][k] = *(const LAS bf16x8*)(lds + PG8_SA(b, h) + aoff + m * 2048 + k * 1024); } while (0)
#define PG8_LDB(dst, b, h) do { _Pragma("unroll") for (int n = 0; n < 2; ++n) _Pragma("unroll") for (int k = 0; k < 2; ++k) dst[n][k] = *(const LAS bf16x8*)(lds + PG8_SB(b, h) + boff + n * 2048 + k * 1024); } while (0)
#define PG8_MMA(ai, bj, At, Bt) do { __builtin_amdgcn_s_setprio(1); _Pragma("unroll") for (int m = 0; m < 4; ++m) _Pragma("unroll") for (int n = 0; n < 2; ++n) _Pragma("unroll") for (int k = 0; k < 2; ++k) \
        acc[ai][bj][m][n] = __builtin_amdgcn_mfma_f32_16x16x32_bf16(Bt[n][k], At[m][k], acc[ai][bj][m][n], 0, 0, 0); __builtin_amdgcn_s_setprio(0); } while (0)
#define PG8_WAIT_V(n) asm volatile("s_waitcnt vmcnt(" #n ")" ::: "memory")
#define PG8_WAIT_L(n) asm volatile("s_waitcnt lgkmcnt(" #n ")" ::: "memory")
#define PG8_BAR __builtin_amdgcn_s_barrier()
#define PG8_SCHED __builtin_amdgcn_sched_barrier(0)
    Unit cur, nxt; int ui = 0;
    if (!S.next(0, cur)) return;
    f32x4 acc[2][2][4][2];
#pragma unroll
    for (int a = 0; a < 2; ++a)
#pragma unroll
        for (int b = 0; b < 2; ++b)
#pragma unroll
            for (int m = 0; m < 4; ++m)
#pragma unroll
                for (int n = 0; n < 2; ++n) acc[a][b][m][n] = (f32x4){0.f, 0.f, 0.f, 0.f};
    bf16x8 At[4][2], B0[2][2], B1[2][2];
    const char* cA = S.Abase(cur); const char* cB = S.Bbase(cur);
    unsigned ca0 = S.aoff(cur, 0, R0, C0), ca1 = S.aoff(cur, 0, R1, C1), ca2 = S.aoff(cur, 1, R0, C0), ca3 = S.aoff(cur, 1, R1, C1);
    PG8_STAGE2(PG8_SB(0, 0), cB, vb0, vb1); PG8_STAGE2(PG8_SB(0, 1), cB + hstepB, vb0, vb1); PG8_STAGE2(PG8_SA(0, 0), cA, ca0, ca1); PG8_STAGE2(PG8_SA(0, 1), cA, ca2, ca3);
    if (wr == 1) PG8_BAR;
    PG8_WAIT_V(2); PG8_BAR;
    PG8_STAGE2(PG8_SB(1, 0), cB + kstep, vb0, vb1); PG8_STAGE2(PG8_SA(1, 0), cA + kstep, ca0, ca1); PG8_STAGE2(PG8_SB(1, 1), cB + hstepB + kstep, vb0, vb1);
    PG8_WAIT_V(6); PG8_BAR;
    for (;;) {
        const bool has_next = S.next(ui + 1, nxt);
        const char* nA = has_next ? S.Abase(nxt) : cA; const char* nB = has_next ? S.Bbase(nxt) : cB;
        unsigned na0 = ca0, na1 = ca1, na2 = ca2, na3 = ca3;
        if (has_next) { na0 = S.aoff(nxt, 0, R0, C0); na1 = S.aoff(nxt, 0, R1, C1); na2 = S.aoff(nxt, 1, R0, C0); na3 = S.aoff(nxt, 1, R1, C1); }
        for (int t = 0; t < nt; t += 2) {
            const bool last = (t == nt - 2);
            const char* a1 = cA + (size_t)(t + 1) * kstep;
            const char* a2 = last ? nA : cA + (size_t)(t + 2) * kstep; const char* b2 = last ? nB : cB + (size_t)(t + 2) * kstep;
            const char* a3 = a2 + kstep; const char* b3 = b2 + kstep;
            const unsigned s0 = last ? na0 : ca0, s1 = last ? na1 : ca1, s2 = last ? na2 : ca2, s3 = last ? na3 : ca3;
            PG8_LDB(B0, 0, 0); PG8_LDB(B1, 0, 1); PG8_SCHED; PG8_LDA(At, 0, 0); PG8_STAGE2(PG8_SA(1, 1), a1, ca2, ca3);
            PG8_WAIT_V(8); PG8_WAIT_L(0); PG8_BAR; PG8_MMA(0, 0, At, B0); PG8_MMA(0, 1, At, B1); PG8_BAR; PG8_SCHED;
            PG8_LDA(At, 0, 1); PG8_STAGE2(PG8_SB(0, 0), b2, vb0, vb1); PG8_STAGE2(PG8_SB(0, 1), b2 + hstepB, vb0, vb1); PG8_STAGE2(PG8_SA(0, 0), a2, s0, s1);
            PG8_WAIT_V(8); PG8_WAIT_L(0); PG8_BAR; PG8_MMA(1, 0, At, B0); PG8_MMA(1, 1, At, B1); PG8_BAR; PG8_SCHED;
            PG8_LDB(B0, 1, 0); PG8_LDB(B1, 1, 1); PG8_SCHED; PG8_LDA(At, 1, 0); PG8_STAGE2(PG8_SA(0, 1), a2, s2, s3);
            PG8_WAIT_V(8); PG8_WAIT_L(0); PG8_BAR; PG8_MMA(0, 0, At, B0); PG8_MMA(0, 1, At, B1); PG8_BAR; PG8_SCHED;
            PG8_LDA(At, 1, 1); PG8_STAGE2(PG8_SB(1, 0), b3, vb0, vb1); PG8_STAGE2(PG8_SB(1, 1), b3 + hstepB, vb0, vb1); PG8_STAGE2(PG8_SA(1, 0), a3, s0, s1);
            PG8_WAIT_V(8); PG8_WAIT_L(0); PG8_BAR; PG8_MMA(1, 0, At, B0); PG8_MMA(1, 1, At, B1); PG8_BAR; PG8_SCHED;
        }
        if (wr == 0) PG8_BAR;
        E(acc, cur, wr, wc, fr, fq);
        if (!has_next) break;
#pragma unroll
        for (int a = 0; a < 2; ++a)
#pragma unroll
            for (int b = 0; b < 2; ++b)
#pragma unroll
                for (int m = 0; m < 4; ++m)
#pragma unroll
                    for (int n = 0; n < 2; ++n) acc[a][b][m][n] = (f32x4){0.f, 0.f, 0.f, 0.f};
        cur = nxt; cA = nA; cB = nB; ca0 = na0; ca1 = na1; ca2 = na2; ca3 = na3; ++ui;
        if (wr == 1) PG8_BAR;
    }
    PG8_WAIT_V(0);
    PG8_BAR;
#undef PG8_SA
#undef PG8_SB
#undef PG8_STAGE2
#undef PG8_LDA
#undef PG8_LDB
#undef PG8_MMA
#undef PG8_WAIT_V
#undef PG8_WAIT_L
#undef PG8_BAR
#undef PG8_SCHED
}

struct DenseSched {
    const char* A; const char* Bt; int K, nM, nN, nwg, G, c;
    __device__ __forceinline__ void init(const void* A_, const void* Bt_, int M, int N, int K_, int G_, int c_) { A = (const char*)A_; Bt = (const char*)Bt_; K = K_; nM = M / BM; nN = N / BM; nwg = nM * nN; G = G_; c = c_; }
    __device__ __forceinline__ bool next(int i, Unit& u) const {
        const long L = (long)i * G + c; if (L >= nwg) return false;
        int wgid = (int)L; { const int q = nwg / 8, r = nwg % 8, xcd = wgid % 8, off = wgid / 8; wgid = (xcd < r ? xcd * (q + 1) : r * (q + 1) + (xcd - r) * q) + off; }
        const int nig = 8 * nN, gid = wgid / nig, fm = gid * 8, gsz = (nM - fm) < 8 ? (nM - fm) : 8;
        const int pm = fm + ((wgid % nig) % gsz); u.pn = (wgid % nig) / gsz; u.rowbase = pm * BM; u.e = 0; u.posbase = 0; u.cnt = 0; return true;
    }
    __device__ __forceinline__ const char* Abase(const Unit& u) const { return A + (size_t)u.rowbase * K * 2; }
    __device__ __forceinline__ const char* Bbase(const Unit& u) const { return Bt + (size_t)u.pn * BM * K * 2; }
    __device__ __forceinline__ unsigned aoff(const Unit&, int half, int R, int C) const { return (unsigned)((half * HALF + R) * K + C) * 2u; }
};
template <bool GATHER>
struct MoeSched {
    const char* A; const char* Bt; int K; const int* lists; const LAS int* TS; const LAS int* CN; int G, c;
    __device__ __forceinline__ bool next(int i, Unit& u) const {
        const int L = i * G + c; const int TT = __builtin_amdgcn_readfirstlane(TS[32]);
        if (L >= TT * 4) return false;
        const int mt = L >> 2; int e = 0;
        while (e < 31 && __builtin_amdgcn_readfirstlane(TS[e + 1]) <= mt) ++e;
        u.e = e; u.rowbase = mt * BM; u.pn = L & 3; u.posbase = (mt - __builtin_amdgcn_readfirstlane(TS[e])) * BM; u.cnt = __builtin_amdgcn_readfirstlane(CN[e]); return true;
    }
    __device__ __forceinline__ const char* Abase(const Unit& u) const { return GATHER ? A : A + (size_t)u.rowbase * K * 2; }
    __device__ __forceinline__ const char* Bbase(const Unit& u) const { return Bt + ((size_t)u.e * 1024 + (size_t)u.pn * BM) * K * 2; }
    __device__ __forceinline__ unsigned aoff(const Unit& u, int half, int R, int C) const {
        if (GATHER) { const int pos = u.posbase + half * HALF + R; const int tok = pos < u.cnt ? lists[u.e * LCAP + pos] : 0; return (unsigned)(tok * K + C) * 2u; }
        return (unsigned)((half * HALF + R) * K + C) * 2u;
    }
};
}

typedef f32x4 AccT[2][2][4][2];
struct EpiInProj {
    static constexpr bool PERM = true;
    bf16 *QG, *KG, *VG, *GG, *QN, *KN, *VN; const float *qnw, *knw;
    __device__ __forceinline__ void operator()(const AccT& acc, const pg8::Unit& u, int wr, int wc, int fr, int fq) const {
        const int pn = u.pn; const int row0 = u.rowbase + wr * 64 + fr;
        if (pn >= 6 && pn < 10) {
            const bool isq = pn < 8; bf16* O = isq ? QN : KN; const float* nw = isq ? qnw : knw; const float sc = isq ? 0.125f : 1.0f;
            f32x4 w[2][2];
#pragma unroll
            for (int bj = 0; bj < 2; ++bj)
#pragma unroll
                for (int n = 0; n < 2; ++n) w[bj][n] = *(const f32x4*)(nw + 32 * bj + 8 * fq + 4 * n) * sc;
#pragma unroll
            for (int ai = 0; ai < 2; ++ai)
#pragma unroll
                for (int m = 0; m < 4; ++m) {
                    float ss = 0.f;
#pragma unroll
                    for (int bj = 0; bj < 2; ++bj)
#pragma unroll
                        for (int n = 0; n < 2; ++n) { const f32x4 v = acc[ai][bj][m][n]; ss += (v[0] * v[0] + v[1] * v[1]) + (v[2] * v[2] + v[3] * v[3]); }
                    ss += __shfl_xor(ss, 16); ss += __shfl_xor(ss, 32);
                    const float rstd = 1.0f / sqrtf(ss * (1.0f / 64.0f) + EPS);
                    bf16* rowp = O + (size_t)(row0 + ai * 128 + m * 16) * 512 + ((pn & 1) * 4 + wc) * 64 + 8 * fq;
#pragma unroll
                    for (int bj = 0; bj < 2; ++bj) { const f32x4 v0 = acc[ai][bj][m][0] * rstd * w[bj][0], v1 = acc[ai][bj][m][1] * rstd * w[bj][1];
                        u32x4 o; o.x = cvt_pk_bf16(v0[0], v0[1]); o.y = cvt_pk_bf16(v0[2], v0[3]); o.z = cvt_pk_bf16(v1[0], v1[1]); o.w = cvt_pk_bf16(v1[2], v1[3]);
                        *(u32x4*)(rowp + bj * 32) = o; }
                }
        } else {
            bf16* O; int ldc, colt; float sc = 1.0f;
            if (pn == 0) { O = QG; ldc = 256; colt = 0; sc = 0.125f; }
            else if (pn == 1) { O = KG; ldc = 256; colt = 0; }
            else if (pn < 4) { O = VG; ldc = 512; colt = (pn - 2) * 256; }
            else if (pn < 6) { O = GG; ldc = 512; colt = (pn - 4) * 256; }
            else { O = VN; ldc = 512; colt = (pn - 10) * 256; }
            const int col0 = colt + wc * 32 + 8 * fq;
#pragma unroll
            for (int ai = 0; ai < 2; ++ai)
#pragma unroll
                for (int m = 0; m < 4; ++m) { bf16* rowp = O + (size_t)(row0 + ai * 128 + m * 16) * ldc + col0;
#pragma unroll
                    for (int bj = 0; bj < 2; ++bj) { const f32x4 v0 = acc[ai][bj][m][0] * sc, v1 = acc[ai][bj][m][1] * sc;
                        u32x4 o; o.x = cvt_pk_bf16(v0[0], v0[1]); o.y = cvt_pk_bf16(v0[2], v0[3]); o.z = cvt_pk_bf16(v1[0], v1[1]); o.w = cvt_pk_bf16(v1[2], v1[3]);
                        *(u32x4*)(rowp + bj * 128) = o; } }
        }
    }
};
struct EpiResid {
    static constexpr bool PERM = false;
    const float* base; float* X; const float* g1;
    __device__ __forceinline__ void operator()(const AccT& acc, const pg8::Unit& u, int wr, int wc, int fr, int fq) const {
        const int row0 = u.rowbase + wr * 64 + fr, col0 = u.pn * 256 + wc * 32 + 4 * fq; const int b = u.rowbase >> 12;
        f32x4 g[2][2];
#pragma unroll
        for (int bj = 0; bj < 2; ++bj)
#pragma unroll
            for (int n = 0; n < 2; ++n) g[bj][n] = *(const f32x4*)(g1 + (size_t)b * MODW + col0 + bj * 128 + n * 16);
#pragma unroll
        for (int ai = 0; ai < 2; ++ai)
#pragma unroll
            for (int m = 0; m < 4; ++m) { const size_t off = (size_t)(row0 + ai * 128 + m * 16) * D + col0;
#pragma unroll
                for (int bj = 0; bj < 2; ++bj)
#pragma unroll
                    for (int n = 0; n < 2; ++n) { const f32x4 bs = *(const f32x4*)(base + off + bj * 128 + n * 16);
                        *(f32x4*)(X + off + bj * 128 + n * 16) = bs + g[bj][n] * acc[ai][bj][m][n]; } }
    }
};
struct EpiSwiGLU {
    static constexpr bool PERM = true;
    bf16* H;
    __device__ __forceinline__ void operator()(const AccT& acc, const pg8::Unit& u, int wr, int wc, int fr, int fq) const {
        const int row0 = u.rowbase + wr * 64 + fr, col0 = u.pn * 128 + wc * 32 + 8 * fq;
#pragma unroll
        for (int ai = 0; ai < 2; ++ai)
#pragma unroll
            for (int m = 0; m < 4; ++m) { bf16* rowp = H + (size_t)(row0 + ai * 128 + m * 16) * DE + col0;
                float r[8];
#pragma unroll
                for (int n = 0; n < 2; ++n)
#pragma unroll
                    for (int i = 0; i < 4; ++i) { const float a = acc[ai][0][m][n][i], b = acc[ai][1][m][n][i]; r[n * 4 + i] = a * sigmoidf_(a) * b; }
                u32x4 o; o.x = cvt_pk_bf16(r[0], r[1]); o.y = cvt_pk_bf16(r[2], r[3]); o.z = cvt_pk_bf16(r[4], r[5]); o.w = cvt_pk_bf16(r[6], r[7]);
                *(u32x4*)rowp = o; }
    }
};
struct EpiY {
    static constexpr bool PERM = true;
    bf16* Y;
    __device__ __forceinline__ void operator()(const AccT& acc, const pg8::Unit& u, int wr, int wc, int fr, int fq) const {
        const int row0 = u.rowbase + wr * 64 + fr, col0 = u.pn * 256 + wc * 32 + 8 * fq;
#pragma unroll
        for (int ai = 0; ai < 2; ++ai)
#pragma unroll
            for (int m = 0; m < 4; ++m) { bf16* rowp = Y + (size_t)(row0 + ai * 128 + m * 16) * D + col0;
#pragma unroll
                for (int bj = 0; bj < 2; ++bj) { const f32x4 v0 = acc[ai][bj][m][0], v1 = acc[ai][bj][m][1];
                    u32x4 o; o.x = cvt_pk_bf16(v0[0], v0[1]); o.y = cvt_pk_bf16(v0[2], v0[3]); o.z = cvt_pk_bf16(v1[0], v1[1]); o.w = cvt_pk_bf16(v1[2], v1[3]);
                    *(u32x4*)(rowp + bj * 128) = o; } }
    }
};

#define XB_TMO      128
#define XB_XCNT(j)  (256  + 64 * (j))
#define XB_XSUB(j)  (1280 + 64 * (j))
#define XB_XGEN(j)  (2304 + 64 * (j))
#define XB_TOP      3328
#define XB_TOPGEN   3392
#define XCD_BAR_WORDS 3456
#define XB_SPIN_CAP (1u << 18)
__device__ __forceinline__ unsigned xb_ld(unsigned* p)              { return __hip_atomic_load(p, __ATOMIC_RELAXED, __HIP_MEMORY_SCOPE_AGENT); }
__device__ __forceinline__ unsigned xb_add(unsigned* p, unsigned v) { return __hip_atomic_fetch_add(p, v, __ATOMIC_RELAXED, __HIP_MEMORY_SCOPE_AGENT); }
__device__ __forceinline__ unsigned xb_xcc_id() { return (unsigned)__builtin_amdgcn_s_getreg((3 << 11) | 20) & 0xFu; }
#define XB_SPIN(cond, bar) do { unsigned _sp = 0; while (cond) { __builtin_amdgcn_s_sleep(1); \
    if ((++_sp & 255u) == 0u) { if (xb_ld(&(bar)[XB_TMO])) break; if (_sp > XB_SPIN_CAP) { atomicAdd(&(bar)[XB_TMO], 1u); break; } } } } while (0)
struct XcdBarrier { unsigned* bar; unsigned x; volatile LAS unsigned* st; };
__device__ __forceinline__ XcdBarrier xcd_barrier_post(unsigned* bar, volatile LAS unsigned* st) {
    XcdBarrier b; b.bar = bar; b.x = xb_xcc_id(); b.st = st;
    if (threadIdx.x == 0) (void)xb_add(&bar[XB_XCNT(b.x)], 1u);
    return b;
}
__device__ __forceinline__ void xcd_barrier_complete(unsigned* bar, unsigned x, unsigned& nloc, unsigned& nx) {
    const unsigned G = gridDim.x * gridDim.y * gridDim.z;
    unsigned sum, cnt, mine, sp = 0u;
    for (;;) {
        sum = 0u; cnt = 0u; mine = 0u;
#pragma unroll
        for (unsigned j = 0; j < 16; ++j) { const unsigned c = xb_ld(&bar[XB_XCNT(j)]); sum += c; cnt += (c > 0u) ? 1u : 0u; mine = (j == x) ? c : mine; }
        if (sum == G) break;
        __builtin_amdgcn_s_sleep(1);
        if ((++sp & 255u) == 0u) { if (xb_ld(&bar[XB_TMO])) break; if (sp > XB_SPIN_CAP) { atomicAdd(&bar[XB_TMO], 1u); break; } }
    }
    nloc = mine > 0u ? mine : 1u; nx = cnt > 0u ? cnt : 1u;
}
__device__ __forceinline__ void xcd_barrier(const XcdBarrier& b) {
    asm volatile("s_waitcnt vmcnt(0)" ::: "memory");
    __syncthreads();
    if (threadIdx.x == 0) {
        unsigned* bar = b.bar;
        __builtin_amdgcn_s_waitcnt(0);
        unsigned nloc = b.st[0], nx = b.st[1];
        if (nloc == 0u) { xcd_barrier_complete(bar, b.x, nloc, nx); b.st[0] = nloc; b.st[1] = nx; }
        const unsigned old = xb_add(&bar[XB_XSUB(b.x)], 1u);
        const unsigned gen = old / nloc;
        if (old + 1u == (gen + 1u) * nloc) {
            __builtin_amdgcn_fence(__ATOMIC_RELEASE, "agent");
            asm volatile("s_waitcnt vmcnt(0)" ::: "memory");
            const unsigned og = xb_add(&bar[XB_TOP], 1u);
            const unsigned tg = og / nx;
            if (og + 1u == (tg + 1u) * nx) xb_add(&bar[XB_TOPGEN], 1u);
            else XB_SPIN(xb_ld(&bar[XB_TOPGEN]) == tg, bar);
            __builtin_amdgcn_fence(__ATOMIC_ACQUIRE, "agent");
            xb_add(&bar[XB_XGEN(b.x)], 1u);
            asm volatile("s_waitcnt vmcnt(0)" ::: "memory");
        } else {
            XB_SPIN(xb_ld(&bar[XB_XGEN(b.x)]) == gen, bar);
            __builtin_amdgcn_fence(__ATOMIC_ACQUIRE, "agent");
            asm volatile("s_waitcnt vmcnt(0)" ::: "memory");
        }
    }
    __syncthreads();
}

__device__ __forceinline__ void transpose_item(const float* W, int K, int N, bf16* WT, int drow0, int k0, int n0, LAS float* scr, int lane) {
#pragma unroll 8
    for (int i = 0; i < 32; ++i) { const int kk = 2 * i + (lane >> 5); scr[kk * 33 + (lane & 31)] = W[(size_t)(k0 + kk) * N + n0 + (lane & 31)]; }
    asm volatile("s_waitcnt lgkmcnt(0)" ::: "memory");
    const int c = lane & 7;
#pragma unroll
    for (int j = 0; j < 4; ++j) { const int n = (lane >> 3) + 8 * j; const LAS float* s = scr + (8 * c) * 33 + n;
        u32x4 o; o.x = pk2(s[0 * 33], s[1 * 33]); o.y = pk2(s[2 * 33], s[3 * 33]); o.z = pk2(s[4 * 33], s[5 * 33]); o.w = pk2(s[6 * 33], s[7 * 33]);
        *(u32x4*)(WT + (size_t)(drow0 + n) * K + k0 + 8 * c) = o; }
    asm volatile("s_waitcnt lgkmcnt(0)" ::: "memory");
}
__device__ __forceinline__ void phase_p0(const Ctx& F) {
    {
        LAS float* cact = (LAS float*)F.lds;
        LAS float* part = (LAS float*)(F.lds + 16384);
        for (int i = F.tid; i < NB * D; i += 512) { const int b = i >> 10, k = i & 1023; const float cv = F.c[i]; cact[k * 4 + b] = cv * sigmoidf_(cv); }
        __syncthreads();
        for (int item = F.vcu; item < 192; item += F.G) {
            const int l = item / 96, n0 = (item % 96) * 64;
            const float* W = F.w_ada + (size_t)l * D * MODW + n0 + F.lane;
            float a0 = 0.f, a1 = 0.f, a2 = 0.f, a3 = 0.f; const int k0 = F.wave * 128;
#pragma unroll 8
            for (int k = 0; k < 128; ++k) { const float w = W[(size_t)(k0 + k) * MODW]; const f32x4 cv = *(const LAS f32x4*)(cact + (k0 + k) * 4);
                a0 += cv[0] * w; a1 += cv[1] * w; a2 += cv[2] * w; a3 += cv[3] * w; }
            part[(F.wave * 4 + 0) * 64 + F.lane] = a0; part[(F.wave * 4 + 1) * 64 + F.lane] = a1; part[(F.wave * 4 + 2) * 64 + F.lane] = a2; part[(F.wave * 4 + 3) * 64 + F.lane] = a3;
            __syncthreads();
            if (F.tid < 256) { const int b = F.tid >> 6, ln = F.tid & 63; float s = 0.f;
#pragma unroll
                for (int w = 0; w < 8; ++w) s += part[(w * 4 + b) * 64 + ln];
                F.mod[(size_t)(l * 4 + b) * MODW + n0 + ln] = s + F.b_ada[l * MODW + n0 + ln]; }
            __syncthreads();
        }
    }
    {
        LAS float* scr = (LAS float*)(F.lds + 32768 + F.wave * 10240);
        const int gw = F.vcu * 8 + F.wave, NGW = F.G * 8;
        constexpr int I_IN = 2 * 16 * 97, I_OUT = 2 * 16 * 32, I_W1 = 2 * 32 * 256, I_W2 = 2 * 32 * 256;
        constexpr int NITEMS = I_IN + I_OUT + 2 * I_W1 + I_W2;
        for (int it = gw; it < NITEMS; it += NGW) {
            int r = it;
            if (r < I_IN) {
                const int l = r / 1552, q = r % 1552, kb = q / 97, nb = q % 97; if (nb == 48) continue;
                const int n0 = 32 * nb; int drow0;
                if (n0 < 1536) drow0 = n0;
                else { const int np = n0 - 32, t = np >> 8, cl = np & 255;
                    if (t >= 6 && t < 10) { const int hh = cl >> 6, d0 = cl & 63; drow0 = t * 256 + (d0 >> 5) * 128 + hh * 32; } else drow0 = np; }
                transpose_item(F.w_in + (size_t)l * D * INW, D, INW, F.win_t + (size_t)l * NPROJ * D, drow0, kb * 64, n0, scr, F.lane); continue; }
            r -= I_IN;
            if (r < I_OUT) { const int l = r / 512, q = r % 512, kb = q / 32, nb = q % 32;
                transpose_item(F.w_out + (size_t)l * D * D, D, D, F.wout_t + (size_t)l * D * D, 32 * nb, kb * 64, 32 * nb, scr, F.lane); continue; }
            r -= I_OUT;
            if (r < 2 * I_W1) { const int which = r / I_W1; const int q = r % I_W1; const int le = q / 256, qq = q % 256, kb = qq / 16, nb = qq % 16; const int n0 = 32 * nb;
                const float* src = (which ? F.w3 : F.w1) + (size_t)le * D * DE;
                transpose_item(src, D, DE, F.w13_t + (size_t)le * 1024 * D, (n0 >> 7) * 256 + which * 128 + (n0 & 127), kb * 64, n0, scr, F.lane); continue; }
            r -= 2 * I_W1;
            { const int le = r / 256, qq = r % 256, kb = qq / 32, nb = qq % 32;
              transpose_item(F.w2 + (size_t)le * DE * D, DE, D, F.w2_t + (size_t)le * D * DE, 32 * nb, kb * 64, 32 * nb, scr, F.lane); }
        }
    }
}

__device__ __forceinline__ void moe_tables(const Ctx& F, int lp) {
    LAS int* TS = (LAS int*)(F.lds + TAB_OFF); LAS int* CN = TS + 40;
    if (F.tid == 0) { int acc = 0;
        for (int e = 0; e < NE; ++e) { const int c = (int)__hip_atomic_load((unsigned*)(F.ctl + CW_CNT + (lp * 32 + e) * 64), RLX_AGENT); CN[e] = c; TS[e] = acc; acc += (c + 255) >> 8; }
        TS[32] = acc; }
    __syncthreads();
}

template <int MODE>
__device__ __forceinline__ void prepass(const Ctx& F, int l) {
    LAS float* tile = (LAS float*)F.lds;
    LAS float* part = (LAS float*)(F.lds + 65536);
    LAS float* scl = (LAS float*)(F.lds + 98304);
    LAS float* sel = scl + 512;
    const LAS int* TS = (const LAS int*)(F.lds + TAB_OFF);
    const bool comb = (MODE == 2) || (MODE == 0 && l > 0);
    const int lp = (MODE == 2) ? DEPTH - 1 : l - 1;
    if (comb) moe_tables(F, lp);
    const int e = F.tid & 31, kg = F.tid >> 5;
    float rw[64];
    if (MODE != 2) {
        const float* W32 = (MODE == 0) ? F.w_in + (size_t)l * D * INW + 1536 : F.router_w; const int wst = (MODE == 0) ? INW : 32;
#pragma unroll
        for (int i = 0; i < 64; ++i) rw[i] = W32[(size_t)(kg * 64 + i) * wst + e];
    }
    const float* nw = ((MODE == 0) ? F.attn_norm : F.ffn_norm) + l * D;
    for (int grp = F.vcu; grp < NTOK / 16; grp += F.G) {
        for (int tt = 0; tt < 2; ++tt) {
            const int m = grp * 16 + F.wave * 2 + tt; const int b = m >> 12;
            const float* src = (MODE == 0 && l == 0) ? F.x_in : F.X;
            f32x4 v[4];
#pragma unroll
            for (int j = 0; j < 4; ++j) v[j] = *(const f32x4*)(src + (size_t)m * D + 256 * j + 4 * F.lane);
            if (comb) {
                const unsigned* ti = F.tokinfo + (size_t)m * 8;
                const unsigned e0 = ti[0], p0 = ti[1], e1 = ti[2], p1 = ti[3]; const float gw0 = __builtin_bit_cast(float, ti[4]), gw1 = __builtin_bit_cast(float, ti[5]);
                const size_t s0 = (size_t)TS[e0] * 256 + p0, s1 = (size_t)TS[e1] * 256 + p1;
                const float* g2 = F.mod + (size_t)(lp * 4 + b) * MODW + 5 * D;
                float* dst = (MODE == 2) ? F.out : F.X;
#pragma unroll
                for (int j = 0; j < 4; ++j) {
                    const u32x2 y0 = *(const u32x2*)(F.Y + s0 * D + 256 * j + 4 * F.lane), y1 = *(const u32x2*)(F.Y + s1 * D + 256 * j + 4 * F.lane);
                    const f32x4 g = *(const f32x4*)(g2 + 256 * j + 4 * F.lane);
                    v[j][0] += g[0] * (gw0 * bf_lo(y0.x) + gw1 * bf_lo(y1.x)); v[j][1] += g[1] * (gw0 * bf_hi(y0.x) + gw1 * bf_hi(y1.x));
                    v[j][2] += g[2] * (gw0 * bf_lo(y0.y) + gw1 * bf_lo(y1.y)); v[j][3] += g[3] * (gw0 * bf_hi(y0.y) + gw1 * bf_hi(y1.y));
                    *(f32x4*)(dst + (size_t)m * D + 256 * j + 4 * F.lane) = v[j];
                }
            }
            if (MODE != 2) {
                float ss = 0.f;
#pragma unroll
                for (int j = 0; j < 4; ++j) ss += (v[j][0] * v[j][0] + v[j][1] * v[j][1]) + (v[j][2] * v[j][2] + v[j][3] * v[j][3]);
                const float rstd = 1.0f / sqrtf(wave_sum(ss) * (1.0f / D) + EPS);
                const float* scp = F.mod + (size_t)(l * 4 + b) * MODW + ((MODE == 0) ? 1 : 4) * D;
                const float* shp = F.mod + (size_t)(l * 4 + b) * MODW + ((MODE == 0) ? 0 : 3) * D;
#pragma unroll
                for (int j = 0; j < 4; ++j) {
                    const int k = 256 * j + 4 * F.lane;
                    const f32x4 w = *(const f32x4*)(nw + k), sc = *(const f32x4*)(scp + k), sh = *(const f32x4*)(shp + k);
                    f32x4 h;
#pragma unroll
                    for (int i = 0; i < 4; ++i) h[i] = (v[j][i] * rstd) * w[i] * (1.0f + sc[i]) + sh[i];
                    u32x2 o; o.x = pk2(h[0], h[1]); o.y = pk2(h[2], h[3]);
                    *(u32x2*)(F.XN + (size_t)m * D + k) = o;
                    *(LAS f32x4*)(tile + (F.wave * 2 + tt) * 1024 + k) = h;
                }
            }
        }
        if (MODE != 2) {
            __syncthreads();
            for (int tok = 0; tok < 16; ++tok) {
                float p = 0.f;
#pragma unroll
                for (int i4 = 0; i4 < 16; ++i4) { const f32x4 hv = *(const LAS f32x4*)(tile + tok * 1024 + kg * 64 + i4 * 4);
                    p += hv[0] * rw[4 * i4] + hv[1] * rw[4 * i4 + 1] + hv[2] * rw[4 * i4 + 2] + hv[3] * rw[4 * i4 + 3]; }
                part[(tok * 16 + kg) * 32 + e] = p;
            }
            __syncthreads();
            {
                const int tok = F.tid >> 5; const int m = grp * 16 + tok; float logit = 0.f;
#pragma unroll
                for (int g = 0; g < 16; ++g) logit += part[(tok * 16 + g) * 32 + e];
                if (MODE == 0) F.lfb[(size_t)m * 32 + e] = logit;
                else {
                    const float s = 1.0f / (1.0f + expf(-logit));
                    scl[tok * 32 + e] = s; sel[tok * 32 + e] = s + F.router_b[e];
                    __syncthreads();
                    if (e == 0) {
                        const LAS float* sv = sel + tok * 32;
                        float gbest = -3.0e38f; int best = 0;
                        for (int g = 0; g < 4; ++g) { float m1 = -3.0e38f, m2 = -3.0e38f;
                            for (int i = 0; i < 8; ++i) { const float x = sv[g * 8 + i]; if (x > m1) { m2 = m1; m1 = x; } else if (x > m2) m2 = x; }
                            const float gs = m1 + m2; if (gs > gbest) { gbest = gs; best = g; } }
                        int i1 = 0; float v1 = sv[best * 8];
                        for (int i = 1; i < 8; ++i) { const float x = sv[best * 8 + i]; if (x > v1) { v1 = x; i1 = i; } }
                        int i2 = -1; float v2 = -3.0e38f;
                        for (int i = 0; i < 8; ++i) { const float x = sv[best * 8 + i]; if (i != i1 && x > v2) { v2 = x; i2 = i; } }
                        const int e0 = best * 8 + i1, e1 = best * 8 + i2;
                        float gw0 = scl[tok * 32 + e0], gw1 = scl[tok * 32 + e1]; const float gsum = gw0 + gw1; gw0 /= gsum; gw1 /= gsum;
                        const unsigned p0 = __hip_atomic_fetch_add((unsigned*)(F.ctl + CW_CNT + (l * 32 + e0) * 64), 1u, RLX_AGENT);
                        const unsigned p1 = __hip_atomic_fetch_add((unsigned*)(F.ctl + CW_CNT + (l * 32 + e1) * 64), 1u, RLX_AGENT);
                        F.lists[e0 * LCAP + p0] = m; F.lists[e1 * LCAP + p1] = m;
                        unsigned* ti = F.tokinfo + (size_t)m * 8;
                        ti[0] = (unsigned)e0; ti[1] = p0; ti[2] = (unsigned)e1; ti[3] = p1; ti[4] = __builtin_bit_cast(unsigned, gw0); ti[5] = __builtin_bit_cast(unsigned, gw1);
                    }
                }
            }
            __syncthreads();
        }
    }
}

__device__ __forceinline__ void gla_front(const Ctx& F, int l, int h, int m0, LAS float* BF, LAS float* BR, LAS float* LFBT, LAS float* GWT, LAS float* GBT) {
    { const int tok = F.tid >> 3, c4 = F.tid & 7; *(LAS f32x4*)(LFBT + tok * 32 + c4 * 4) = *(const f32x4*)(F.lfb + (size_t)(m0 + tok) * 32 + c4 * 4); }
#pragma unroll
    for (int k = 0; k < 4; ++k) { const int idx = F.tid + 512 * k; const int dir = idx >> 10, r = (idx >> 6) & 15, d = idx & 63;
        GWT[idx] = F.gate_w[(size_t)((l * 2 + dir) * 16 + r) * 256 + h * 64 + d]; }
    if (F.tid < 128) { const int dir = F.tid >> 6, d = F.tid & 63; GBT[F.tid] = F.gate_b[(l * 2 + dir) * 256 + h * 64 + d]; }
    __syncthreads();
    for (int k = 0; k < 16; ++k) { const int idx = F.tid + 512 * k; const int dir = idx >> 12, i = (idx >> 6) & 63, d = idx & 63;
        float z = GBT[dir * 64 + d];
#pragma unroll
        for (int r = 0; r < 16; ++r) z += LFBT[i * 32 + dir * 16 + r] * GWT[(dir * 16 + r) * 64 + d];
        const float la = logsigf_(z) * (1.0f / 16.0f);
        (dir ? BR : BF)[i * 64 + d] = la; }
    __syncthreads();
    if (F.tid < 64) { const int d = F.tid; float run = 0.f; for (int i = 0; i < 64; ++i) { run += BF[i * 64 + d]; BF[i * 64 + d] = run; } }
    else if (F.tid < 128) { const int d = F.tid - 64; float run = 0.f; for (int i = 63; i >= 0; --i) { run += BR[i * 64 + d]; BR[i * 64 + d] = run; } }
    __syncthreads();
}
__device__ __forceinline__ void gla_a_item(const Ctx& F, int l, int it) {
    const int b = it >> 8, h = (it >> 6) & 3, c = it & 63, bh = b * 4 + h, m0 = b * T + c * 64;
    LAS float* BF = (LAS float*)F.lds; LAS float* BR = (LAS float*)(F.lds + 16384);
    LAS float* LFBT = (LAS float*)(F.lds + 32768); LAS float* GWT = (LAS float*)(F.lds + 40960); LAS float* GBT = (LAS float*)(F.lds + 49152);
    LAS bf16* KRAW = (LAS bf16*)(F.lds + 49664); LAS bf16* VRAW = (LAS bf16*)(F.lds + 57856);
    LAS float* KF = (LAS float*)(F.lds + 74240); LAS float* KB = (LAS float*)(F.lds + 90624);
    { const int tok = F.tid >> 3, ch = F.tid & 7; *(LAS u32x4*)(KRAW + tok * 64 + ch * 8) = *(const u32x4*)(F.KG + (size_t)(m0 + tok) * 256 + h * 64 + ch * 8); }
#pragma unroll
    for (int k = 0; k < 2; ++k) { const int idx = F.tid + 512 * k; const int tok = idx >> 4, ch = idx & 15;
        *(LAS u32x4*)(VRAW + tok * 128 + ch * 8) = *(const u32x4*)(F.VG + (size_t)(m0 + tok) * 512 + h * 128 + ch * 8); }
    gla_front(F, l, h, m0, BF, BR, LFBT, GWT, GBT);
#pragma unroll
    for (int k = 0; k < 8; ++k) { const int idx = F.tid + 512 * k; const int j = idx >> 6, d = idx & 63; const float kv = bf2f(KRAW[idx]);
        KF[idx] = kv * expf(BF[63 * 64 + d] - BF[j * 64 + d]); KB[idx] = kv * expf(BR[d] - BR[j * 64 + d]); }
    if (F.tid < 128) { const int dir = F.tid >> 6, d = F.tid & 63; F.gdec[(size_t)((bh * 2 + dir) * 64 + c) * 64 + d] = expf(dir ? BR[d] : BF[63 * 64 + d]); }
    __syncthreads();
    {
        const int dir = F.tid >> 8, tt = F.tid & 255, db = tt >> 4, eb = tt & 15;
        const LAS float* src = dir ? KB : KF;
        float acc[4][8];
#pragma unroll
        for (int a = 0; a < 4; ++a)
#pragma unroll
            for (int q = 0; q < 8; ++q) acc[a][q] = 0.f;
        for (int j = 0; j < 64; ++j) {
            const f32x4 kd = *(const LAS f32x4*)(src + j * 64 + db * 4); const u32x4 vv = *(const LAS u32x4*)(VRAW + j * 128 + eb * 8);
            float ve[8]; ve[0] = bf_lo(vv.x); ve[1] = bf_hi(vv.x); ve[2] = bf_lo(vv.y); ve[3] = bf_hi(vv.y); ve[4] = bf_lo(vv.z); ve[5] = bf_hi(vv.z); ve[6] = bf_lo(vv.w); ve[7] = bf_hi(vv.w);
#pragma unroll
            for (int a = 0; a < 4; ++a)
#pragma unroll
                for (int q = 0; q < 8; ++q) acc[a][q] += kd[a] * ve[q];
        }
        float* Ub = F.U + ((size_t)((bh * 2 + dir) * 64 + c) * 64) * 128;
#pragma unroll
        for (int a = 0; a < 4; ++a) { float* p = Ub + (size_t)(db * 4 + a) * 128 + eb * 8;
            *(f32x4*)p = (f32x4){acc[a][0], acc[a][1], acc[a][2], acc[a][3]}; *(f32x4*)(p + 4) = (f32x4){acc[a][4], acc[a][5], acc[a][6], acc[a][7]}; }
    }
    __syncthreads();
}
__device__ __forceinline__ void gla_b(const Ctx& F) {
    for (int id = F.vcu * 512 + F.tid; id < 32 * 2048; id += F.G * 512) {
        const int s = id >> 11, q4 = id & 2047, d = q4 >> 5, dir = s & 1;
        float* base = F.U + (size_t)s * 64 * 8192 + 4 * q4; const float* gd = F.gdec + (size_t)s * 64 * 64 + d;
        f32x4 S = (f32x4){0.f, 0.f, 0.f, 0.f};
#pragma unroll 8
        for (int step = 0; step < 64; ++step) { const int c = dir ? 63 - step : step;
            const f32x4 u = *(const f32x4*)(base + (size_t)c * 8192); const float g = gd[c * 64];
            *(f32x4*)(base + (size_t)c * 8192) = S; S = S * g + u; }
    }
}
__device__ __forceinline__ void gla_c_item(const Ctx& F, int l, int it) {
    const int b = it >> 8, h = (it >> 6) & 3, c = it & 63, bh = b * 4 + h, m0 = b * T + c * 64;
    LAS float* BF = (LAS float*)F.lds; LAS float* BR = (LAS float*)(F.lds + 17408); LAS float* P = BF;
    LAS float* LFBT = (LAS float*)(F.lds + 34816); LAS float* GWT = (LAS float*)(F.lds + 43008); LAS float* GBT = (LAS float*)(F.lds + 51200);
    LAS float* QF = (LAS float*)(F.lds + 51712); LAS float* QB = (LAS float*)(F.lds + 69120); LAS float* KF = (LAS float*)(F.lds + 86528); LAS float* KB = (LAS float*)(F.lds + 103936);
    LAS float* SST = KF;
    LAS bf16* VRAW = (LAS bf16*)(F.lds + 121344);
#pragma unroll
    for (int k = 0; k < 2; ++k) { const int idx = F.tid + 512 * k; const int tok = idx >> 4, ch = idx & 15;
        *(LAS u32x4*)(VRAW + tok * 128 + ch * 8) = *(const u32x4*)(F.VG + (size_t)(m0 + tok) * 512 + h * 128 + ch * 8); }
    gla_front(F, l, h, m0, BF, BR, LFBT, GWT, GBT);
#pragma unroll
    for (int k = 0; k < 8; ++k) { const int idx = F.tid + 512 * k; const int i = idx >> 6, d = idx & 63;
        const float qv = bf2f(F.QG[(size_t)(m0 + i) * 256 + h * 64 + d]), kv = bf2f(F.KG[(size_t)(m0 + i) * 256 + h * 64 + d]);
        const float bfv = BF[idx], brv = BR[idx];
        QF[i * 68 + d] = qv * expf(bfv); KF[i * 68 + d] = kv * expf(-bfv); QB[i * 68 + d] = qv * expf(brv); KB[i * 68 + d] = kv * expf(-brv); }
    __syncthreads();
    {
        float pf[8], pb[8];
#pragma unroll
        for (int ii = 0; ii < 8; ++ii) { pf[ii] = 0.f; pb[ii] = 0.f; }
        for (int d4 = 0; d4 < 16; ++d4) {
            const f32x4 kf4 = *(const LAS f32x4*)(KF + F.lane * 68 + d4 * 4), kb4 = *(const LAS f32x4*)(KB + F.lane * 68 + d4 * 4);
#pragma unroll
            for (int ii = 0; ii < 8; ++ii) { const f32x4 qf4 = *(const LAS f32x4*)(QF + (F.wave * 8 + ii) * 68 + d4 * 4), qb4 = *(const LAS f32x4*)(QB + (F.wave * 8 + ii) * 68 + d4 * 4);
                pf[ii] += (qf4[0] * kf4[0] + qf4[1] * kf4[1]) + (qf4[2] * kf4[2] + qf4[3] * kf4[3]);
                pb[ii] += (qb4[0] * kb4[0] + qb4[1] * kb4[1]) + (qb4[2] * kb4[2] + qb4[3] * kb4[3]); }
        }
        __syncthreads();
#pragma unroll
        for (int ii = 0; ii < 8; ++ii) { const int i = F.wave * 8 + ii; P[i * 68 + F.lane] = (F.lane <= i) ? pf[ii] : pb[ii]; }
    }
    __syncthreads();
    const int ib = F.tid >> 5, e4 = F.tid & 31;
    f32x4 acc[4];
#pragma unroll
    for (int ii = 0; ii < 4; ++ii) acc[ii] = (f32x4){0.f, 0.f, 0.f, 0.f};
#pragma unroll
    for (int k = 0; k < 4; ++k) { const int idx = F.tid + 512 * k; *(LAS f32x4*)(SST + idx * 4) = *(const f32x4*)(F.U + ((size_t)((bh * 2 + 0) * 64 + c) * 8192) + idx * 4); }
    for (int j4 = 0; j4 < 16; ++j4) {
        f32x4 p4[4];
#pragma unroll
        for (int ii = 0; ii < 4; ++ii) p4[ii] = *(const LAS f32x4*)(P + (ib * 4 + ii) * 68 + j4 * 4);
#pragma unroll
        for (int jj = 0; jj < 4; ++jj) { const u32x2 vv = *(const LAS u32x2*)(VRAW + (j4 * 4 + jj) * 128 + e4 * 4);
            const f32x4 v4 = (f32x4){bf_lo(vv.x), bf_hi(vv.x), bf_lo(vv.y), bf_hi(vv.y)};
#pragma unroll
            for (int ii = 0; ii < 4; ++ii) acc[ii] += v4 * p4[ii][jj]; }
    }
    __syncthreads();
    for (int d4 = 0; d4 < 16; ++d4) {
        f32x4 q4[4];
#pragma unroll
        for (int ii = 0; ii < 4; ++ii) q4[ii] = *(const LAS f32x4*)(QF + (ib * 4 + ii) * 68 + d4 * 4);
#pragma unroll
        for (int dd = 0; dd < 4; ++dd) { const f32x4 s4 = *(const LAS f32x4*)(SST + (d4 * 4 + dd) * 128 + e4 * 4);
#pragma unroll
            for (int ii = 0; ii < 4; ++ii) acc[ii] += s4 * q4[ii][dd]; }
    }
    __syncthreads();
#pragma unroll
    for (int k = 0; k < 4; ++k) { const int idx = F.tid + 512 * k; *(LAS f32x4*)(SST + idx * 4) = *(const f32x4*)(F.U + ((size_t)((bh * 2 + 1) * 64 + c) * 8192) + idx * 4); }
    __syncthreads();
    for (int d4 = 0; d4 < 16; ++d4) {
        f32x4 q4[4];
#pragma unroll
        for (int ii = 0; ii < 4; ++ii) q4[ii] = *(const LAS f32x4*)(QB + (ib * 4 + ii) * 68 + d4 * 4);
#pragma unroll
        for (int dd = 0; dd < 4; ++dd) { const f32x4 s4 = *(const LAS f32x4*)(SST + (d4 * 4 + dd) * 128 + e4 * 4);
#pragma unroll
            for (int ii = 0; ii < 4; ++ii) acc[ii] += s4 * q4[ii][dd]; }
    }
    const f32x4 gn = *(const f32x4*)(F.gla_norm + l * 128 + e4 * 4);
#pragma unroll
    for (int ii = 0; ii < 4; ++ii) {
        float ss = (acc[ii][0] * acc[ii][0] + acc[ii][1] * acc[ii][1]) + (acc[ii][2] * acc[ii][2] + acc[ii][3] * acc[ii][3]);
        ss += __shfl_xor(ss, 1); ss += __shfl_xor(ss, 2); ss += __shfl_xor(ss, 4); ss += __shfl_xor(ss, 8); ss += __shfl_xor(ss, 16);
        const float rstd = 1.0f / sqrtf(ss * (1.0f / 128.0f) + EPS);
        const int m = m0 + ib * 4 + ii;
        const u32x2 gg = *(const u32x2*)(F.GG + (size_t)m * 512 + h * 128 + e4 * 4);
        const float g0 = bf_lo(gg.x), g1 = bf_hi(gg.x), g2 = bf_lo(gg.y), g3 = bf_hi(gg.y);
        const float o0 = acc[ii][0] * rstd * gn[0] * (g0 * sigmoidf_(g0)), o1 = acc[ii][1] * rstd * gn[1] * (g1 * sigmoidf_(g1));
        const float o2 = acc[ii][2] * rstd * gn[2] * (g2 * sigmoidf_(g2)), o3 = acc[ii][3] * rstd * gn[3] * (g3 * sigmoidf_(g3));
        u32x2 o; o.x = pk2(o0, o1); o.y = pk2(o2, o3);
        *(u32x2*)(F.XN + (size_t)m * D + h * 128 + e4 * 4) = o;
    }
    __syncthreads();
}

__device__ __forceinline__ void natten_item(const Ctx& F, int l, int it) {
    const int b = it >> 9, hh = (it >> 6) & 7, r = it & 63;
    const int rs = min(max(r - 4, 0), 56); const int tok0 = b * T + rs * 64;
    LAS bf16* KT = (LAS bf16*)F.lds; LAS bf16* VT = (LAS bf16*)(F.lds + 65536); LAS float* RPB = (LAS float*)(F.lds + 131072);
#pragma unroll
    for (int k = 0; k < 8; ++k) { const int idx = F.tid + 512 * k; const int kk = idx >> 3, ch = idx & 7;
        *(LAS u32x4*)(KT + kk * 64 + ch * 8) = *(const u32x4*)(F.KN + (size_t)(tok0 + kk) * 512 + hh * 64 + ch * 8);
        *(LAS u32x4*)(VT + kk * 64 + ch * 8) = *(const u32x4*)(F.VN + (size_t)(tok0 + kk) * 512 + hh * 64 + ch * 8); }
    if (F.tid < 465) RPB[F.tid] = F.rpb[(size_t)(l * 8 + hh) * 465 + F.tid];
    __syncthreads();
    const int i = F.tid >> 3, dc = F.tid & 7; const int m = b * T + r * 64 + i; const int cs = min(max(i - 8, 0), 48);
    float qf[8];
    { const u32x4 q8 = *(const u32x4*)(F.QN + (size_t)m * 512 + hh * 64 + dc * 8);
      qf[0] = bf_lo(q8.x); qf[1] = bf_hi(q8.x); qf[2] = bf_lo(q8.y); qf[3] = bf_hi(q8.y); qf[4] = bf_lo(q8.z); qf[5] = bf_hi(q8.z); qf[6] = bf_lo(q8.w); qf[7] = bf_hi(q8.w); }
    float sc[16];
    const bool b4 = (dc & 4) != 0, b2 = (dc & 2) != 0, b1 = (dc & 1) != 0;
#pragma unroll
    for (int g = 0; g < 16; ++g) {
        float p[8];
#pragma unroll
        for (int t = 0; t < 8; ++t) { const int key = (g >> 1) * 64 + cs + (g & 1) * 8 + t; const u32x4 k8 = *(const LAS u32x4*)(KT + key * 64 + dc * 8);
            p[t] = (qf[0] * bf_lo(k8.x) + qf[1] * bf_hi(k8.x)) + (qf[2] * bf_lo(k8.y) + qf[3] * bf_hi(k8.y)) + (qf[4] * bf_lo(k8.z) + qf[5] * bf_hi(k8.z)) + (qf[6] * bf_lo(k8.w) + qf[7] * bf_hi(k8.w)); }
        float p4[4], p2[2];
#pragma unroll
        for (int t = 0; t < 4; ++t) { const float snd = b4 ? p[t] : p[t + 4]; const float rcv = __shfl_xor(snd, 4); p4[t] = (b4 ? p[t + 4] : p[t]) + rcv; }
#pragma unroll
        for (int t = 0; t < 2; ++t) { const float snd = b2 ? p4[t] : p4[t + 2]; const float rcv = __shfl_xor(snd, 2); p2[t] = (b2 ? p4[t + 2] : p4[t]) + rcv; }
        const float snd = b1 ? p2[0] : p2[1]; const float rcv = __shfl_xor(snd, 1); const float s = (b1 ? p2[1] : p2[0]) + rcv;
        const int kr = g >> 1, cc = (g & 1) * 8 + dc;
        sc[g] = s + RPB[(rs + kr - r + 7) * 31 + (cs + cc - i + 15)];
    }
    float mx = sc[0];
#pragma unroll
    for (int g = 1; g < 16; ++g) mx = fmaxf(mx, sc[g]);
    mx = fmaxf(mx, __shfl_xor(mx, 1)); mx = fmaxf(mx, __shfl_xor(mx, 2)); mx = fmaxf(mx, __shfl_xor(mx, 4));
    float sum = 0.f;
#pragma unroll
    for (int g = 0; g < 16; ++g) { sc[g] = expf(sc[g] - mx); sum += sc[g]; }
    sum += __shfl_xor(sum, 1); sum += __shfl_xor(sum, 2); sum += __shfl_xor(sum, 4);
    const float inv = 1.0f / sum;
    float o[8];
#pragma unroll
    for (int q = 0; q < 8; ++q) o[q] = 0.f;
    const int lbase = F.lane & ~7;
#pragma unroll
    for (int g = 0; g < 16; ++g)
#pragma unroll
        for (int t = 0; t < 8; ++t) { const float pk = __shfl(sc[g], lbase + t); const int key = (g >> 1) * 64 + cs + (g & 1) * 8 + t;
            const u32x4 v8 = *(const LAS u32x4*)(VT + key * 64 + dc * 8);
            o[0] += pk * bf_lo(v8.x); o[1] += pk * bf_hi(v8.x); o[2] += pk * bf_lo(v8.y); o[3] += pk * bf_hi(v8.y);
            o[4] += pk * bf_lo(v8.z); o[5] += pk * bf_hi(v8.z); o[6] += pk * bf_lo(v8.w); o[7] += pk * bf_hi(v8.w); }
    u32x4 ov; ov.x = pk2(o[0] * inv, o[1] * inv); ov.y = pk2(o[2] * inv, o[3] * inv); ov.z = pk2(o[4] * inv, o[5] * inv); ov.w = pk2(o[6] * inv, o[7] * inv);
    *(u32x4*)(F.XN + (size_t)m * D + 512 + hh * 64 + dc * 8) = ov;
    __syncthreads();
}


#ifndef GLA_V2
#define GLA_V2 1
#endif
#ifndef NATTEN_V2
#define NATTEN_V2 1
#endif
constexpr int KST = 80, VST = 144;
__device__ __forceinline__ void gla_front2(const Ctx& F, int l, int h, int m0, LAS float* BF, LAS float* BR, LAS float* LFBT, LAS float* GWT, LAS float* GBT, LAS float* SEG) {
    { const int tok = F.tid >> 3, c4 = F.tid & 7; *(LAS f32x4*)(LFBT + tok * 32 + c4 * 4) = *(const f32x4*)(F.lfb + (size_t)(m0 + tok) * 32 + c4 * 4); }
#pragma unroll
    for (int k = 0; k < 4; ++k) { const int idx = F.tid + 512 * k; const int dir = idx >> 10, r = (idx >> 6) & 15, d = idx & 63;
        GWT[idx] = F.gate_w[(size_t)((l * 2 + dir) * 16 + r) * 256 + h * 64 + d]; }
    if (F.tid < 128) { const int dir = F.tid >> 6, d = F.tid & 63; GBT[F.tid] = F.gate_b[(l * 2 + dir) * 256 + h * 64 + d]; }
    __syncthreads();
    for (int k = 0; k < 16; ++k) { const int idx = F.tid + 512 * k; const int dir = idx >> 12, i = (idx >> 6) & 63, d = idx & 63;
        float z = GBT[dir * 64 + d];
#pragma unroll
        for (int r = 0; r < 16; ++r) z += LFBT[i * 32 + dir * 16 + r] * GWT[(dir * 16 + r) * 64 + d];
        const float la = (fminf(z, 0.f) - __logf(1.0f + __expf(-fabsf(z)))) * (1.0f / 16.0f);
        (dir ? BR : BF)[i * 64 + d] = la; }
    __syncthreads();
    {
        const int dir = F.tid >> 8, sg = (F.tid >> 6) & 3, d = F.tid & 63;
        LAS float* A = dir ? BR : BF; float v[16]; float run = 0.f;
        if (dir == 0) {
#pragma unroll
            for (int q = 0; q < 16; ++q) { run += A[(sg * 16 + q) * 64 + d]; v[q] = run; }
        } else {
#pragma unroll
            for (int q = 15; q >= 0; --q) { run += A[(sg * 16 + q) * 64 + d]; v[q] = run; }
        }
        SEG[(dir * 4 + sg) * 64 + d] = run;
        __syncthreads();
        float pre = 0.f;
        if (dir == 0) { for (int s = 0; s < 4; ++s) if (s < sg) pre += SEG[(0 + s) * 64 + d]; }
        else { for (int s = 0; s < 4; ++s) if (s > sg) pre += SEG[(4 + s) * 64 + d]; }
#pragma unroll
        for (int q = 0; q < 16; ++q) A[(sg * 16 + q) * 64 + d] = v[q] + pre;
    }
    __syncthreads();
}
__device__ __forceinline__ void gla_a2_item(const Ctx& F, int l, int it) {
    const int b = it >> 8, h = (it >> 6) & 3, c = it & 63, bh = b * 4 + h, m0 = b * T + c * 64;
    LAS float* BF = (LAS float*)F.lds; LAS float* BR = (LAS float*)(F.lds + 16384);
    LAS float* LFBT = (LAS float*)(F.lds + 32768); LAS float* GWT = (LAS float*)(F.lds + 40960); LAS float* GBT = (LAS float*)(F.lds + 49152);
    LAS bf16* KHF = (LAS bf16*)(F.lds + 49664); LAS bf16* KHB = (LAS bf16*)(F.lds + 59904); LAS bf16* VT = (LAS bf16*)(F.lds + 70144);
    LAS float* SEG = (LAS float*)(F.lds + 88576);
#pragma unroll
    for (int k = 0; k < 2; ++k) { const int idx = F.tid + 512 * k; const int tok = idx >> 4, ch = idx & 15;
        *(LAS u32x4*)(VT + tok * VST + ch * 8) = *(const u32x4*)(F.VG + (size_t)(m0 + tok) * 512 + h * 128 + ch * 8); }
    gla_front2(F, l, h, m0, BF, BR, LFBT, GWT, GBT, SEG);
#pragma unroll
    for (int k = 0; k < 4; ++k) { const int idx = F.tid + 512 * k; const int j = idx >> 5, d = (idx & 31) * 2;
        const unsigned kk = *(const unsigned*)(F.KG + (size_t)(m0 + j) * 256 + h * 64 + d); const float k0 = bf_lo(kk), k1 = bf_hi(kk);
        *(LAS unsigned*)(KHF + j * KST + d) = cvtpk(k0 * __expf(BF[63 * 64 + d] - BF[j * 64 + d]), k1 * __expf(BF[63 * 64 + d + 1] - BF[j * 64 + d + 1]));
        *(LAS unsigned*)(KHB + j * KST + d) = cvtpk(k0 * __expf(BR[d] - BR[j * 64 + d]), k1 * __expf(BR[d + 1] - BR[j * 64 + d + 1])); }
    if (F.tid < 128) { const int dir = F.tid >> 6, d = F.tid & 63; F.gdec[(size_t)((bh * 2 + dir) * 64 + c) * 64 + d] = __expf(dir ? BR[d] : BF[63 * 64 + d]); }
    __syncthreads();
    {
        const int dir = F.wave >> 2, etq = F.wave & 3, i16 = F.lane & 15, g = F.lane >> 4;
        const LAS bf16* KH = dir ? KHB : KHF;
        f32x4 acc[4][2];
#pragma unroll
        for (int dt = 0; dt < 4; ++dt) { acc[dt][0] = (f32x4){0.f, 0.f, 0.f, 0.f}; acc[dt][1] = (f32x4){0.f, 0.f, 0.f, 0.f}; }
#pragma unroll
        for (int ks = 0; ks < 2; ++ks) {
            const int row0 = 32 * ks + 8 * g + (i16 >> 2), cc = 4 * (i16 & 3);
            bf16x8 vb[2];
#pragma unroll
            for (int e2 = 0; e2 < 2; ++e2) { const int et = etq * 2 + e2; vb[e2] = cat8(tr16(VT + row0 * VST + 16 * et + cc), tr16(VT + (row0 + 4) * VST + 16 * et + cc)); }
#pragma unroll
            for (int dt = 0; dt < 4; ++dt) { const bf16x8 ka = cat8(tr16(KH + row0 * KST + 16 * dt + cc), tr16(KH + (row0 + 4) * KST + 16 * dt + cc));
                acc[dt][0] = mfma16(ka, vb[0], acc[dt][0]); acc[dt][1] = mfma16(ka, vb[1], acc[dt][1]); }
        }
        float* Ub = F.U + (size_t)((bh * 2 + dir) * 64 + c) * 8192;
#pragma unroll
        for (int dt = 0; dt < 4; ++dt)
#pragma unroll
            for (int e2 = 0; e2 < 2; ++e2) *(f32x4*)(Ub + (size_t)(16 * (etq * 2 + e2) + i16) * 64 + 16 * dt + 4 * g) = acc[dt][e2];
    }
    __syncthreads();
}
__device__ __forceinline__ void gla_b2(const Ctx& F) {
    const float* __restrict__ U = F.U; bf16* __restrict__ SP = F.SP; const float* __restrict__ GD = F.gdec;
    for (int id = F.vcu * 512 + F.tid; id < 32 * 2048; id += F.G * 512) {
        const int s = id >> 11, q4 = id & 2047, d4 = (q4 & 15) * 4, dir = s & 1;
        const float* base = U + (size_t)s * 64 * 8192 + 4 * q4; bf16* ob = SP + (size_t)s * 64 * 8192 + 4 * q4; const float* gd = GD + (size_t)s * 64 * 64 + d4;
        f32x4 S = (f32x4){0.f, 0.f, 0.f, 0.f};
#pragma unroll 8
        for (int step = 0; step < 64; ++step) { const int c = dir ? 63 - step : step;
            const f32x4 u = *(const f32x4*)(base + (size_t)c * 8192); const f32x4 g = *(const f32x4*)(gd + c * 64);
            u32x2 o; o.x = cvtpk(S[0], S[1]); o.y = cvtpk(S[2], S[3]); *(u32x2*)(ob + (size_t)c * 8192) = o;
            S = S * g + u; }
    }
}
__device__ __forceinline__ void gla_c2_item(const Ctx& F, int l, int it) {
    const int b = it >> 8, h = (it >> 6) & 3, c = it & 63, bh = b * 4 + h, m0 = b * T + c * 64;
    LAS float* BF = (LAS float*)F.lds; LAS float* BR = (LAS float*)(F.lds + 16384);
    LAS float* LFBT = (LAS float*)(F.lds + 32768); LAS float* GWT = (LAS float*)(F.lds + 40960); LAS float* GBT = (LAS float*)(F.lds + 49152);
    LAS bf16* QF = (LAS bf16*)(F.lds + 49664); LAS bf16* QB = (LAS bf16*)(F.lds + 59904); LAS bf16* KF = (LAS bf16*)(F.lds + 70144); LAS bf16* KB = (LAS bf16*)(F.lds + 80384);
    LAS bf16* VT = (LAS bf16*)(F.lds + 90624);
    LAS bf16* SFT = (LAS bf16*)(F.lds + 109056); LAS bf16* SBT = (LAS bf16*)(F.lds + 129536);
    LAS float* SEG = (LAS float*)(F.lds + 150016); LAS float* SSX = SEG + 512;
#pragma unroll
    for (int k = 0; k < 2; ++k) { const int idx = F.tid + 512 * k; const int tok = idx >> 4, ch = idx & 15;
        *(LAS u32x4*)(VT + tok * VST + ch * 8) = *(const u32x4*)(F.VG + (size_t)(m0 + tok) * 512 + h * 128 + ch * 8); }
#pragma unroll
    for (int k = 0; k < 2; ++k) { const int idx = F.tid + 512 * k; const int e = idx >> 3, ch = idx & 7;
        *(LAS u32x4*)(SFT + e * KST + ch * 8) = *(const u32x4*)(F.SP + (size_t)((bh * 2 + 0) * 64 + c) * 8192 + e * 64 + ch * 8);
        *(LAS u32x4*)(SBT + e * KST + ch * 8) = *(const u32x4*)(F.SP + (size_t)((bh * 2 + 1) * 64 + c) * 8192 + e * 64 + ch * 8); }
    gla_front2(F, l, h, m0, BF, BR, LFBT, GWT, GBT, SEG);
#pragma unroll
    for (int k = 0; k < 4; ++k) { const int idx = F.tid + 512 * k; const int i = idx >> 5, d = (idx & 31) * 2;
        const unsigned qq = *(const unsigned*)(F.QG + (size_t)(m0 + i) * 256 + h * 64 + d), kk = *(const unsigned*)(F.KG + (size_t)(m0 + i) * 256 + h * 64 + d);
        const float q0 = bf_lo(qq), q1 = bf_hi(qq), k0 = bf_lo(kk), k1 = bf_hi(kk);
        const float f0 = BF[i * 64 + d], f1 = BF[i * 64 + d + 1], r0 = BR[i * 64 + d], r1 = BR[i * 64 + d + 1];
        *(LAS unsigned*)(QF + i * KST + d) = cvtpk(q0 * __expf(f0), q1 * __expf(f1)); *(LAS unsigned*)(KF + i * KST + d) = cvtpk(k0 * __expf(-f0), k1 * __expf(-f1));
        *(LAS unsigned*)(QB + i * KST + d) = cvtpk(q0 * __expf(r0), q1 * __expf(r1)); *(LAS unsigned*)(KB + i * KST + d) = cvtpk(k0 * __expf(-r0), k1 * __expf(-r1)); }
    __syncthreads();
    const int itile = F.wave & 3, eh = F.wave >> 2, i16 = F.lane & 15, g = F.lane >> 4;
    bf16x8 qf[2], qb[2];
#pragma unroll
    for (int ks = 0; ks < 2; ++ks) { qf[ks] = *(const LAS bf16x8*)(QF + (16 * itile + i16) * KST + 32 * ks + 8 * g); qb[ks] = *(const LAS bf16x8*)(QB + (16 * itile + i16) * KST + 32 * ks + 8 * g); }
    f32x4 pt[4];
#pragma unroll
    for (int jt = 0; jt < 4; ++jt) {
        f32x4 pf = (f32x4){0.f, 0.f, 0.f, 0.f}, pb = (f32x4){0.f, 0.f, 0.f, 0.f};
#pragma unroll
        for (int ks = 0; ks < 2; ++ks) {
            const bf16x8 kf = *(const LAS bf16x8*)(KF + (16 * jt + i16) * KST + 32 * ks + 8 * g), kb = *(const LAS bf16x8*)(KB + (16 * jt + i16) * KST + 32 * ks + 8 * g);
            pf = mfma16(kf, qf[ks], pf); pb = mfma16(kb, qb[ks], pb); }
        const int iq = 16 * itile + i16;
#pragma unroll
        for (int r = 0; r < 4; ++r) pt[jt][r] = (16 * jt + 4 * g + r <= iq) ? pf[r] : pb[r];
    }
    const bf16x8 pp0 = pack8(pt[0], pt[1]), pp1 = pack8(pt[2], pt[3]);
    f32x4 acc[4];
#pragma unroll
    for (int e4 = 0; e4 < 4; ++e4) {
        const int et = eh * 4 + e4; f32x4 a = (f32x4){0.f, 0.f, 0.f, 0.f};
        const int rr = 4 * g + (i16 >> 2), cc = 16 * et + 4 * (i16 & 3);
        a = mfma16(cat8(tr16(VT + rr * VST + cc), tr16(VT + (rr + 16) * VST + cc)), pp0, a);
        a = mfma16(cat8(tr16(VT + (rr + 32) * VST + cc), tr16(VT + (rr + 48) * VST + cc)), pp1, a);
#pragma unroll
        for (int ks = 0; ks < 2; ++ks) {
            a = mfma16(*(const LAS bf16x8*)(SFT + (16 * et + i16) * KST + 32 * ks + 8 * g), qf[ks], a);
            a = mfma16(*(const LAS bf16x8*)(SBT + (16 * et + i16) * KST + 32 * ks + 8 * g), qb[ks], a); }
        acc[e4] = a;
    }
    float ss = 0.f;
#pragma unroll
    for (int e4 = 0; e4 < 4; ++e4) ss += (acc[e4][0] * acc[e4][0] + acc[e4][1] * acc[e4][1]) + (acc[e4][2] * acc[e4][2] + acc[e4][3] * acc[e4][3]);
    ss += __shfl_xor(ss, 16); ss += __shfl_xor(ss, 32);
    if (g == 0) SSX[eh * 64 + 16 * itile + i16] = ss;
    __syncthreads();
    const float rstd = 1.0f / sqrtf((SSX[16 * itile + i16] + SSX[64 + 16 * itile + i16]) * (1.0f / 128.0f) + EPS);
    const int m = m0 + 16 * itile + i16;
#pragma unroll
    for (int e4 = 0; e4 < 4; ++e4) {
        const int e0 = 16 * (eh * 4 + e4) + 4 * g;
        const f32x4 gn = *(const f32x4*)(F.gla_norm + l * 128 + e0);
        const u32x2 gg = *(const u32x2*)(F.GG + (size_t)m * 512 + h * 128 + e0);
        const float g0 = bf_lo(gg.x), g1 = bf_hi(gg.x), g2 = bf_lo(gg.y), g3 = bf_hi(gg.y);
        u32x2 o; o.x = cvtpk(acc[e4][0] * rstd * gn[0] * (g0 * sigmoidf_(g0)), acc[e4][1] * rstd * gn[1] * (g1 * sigmoidf_(g1)));
        o.y = cvtpk(acc[e4][2] * rstd * gn[2] * (g2 * sigmoidf_(g2)), acc[e4][3] * rstd * gn[3] * (g3 * sigmoidf_(g3)));
        *(u32x2*)(F.XN + (size_t)m * D + h * 128 + e0) = o;
    }
    __syncthreads();
}

__device__ __forceinline__ int na_rs(int r) { return min(max(r - 4, 0), 56); }
__device__ __forceinline__ void natten2_task(const Ctx& F, int l, int task) {
    const int b = task >> 6, hh = (task >> 3) & 7, seg = task & 7;
    LAS unsigned char* KR = F.lds; LAS unsigned char* VR = F.lds + 73728; LAS float* RPB = (LAS float*)(F.lds + 147456);
    const bf16* KNb = F.KN + (size_t)b * T * 512 + hh * 64; const bf16* VNb = F.VN + (size_t)b * T * 512 + hh * 64;
    if (F.tid < 465) RPB[F.tid] = F.rpb[(size_t)(l * 8 + hh) * 465 + F.tid];
    const int lkey = F.tid >> 3, lch = F.tid & 7;
    const int kdst = lkey * 128 + ((lch ^ (lkey & 7)) << 4), vdst = lkey * 128 + ((lch ^ (((lkey >> 1) & 3) << 1)) << 4);
    int Lhi = na_rs(seg * 8);
    {
        const int hi = na_rs(seg * 8 + 1) + 8;
        for (int gr = Lhi; gr < hi; ++gr) { const int slot = gr % 9;
            *(LAS u32x4*)(KR + slot * 8192 + kdst) = *(const u32x4*)(KNb + (size_t)(gr * 64 + lkey) * 512 + lch * 8);
            *(LAS u32x4*)(VR + slot * 8192 + vdst) = *(const u32x4*)(VNb + (size_t)(gr * 64 + lkey) * 512 + lch * 8); }
        Lhi = hi;
    }
    __syncthreads();
    const int n = F.wave & 3, rp = F.wave >> 2, i16 = F.lane & 15, g = F.lane >> 4;
    const int bs = min(max(16 * n - 8, 0), 32);
    const int cq = 16 * n + i16, cs = min(max(cq - 8, 0), 48);
    for (int step = 0; step < 4; ++step) {
        const int r0 = seg * 8 + step * 2, r = r0 + rp, rs = na_rs(r);
        u32x4 pk0, pk1, pv0, pv1; int nr0 = -1, nr1 = -1;
        if (step < 3) { const int hin = na_rs(r0 + 3) + 8; if (Lhi < hin) nr0 = Lhi; if (Lhi + 1 < hin) nr1 = Lhi + 1; }
        if (nr0 >= 0) { pk0 = *(const u32x4*)(KNb + (size_t)(nr0 * 64 + lkey) * 512 + lch * 8); pv0 = *(const u32x4*)(VNb + (size_t)(nr0 * 64 + lkey) * 512 + lch * 8); }
        if (nr1 >= 0) { pk1 = *(const u32x4*)(KNb + (size_t)(nr1 * 64 + lkey) * 512 + lch * 8); pv1 = *(const u32x4*)(VNb + (size_t)(nr1 * 64 + lkey) * 512 + lch * 8); }
        const int m = b * T + r * 64 + cq;
        bf16x8 qf[2];
#pragma unroll
        for (int ks = 0; ks < 2; ++ks) qf[ks] = *(const bf16x8*)(F.QN + (size_t)m * 512 + hh * 64 + 32 * ks + 8 * g);
        f32x4 S[16];
#pragma unroll
        for (int t = 0; t < 16; ++t) {
            const int slot = (rs + (t >> 1)) % 9, kc = bs + (t & 1) * 16 + i16;
            const LAS unsigned char* kp = KR + slot * 8192 + kc * 128;
            f32x4 a = (f32x4){0.f, 0.f, 0.f, 0.f};
#pragma unroll
            for (int ks = 0; ks < 2; ++ks) a = mfma16(*(const LAS bf16x8*)(kp + (((4 * ks + g) ^ (kc & 7)) << 4)), qf[ks], a);
            S[t] = a;
        }
        float mx = -3.0e38f;
#pragma unroll
        for (int t = 0; t < 16; ++t)
#pragma unroll
            for (int rr = 0; rr < 4; ++rr) {
                const int kcol = bs + (t & 1) * 16 + 4 * g + rr; const bool ok = (unsigned)(kcol - cs) < 16u;
                const int bi = ok ? (rs + (t >> 1) - r + 7) * 31 + (kcol - cq + 15) : 0;
                const float v = ok ? S[t][rr] + RPB[bi] : -1.0e30f;
                S[t][rr] = v; mx = fmaxf(mx, v); }
        mx = fmaxf(mx, __shfl_xor(mx, 16)); mx = fmaxf(mx, __shfl_xor(mx, 32));
        float sum = 0.f;
#pragma unroll
        for (int t = 0; t < 16; ++t)
#pragma unroll
            for (int rr = 0; rr < 4; ++rr) { const float p = __expf(S[t][rr] - mx); S[t][rr] = p; sum += p; }
        sum += __shfl_xor(sum, 16); sum += __shfl_xor(sum, 32);
        const float inv = 1.0f / sum;
        f32x4 o[4];
#pragma unroll
        for (int dt = 0; dt < 4; ++dt) o[dt] = (f32x4){0.f, 0.f, 0.f, 0.f};
#pragma unroll
        for (int pp = 0; pp < 8; ++pp) {
            const bf16x8 pf = pack8(S[2 * pp], S[2 * pp + 1]);
            const int slot = (rs + pp) % 9; const int key0 = bs + 4 * g + (i16 >> 2), key1 = key0 + 16;
            const LAS unsigned char* v0 = VR + slot * 8192 + key0 * 128; const LAS unsigned char* v1 = VR + slot * 8192 + key1 * 128;
            const int sw0 = ((key0 >> 1) & 3) << 1, sw1 = ((key1 >> 1) & 3) << 1, half = (i16 & 1) * 8, cpair = (i16 & 3) >> 1;
#pragma unroll
            for (int dt = 0; dt < 4; ++dt) {
                const int ch = 2 * dt + cpair;
                const bf16x8 vf = cat8(tr16(v0 + ((ch ^ sw0) << 4) + half), tr16(v1 + ((ch ^ sw1) << 4) + half));
                o[dt] = mfma16(vf, pf, o[dt]); }
        }
#pragma unroll
        for (int dt = 0; dt < 4; ++dt) { u32x2 ov; ov.x = cvtpk(o[dt][0] * inv, o[dt][1] * inv); ov.y = cvtpk(o[dt][2] * inv, o[dt][3] * inv);
            *(u32x2*)(F.XN + (size_t)m * D + 512 + hh * 64 + 16 * dt + 4 * g) = ov; }
        __syncthreads();
        if (nr0 >= 0) { const int slot = nr0 % 9; *(LAS u32x4*)(KR + slot * 8192 + kdst) = pk0; *(LAS u32x4*)(VR + slot * 8192 + vdst) = pv0; Lhi = nr0 + 1; }
        if (nr1 >= 0) { const int slot = nr1 % 9; *(LAS u32x4*)(KR + slot * 8192 + kdst) = pk1; *(LAS u32x4*)(VR + slot * 8192 + vdst) = pv1; Lhi = nr1 + 1; }
        __syncthreads();
    }
}

__global__ void __launch_bounds__(512, 2) fwd_kernel(Args args) {
    extern __shared__ __attribute__((aligned(16))) unsigned char lds_raw[];
    Base B;
    B.lds = (LAS unsigned char*)lds_raw;
    B.tid = threadIdx.x; B.lane = B.tid & 63; B.wave = __builtin_amdgcn_readfirstlane(B.tid >> 6);
    B.G = gridDim.x; { const int bx = blockIdx.x; B.vcu = (B.G % 8 == 0) ? (bx % 8) * (B.G / 8) + bx / 8 : bx; }
    for (int u = B.tid; u < (LDS_BYTES - LDSCTL_OFF) / 4; u += 512) ((LAS unsigned*)(B.lds + LDSCTL_OFF))[u] = 0u;
    __syncthreads();
    volatile LAS unsigned* MISC = (volatile LAS unsigned*)(B.lds + MISC_OFF);
    unsigned* const barw = (unsigned*)(args.ws + WS_CTL) + CW_BAR;
    XcdBarrier bar; bar.bar = barw; bar.x = 0; bar.st = nullptr;
    const bool multi = (args.ph_hi - args.ph_lo) > 1;
    if (multi) bar = xcd_barrier_post(barw, MISC + 8);

#ifndef PHM
#define PHM 0xfff
#endif
#define PH_EN(bit) ((PHM >> (bit)) & 1)
#ifndef REPM
#define REPM 0
#endif
#ifndef REPN
#define REPN 3
#endif
#define NREP(bit, l) ((((REPM >> (bit)) & 1) && (l) == 0) ? REPN : 1)
    for (int ph = args.ph_lo; ph < args.ph_hi; ++ph) {
        if (ph == 0) { if (PH_EN(0)) { for (int rep = 0; rep < NREP(0, 0); ++rep) { const Ctx F = make_ctx(B); phase_p0(F); __syncthreads(); } } }
        else if (ph == NPHASES - 1) { if (PH_EN(1)) { const Ctx F = make_ctx(B); prepass<2>(F, 0); } }
        else {
            const int l = (ph - 1) / 9, sp = (ph - 1) % 9;
            if (sp == 0) { if (PH_EN(2)) { for (int rep = 0; rep < NREP(2, l); ++rep) { const Ctx F = make_ctx(B); prepass<0>(F, l); __syncthreads(); } } }
            else if (sp == 1) { if (PH_EN(3)) for (int rep = 0; rep < NREP(3, l); ++rep) { const Ctx F = make_ctx(B);
                pg8::DenseSched S; S.init(F.XN, F.win_t + (size_t)l * NPROJ * D, NTOK, NPROJ, D, F.G, F.bx);
                EpiInProj E{F.QG, F.KG, F.VG, F.GG, F.QN, F.KN, F.VN, F.q_norm + l * 64, F.k_norm + l * 64};
                pg8::gemm_phase<EpiInProj, pg8::DenseSched>(F.lds, D, S, E, F.tid);
            } } else if (sp == 2) { const Ctx F = make_ctx(B);
#if GLA_V2 || NATTEN_V2
                if (PH_EN(5)) for (int rep = 0; rep < NREP(5, l); ++rep) for (int tk = F.vcu; tk < 256; tk += F.G) {
#if NATTEN_V2
                    natten2_task(F, l, tk);
#else
                    for (int q = 0; q < 8; ++q) natten_item(F, l, ((tk >> 3) << 6) + (tk & 7) * 8 + q);
#endif
                }
                if (PH_EN(4)) for (int rep = 0; rep < NREP(4, l); ++rep) for (int it = F.vcu; it < 1024; it += F.G) {
#if GLA_V2
                    gla_a2_item(F, l, it);
#else
                    gla_a_item(F, l, it);
#endif
                }
#else
                for (int it = F.vcu; it < 3072; it += F.G) { if (it < 1024) { if (PH_EN(4)) for (int rep = 0; rep < NREP(4, l); ++rep) gla_a_item(F, l, it); } else { if (PH_EN(5)) for (int rep = 0; rep < NREP(5, l); ++rep) natten_item(F, l, it - 1024); } }
#endif
            } else if (sp == 3) { if (PH_EN(6)) for (int rep = 0; rep < NREP(6, l); ++rep) { const Ctx F = make_ctx(B);
#if GLA_V2
                gla_b2(F);
#else
                gla_b(F);
#endif
            } }
            else if (sp == 4) { if (PH_EN(7)) for (int rep = 0; rep < NREP(7, l); ++rep) { const Ctx F = make_ctx(B); for (int it = F.vcu; it < 1024; it += F.G) {
#if GLA_V2
                gla_c2_item(F, l, it);
#else
                gla_c_item(F, l, it);
#endif
            } } }
            else if (sp == 5) { if (PH_EN(8)) for (int rep = 0; rep < NREP(8, l); ++rep) { const Ctx F = make_ctx(B);
                pg8::DenseSched S; S.init(F.XN, F.wout_t + (size_t)l * D * D, NTOK, D, D, F.G, F.bx);
                EpiResid E{l == 0 ? F.x_in : F.X, F.X, F.mod + (size_t)(l * 4) * MODW + 2 * D};
                pg8::gemm_phase<EpiResid, pg8::DenseSched>(F.lds, D, S, E, F.tid);
            } } else if (sp == 6) { if (PH_EN(9)) { const Ctx F = make_ctx(B); prepass<1>(F, l); } }
            else if (sp == 7) { if (PH_EN(10)) for (int rep = 0; rep < NREP(10, l); ++rep) { const Ctx F = make_ctx(B);
                moe_tables(F, l);
                pg8::MoeSched<true> S; S.A = (const char*)F.XN; S.Bt = (const char*)(F.w13_t + (size_t)l * NE * 1024 * D); S.K = D; S.lists = F.lists;
                S.TS = (const LAS int*)(F.lds + TAB_OFF); S.CN = S.TS + 40; S.G = F.G; S.c = F.vcu;
                EpiSwiGLU E{F.H};
                pg8::gemm_phase<EpiSwiGLU, pg8::MoeSched<true>>(F.lds, D, S, E, F.tid);
            } } else { if (PH_EN(11)) for (int rep = 0; rep < NREP(11, l); ++rep) { const Ctx F = make_ctx(B);
                moe_tables(F, l);
                pg8::MoeSched<false> S; S.A = (const char*)F.H; S.Bt = (const char*)(F.w2_t + (size_t)l * NE * D * DE); S.K = DE; S.lists = F.lists;
                S.TS = (const LAS int*)(F.lds + TAB_OFF); S.CN = S.TS + 40; S.G = F.G; S.c = F.vcu;
                EpiY E{F.Y};
                pg8::gemm_phase<EpiY, pg8::MoeSched<false>>(F.lds, DE, S, E, F.tid);
            } }
        }
        if (ph + 1 < args.ph_hi) xcd_barrier(bar);
    }
}

extern "C" void kernel_launch(void* const* d_in, const int* in_sizes, int n_in, void* d_out, int out_size, void* d_ws, size_t ws_size, hipStream_t stream) {
    static int grid = 0;
    if (grid == 0) {
        if (n_in != 19 || in_sizes[0] != NTOK * D || out_size != NTOK * D || ws_size < WS_END) {
            fprintf(stderr, "kernel_launch: unexpected shapes (n_in %d, in0 %d, out %d, ws %zu, need %zu); nothing launched\n", n_in, n_in > 0 ? in_sizes[0] : -1, out_size, ws_size, (size_t)WS_END); grid = -1; return; }
        int dev = 0, cus = 0;
        if (hipGetDevice(&dev) != hipSuccess || hipDeviceGetAttribute(&cus, hipDeviceAttributeMultiprocessorCount, dev) != hipSuccess) { fprintf(stderr, "kernel_launch: device query failed\n"); grid = -1; return; }
        if (hipFuncSetAttribute((const void*)fwd_kernel, hipFuncAttributeMaxDynamicSharedMemorySize, LDS_BYTES) != hipSuccess) { fprintf(stderr, "kernel_launch: hipFuncSetAttribute failed\n"); grid = -1; return; }
        (void)hipGetLastError();
        grid = cus;
    }
    if (grid < 0) return;
    if (hipMemsetAsync((char*)d_ws + WS_CTL, 0, CTL_ZERO_BYTES, stream) != hipSuccess) { fprintf(stderr, "kernel_launch: memset failed\n"); return; }
    Args a{};
    for (int i = 0; i < 19; ++i) a.in[i] = (const float*)d_in[i];
    a.out = (float*)d_out; a.ws = (unsigned char*)d_ws;
#if MK_PER_PHASE
    for (int ph = 0; ph < NPHASES; ++ph) { a.ph_lo = ph; a.ph_hi = ph + 1; hipLaunchKernelGGL(fwd_kernel, dim3(grid), dim3(512), LDS_BYTES, stream, a); }
#else
    a.ph_lo = 0; a.ph_hi = NPHASES;
    hipLaunchKernelGGL(fwd_kernel, dim3(grid), dim3(512), LDS_BYTES, stream, a);
#endif
    const hipError_t le = hipPeekAtLastError();
    if (le != hipSuccess) fprintf(stderr, "kernel_launch: launch failed: %s\n", hipGetErrorName(le));
}
```

```cpp
#include <hip/hip_runtime.h>
#include <cstdio>
#include <cstdint>

#ifndef MK_PER_PHASE
#define MK_PER_PHASE 0
#endif

#define LAS __attribute__((address_space(3)))
#define GAS __attribute__((address_space(1)))
typedef unsigned short bf16;
typedef short bf16x8 __attribute__((ext_vector_type(8)));
typedef float f32x4 __attribute__((ext_vector_type(4)));
typedef float f32x2 __attribute__((ext_vector_type(2)));
typedef unsigned u32x4 __attribute__((ext_vector_type(4)));
typedef unsigned u32x2 __attribute__((ext_vector_type(2)));
typedef GAS unsigned gu32;

constexpr int NB = 4, T = 4096, D = 1024, NTOK = NB * T, DEPTH = 2, INW = 3104, NPROJ = 3072, MODW = 6144;
constexpr int NE = 32, DE = 512, LCAP = 16384;
constexpr float EPS = 1e-6f;
#ifndef MOE_FUSED
#define MOE_FUSED 1
#endif
#ifndef GLA_TEAM
#define GLA_TEAM 1
#endif
constexpr int PPL = (MOE_FUSED ? 8 : 9) - (GLA_TEAM ? 2 : 0);
constexpr int SP_OUT = GLA_TEAM ? 3 : 5;
constexpr int NPHASES = 2 + 2 * PPL;

constexpr size_t MiB = 1u << 20;
constexpr size_t WS_CTL = 0, CTL_ZERO_BYTES = 256 * 1024;
constexpr size_t WS_MOD = 1 * MiB;
constexpr size_t WS_LFB = 2 * MiB;
constexpr size_t WS_TOKINFO = 4 * MiB;
constexpr size_t WS_GDEC = 4 * MiB + 512 * 1024;
constexpr size_t WS_LISTS = 5 * MiB;
constexpr size_t WS_WIN = 8 * MiB;
constexpr size_t WS_WOUT = 20 * MiB;
constexpr size_t WS_W13 = 24 * MiB;
constexpr size_t WS_W2 = 152 * MiB;
constexpr size_t WS_XN = 216 * MiB;
constexpr size_t WS_X = 248 * MiB;
constexpr size_t WS_QG = 312 * MiB, WS_KG = 320 * MiB, WS_VG = 328 * MiB, WS_GG = 344 * MiB, WS_QN = 360 * MiB, WS_KN = 376 * MiB, WS_VN = 392 * MiB;
constexpr size_t WS_U = 408 * MiB;
constexpr size_t WS_BFBR = 440 * MiB;
constexpr size_t WS_H = 312 * MiB;
constexpr size_t WS_Y = 352 * MiB;
constexpr size_t WS_SP = 472 * MiB;
constexpr size_t WS_END = 504 * MiB;
constexpr int CW_BAR = 4096, CW_CNT = 8192, CW_RDY = 12288, CW_TEAM = 36864, CW_PAN = 38912;

constexpr int SCR_BYTES = 155648;
constexpr int LDSCTL_OFF = SCR_BYTES, MISC_OFF = LDSCTL_OFF + 320, TAB_OFF = LDSCTL_OFF + 1024;
constexpr int LDS_BYTES = 163840;

#define RLX_AGENT __ATOMIC_RELAXED, __HIP_MEMORY_SCOPE_AGENT
__device__ __forceinline__ unsigned f2bf(float f) { unsigned u = __builtin_bit_cast(unsigned, f); return (u + 0x7fffu + ((u >> 16) & 1u)) >> 16; }
__device__ __forceinline__ unsigned pk2(float lo, float hi) { return f2bf(lo) | (f2bf(hi) << 16); }
__device__ __forceinline__ float bf_lo(unsigned w) { return __builtin_bit_cast(float, w << 16); }
__device__ __forceinline__ float bf_hi(unsigned w) { return __builtin_bit_cast(float, w & 0xffff0000u); }
__device__ __forceinline__ float bf2f(bf16 b) { return __builtin_bit_cast(float, (unsigned)b << 16); }
__device__ __forceinline__ unsigned cvt_pk_bf16(float lo, float hi) { unsigned r; asm volatile("v_cvt_pk_bf16_f32 %0, %1, %2" : "=v"(r) : "v"(lo), "v"(hi)); return r; }
__device__ __forceinline__ float wave_sum(float v) {
#pragma unroll
    for (int o = 1; o < 64; o <<= 1) v += __shfl_xor(v, o);
    return v;
}
__device__ __forceinline__ float sigmoidf_(float x) { return __builtin_amdgcn_rcpf(1.0f + __expf(-x)); }
__device__ __forceinline__ float logsigf_(float z) { return fminf(z, 0.f) - log1pf(expf(-fabsf(z))); }


typedef short s16x4 __attribute__((ext_vector_type(4)));
typedef __bf16 bf16x2_t __attribute__((ext_vector_type(2)));
__device__ __forceinline__ unsigned cvtpk(float lo, float hi) { f32x2 v = {lo, hi}; bf16x2_t b = __builtin_convertvector(v, bf16x2_t); return __builtin_bit_cast(unsigned, b); }
__device__ __forceinline__ unsigned pkh2(float a, float b) { typedef _Float16 h2 __attribute__((ext_vector_type(2))); h2 v = {(_Float16)a, (_Float16)b}; return __builtin_bit_cast(unsigned, v); }
__device__ __forceinline__ f32x2 unh2(unsigned w) { typedef _Float16 h2 __attribute__((ext_vector_type(2))); const h2 v = __builtin_bit_cast(h2, w); return (f32x2){(float)v[0], (float)v[1]}; }
__device__ __forceinline__ f32x4 mfma16(bf16x8 a, bf16x8 b, f32x4 c) { return __builtin_amdgcn_mfma_f32_16x16x32_bf16(a, b, c, 0, 0, 0); }
__device__ __forceinline__ s16x4 tr16(const LAS void* p) { return __builtin_amdgcn_ds_read_tr16_b64_v4i16((LAS s16x4*)p); }
__device__ __forceinline__ bf16x8 cat8(s16x4 lo, s16x4 hi) { return __builtin_shufflevector(lo, hi, 0, 1, 2, 3, 4, 5, 6, 7); }
__device__ __forceinline__ bf16x8 pack8(f32x4 a, f32x4 b) { u32x4 p; p.x = cvtpk(a[0], a[1]); p.y = cvtpk(a[2], a[3]); p.z = cvtpk(b[0], b[1]); p.w = cvtpk(b[2], b[3]); return __builtin_bit_cast(bf16x8, p); }

struct Ctx {
    LAS unsigned char* lds;
    int tid, lane, wave, vcu, G, bx;
    const float *x_in, *c, *w_ada, *b_ada, *attn_norm, *ffn_norm, *w_in, *gate_w, *gate_b, *gla_norm, *q_norm, *k_norm, *rpb, *w_out, *router_w, *router_b, *w1, *w3, *w2;
    float* out;
    gu32* ctl;
    float *mod, *lfb, *gdec, *U, *bfbr; bf16* Xb; bf16* SP; bf16* UB;
    unsigned* tokinfo; int* lists;
    bf16 *win_t, *wout_t, *w13_t, *w2_t, *XN, *QG, *KG, *VG, *GG, *QN, *KN, *VN, *H, *Y;
};

#ifndef PHM
#define PHM 0xfff
#endif
#define PH_EN12 ((PHM >> 12) & 1)
struct Args { const float* in[19]; float* out; unsigned char* ws; int ph_lo, ph_hi; };
struct Base { LAS unsigned char* lds; int tid, lane, wave, vcu, G; };
typedef __attribute__((address_space(4))) const Args CArgs;
__device__ __forceinline__ CArgs* kargs() { CArgs* p = (CArgs*)__builtin_amdgcn_kernarg_segment_ptr(); asm volatile("" : "+s"(p)); return p; }
__device__ __forceinline__ Ctx make_ctx(const Base& B) {
    CArgs* A = kargs(); Ctx F;
    { int t = B.tid; asm volatile("" : "+v"(t)); F.tid = t; F.lane = t & 63; F.wave = __builtin_amdgcn_readfirstlane(t >> 6); }
    { int v = B.vcu, g = B.G; asm volatile("" : "+s"(v), "+s"(g)); F.vcu = v; F.G = g; int bx = (int)blockIdx.x; asm volatile("" : "+s"(bx)); F.bx = bx; }
    { LAS unsigned char* lp = B.lds; asm volatile("" : "+s"(lp)); F.lds = lp; }
    F.x_in = A->in[0]; F.c = A->in[1]; F.w_ada = A->in[2]; F.b_ada = A->in[3]; F.attn_norm = A->in[4]; F.ffn_norm = A->in[5]; F.w_in = A->in[6];
    F.gate_w = A->in[7]; F.gate_b = A->in[8]; F.gla_norm = A->in[9]; F.q_norm = A->in[10]; F.k_norm = A->in[11]; F.rpb = A->in[12]; F.w_out = A->in[13];
    F.router_w = A->in[14]; F.router_b = A->in[15]; F.w1 = A->in[16]; F.w3 = A->in[17]; F.w2 = A->in[18];
    F.out = A->out;
    unsigned char* ws = A->ws;
    F.ctl = (gu32*)(ws + WS_CTL);
    F.mod = (float*)(ws + WS_MOD); F.lfb = (float*)(ws + WS_LFB); F.gdec = (float*)(ws + WS_GDEC); F.Xb = (bf16*)(ws + WS_X); F.U = (float*)(ws + WS_U); F.bfbr = (float*)(ws + WS_BFBR); F.SP = (bf16*)(ws + WS_SP); F.UB = (bf16*)(ws + WS_U);
    F.tokinfo = (unsigned*)(ws + WS_TOKINFO); F.lists = (int*)(ws + WS_LISTS);
    F.win_t = (bf16*)(ws + WS_WIN); F.wout_t = (bf16*)(ws + WS_WOUT); F.w13_t = (bf16*)(ws + WS_W13); F.w2_t = (bf16*)(ws + WS_W2);
    F.XN = (bf16*)(ws + WS_XN); F.QG = (bf16*)(ws + WS_QG); F.KG = (bf16*)(ws + WS_KG); F.VG = (bf16*)(ws + WS_VG); F.GG = (bf16*)(ws + WS_GG);
    F.QN = (bf16*)(ws + WS_QN); F.KN = (bf16*)(ws + WS_KN); F.VN = (bf16*)(ws + WS_VN); F.H = (bf16*)(ws + WS_H); F.Y = (bf16*)(ws + WS_Y);
    return F;
}

namespace pg8 {
constexpr int BM = 256, BK = 64, HALF = 128, HTB = HALF * BK * 2, STAGE_BYTES = 8 * HTB;
__host__ __device__ __forceinline__ int lds_byte(int r, int c) { const int st = (r >> 4) * 2 + (c >> 5), rr = r & 15, cc = c & 31, ob = rr * 64 + cc * 2; return st * 1024 + (ob ^ (((ob >> 9) & 1) << 5)); }
__host__ __device__ __forceinline__ void stage_rc(int b, int& R, int& C) { const int st = b / 1024, sb = b % 1024, swz = sb ^ (((sb >> 9) & 1) << 5); R = (st >> 1) * 16 + swz / 64; C = (st & 1) * 32 + (swz % 64) / 2; }
__host__ __device__ __forceinline__ int perm32(int rho) { const int n = rho >> 4, i = rho & 15; return 8 * (i >> 2) + 4 * n + (i & 3); }

struct Unit { int rowbase, pn, e, posbase, cnt; };

template <class Epi, class Sched>
__device__ __forceinline__ void gemm_phase(LAS unsigned char* lds, const int K, const Sched& S, const Epi& E, const int tid) {
    const int wid = __builtin_amdgcn_readfirstlane(tid >> 6), lane = tid & 63, wr = wid >> 2, wc = wid & 3, fr = lane & 15, fq = lane >> 4;
    const int nt = K / BK;
    int R0, C0, R1, C1; stage_rc(tid * 16, R0, C0); stage_rc(tid * 16 + 8192, R1, C1);
    const int Rb0 = Epi::PERM ? ((R0 & ~31) + perm32(R0 & 31)) : R0, Rb1 = Epi::PERM ? ((R1 & ~31) + perm32(R1 & 31)) : R1;
    const unsigned vb0 = (unsigned)(Rb0 * K + C0) * 2u, vb1 = (unsigned)(Rb1 * K + C1) * 2u;
    const size_t kstep = (size_t)(BK * 2);
    const size_t hstepB = (size_t)HALF * K * 2;
    const unsigned ldsw = (unsigned)wid * 1024u;
    const int aoff = lds_byte(wr * 64 + fr, fq * 8), boff = lds_byte(wc * 32 + fr, fq * 8);
#define PG8_SA(b, h) (((b) * 2 + (h)) * HTB)
#define PG8_SB(b, h) ((4 + (b) * 2 + (h)) * HTB)
#define PG8_STAGE2(bufoff, gbase, o0, o1) do { \
        __builtin_amdgcn_global_load_lds((const unsigned*)((const char*)(gbase) + (o0)), (LAS unsigned*)(lds + (bufoff) + ldsw), 16, 0, 0); \
        __builtin_amdgcn_global_load_lds((const unsigned*)((const char*)(gbase) + (o1)), (LAS unsigned*)(lds + (bufoff) + ldsw + 8192), 16, 0, 0); } while (0)
#define PG8_LDA(dst, b, h) do { _Pragma("unroll") for (int m = 0; m < 4; ++m) _Pragma("unroll") for (int k = 0; k < 2; ++k) dst[m][k] = *(const LAS bf16x8*)(lds + PG8_SA(b, h) + aoff + m * 2048 + k * 1024); } while (0)
#define PG8_LDB(dst, b, h) do { _Pragma("unroll") for (int n = 0; n < 2; ++n) _Pragma("unroll") for (int k = 0; k < 2; ++k) dst[n][k] = *(const LAS bf16x8*)(lds + PG8_SB(b, h) + boff + n * 2048 + k * 1024); } while (0)
#define PG8_MMA(ai, bj, At, Bt) do { __builtin_amdgcn_s_setprio(1); _Pragma("unroll") for (int m = 0; m < 4; ++m) _Pragma("unroll") for (int n = 0; n < 2; ++n) _Pragma("unroll") for (int k = 0; k < 2; ++k) \
        acc[ai][bj][m][n] = __builtin_amdgcn_mfma_f32_16x16x32_bf16(Bt[n][k], At[m][k], acc[ai][bj][m][n], 0, 0, 0); __builtin_amdgcn_s_setprio(0); } while (0)
#define PG8_WAIT_V(n) asm volatile("s_waitcnt vmcnt(" #n ")" ::: "memory")
#define PG8_WAIT_L(n) asm volatile("s_waitcnt lgkmcnt(" #n ")" ::: "memory")
#define PG8_BAR __builtin_amdgcn_s_barrier()
#define PG8_SCHED __builtin_amdgcn_sched_barrier(0)
    Unit cur, nxt; int ui = 0;
    if (!S.next(0, cur)) return;
    f32x4 acc[2][2][4][2];
#pragma unroll
    for (int a = 0; a < 2; ++a)
#pragma unroll
        for (int b = 0; b < 2; ++b)
#pragma unroll
            for (int m = 0; m < 4; ++m)
#pragma unroll
                for (int n = 0; n < 2; ++n) acc[a][b][m][n] = (f32x4){0.f, 0.f, 0.f, 0.f};
    bf16x8 At[4][2], B0[2][2], B1[2][2];
    const char* cA = S.Abase(cur); const char* cB = S.Bbase(cur);
    unsigned ca0 = S.aoff(cur, 0, R0, C0), ca1 = S.aoff(cur, 0, R1, C1), ca2 = S.aoff(cur, 1, R0, C0), ca3 = S.aoff(cur, 1, R1, C1);
    PG8_STAGE2(PG8_SB(0, 0), cB, vb0, vb1); PG8_STAGE2(PG8_SB(0, 1), cB + hstepB, vb0, vb1);
    S.a_ready(cur);
    PG8_STAGE2(PG8_SA(0, 0), cA, ca0, ca1); PG8_STAGE2(PG8_SA(0, 1), cA, ca2, ca3);
    if (wr == 1) PG8_BAR;
    PG8_WAIT_V(2); PG8_BAR;
    PG8_STAGE2(PG8_SB(1, 0), cB + kstep, vb0, vb1); PG8_STAGE2(PG8_SA(1, 0), cA + kstep, ca0, ca1); PG8_STAGE2(PG8_SB(1, 1), cB + hstepB + kstep, vb0, vb1);
    PG8_WAIT_V(6); PG8_BAR;
    for (;;) {
        const bool has_next = S.next(ui + 1, nxt);
        const char* nA = has_next ? S.Abase(nxt) : cA; const char* nB = has_next ? S.Bbase(nxt) : cB;
        unsigned na0 = ca0, na1 = ca1, na2 = ca2, na3 = ca3;
        if (has_next) { na0 = S.aoff(nxt, 0, R0, C0); na1 = S.aoff(nxt, 0, R1, C1); na2 = S.aoff(nxt, 1, R0, C0); na3 = S.aoff(nxt, 1, R1, C1); }
        for (int t = 0; t < nt; t += 2) {
            const bool last = (t == nt - 2);
            if (last && has_next) S.a_ready(nxt);
            const char* a1 = cA + (size_t)(t + 1) * kstep;
            const char* a2 = last ? nA : cA + (size_t)(t + 2) * kstep; const char* b2 = last ? nB : cB + (size_t)(t + 2) * kstep;
            const char* a3 = a2 + kstep; const char* b3 = b2 + kstep;
            const unsigned s0 = last ? na0 : ca0, s1 = last ? na1 : ca1, s2 = last ? na2 : ca2, s3 = last ? na3 : ca3;
            PG8_LDB(B0, 0, 0); PG8_LDB(B1, 0, 1); PG8_SCHED; PG8_LDA(At, 0, 0); PG8_STAGE2(PG8_SA(1, 1), a1, ca2, ca3);
            PG8_WAIT_V(8); PG8_WAIT_L(0); PG8_BAR; PG8_MMA(0, 0, At, B0); PG8_MMA(0, 1, At, B1); PG8_BAR; PG8_SCHED;
            PG8_LDA(At, 0, 1); PG8_STAGE2(PG8_SB(0, 0), b2, vb0, vb1); PG8_STAGE2(PG8_SB(0, 1), b2 + hstepB, vb0, vb1); PG8_STAGE2(PG8_SA(0, 0), a2, s0, s1);
            PG8_WAIT_V(8); PG8_WAIT_L(0); PG8_BAR; PG8_MMA(1, 0, At, B0); PG8_MMA(1, 1, At, B1); PG8_BAR; PG8_SCHED;
            PG8_LDB(B0, 1, 0); PG8_LDB(B1, 1, 1); PG8_SCHED; PG8_LDA(At, 1, 0); PG8_STAGE2(PG8_SA(0, 1), a2, s2, s3);
            PG8_WAIT_V(8); PG8_WAIT_L(0); PG8_BAR; PG8_MMA(0, 0, At, B0); PG8_MMA(0, 1, At, B1); PG8_BAR; PG8_SCHED;
            PG8_LDA(At, 1, 1); PG8_STAGE2(PG8_SB(1, 0), b3, vb0, vb1); PG8_STAGE2(PG8_SB(1, 1), b3 + hstepB, vb0, vb1); PG8_STAGE2(PG8_SA(1, 0), a3, s0, s1);
            PG8_WAIT_V(8); PG8_WAIT_L(0); PG8_BAR; PG8_MMA(1, 0, At, B0); PG8_MMA(1, 1, At, B1); PG8_BAR; PG8_SCHED;
        }
        if (wr == 0) PG8_BAR;
        E(acc, cur, wr, wc, fr, fq);
        if (!has_next) break;
#pragma unroll
        for (int a = 0; a < 2; ++a)
#pragma unroll
            for (int b = 0; b < 2; ++b)
#pragma unroll
                for (int m = 0; m < 4; ++m)
#pragma unroll
                    for (int n = 0; n < 2; ++n) acc[a][b][m][n] = (f32x4){0.f, 0.f, 0.f, 0.f};
        cur = nxt; cA = nA; cB = nB; ca0 = na0; ca1 = na1; ca2 = na2; ca3 = na3; ++ui;
        if (wr == 1) PG8_BAR;
    }
    PG8_WAIT_V(0);
    PG8_BAR;
#undef PG8_SA
#undef PG8_SB
#undef PG8_STAGE2
#undef PG8_LDA
#undef PG8_LDB
#undef PG8_MMA
#undef PG8_WAIT_V
#undef PG8_WAIT_L
#undef PG8_BAR
#undef PG8_SCHED
}

struct DenseSched {
    const char* A; const char* Bt; int K, nM, nN, nwg, G, c; unsigned* rdy = nullptr; unsigned need = 0;
    __device__ __forceinline__ void init(const void* A_, const void* Bt_, int M, int N, int K_, int G_, int c_) { A = (const char*)A_; Bt = (const char*)Bt_; K = K_; nM = M / BM; nN = N / BM; nwg = nM * nN; G = G_; c = c_; }
    __device__ __forceinline__ bool next(int i, Unit& u) const {
        const long L = (long)i * G + c; if (L >= nwg) return false;
        int wgid = (int)L; { const int q = nwg / 8, r = nwg % 8, xcd = wgid % 8, off = wgid / 8; wgid = (xcd < r ? xcd * (q + 1) : r * (q + 1) + (xcd - r) * q) + off; }
        const int nig = 8 * nN, gid = wgid / nig, fm = gid * 8, gsz = (nM - fm) < 8 ? (nM - fm) : 8;
        const int pm = fm + ((wgid % nig) % gsz); u.pn = (wgid % nig) / gsz; u.rowbase = pm * BM; u.e = 0; u.posbase = 0; u.cnt = 0; return true;
    }
    __device__ __forceinline__ const char* Abase(const Unit& u) const { return A + (size_t)u.rowbase * K * 2; }
    __device__ __forceinline__ const char* Bbase(const Unit& u) const { return Bt + (size_t)u.pn * BM * K * 2; }
    __device__ __forceinline__ unsigned aoff(const Unit&, int half, int R, int C) const { return (unsigned)((half * HALF + R) * K + C) * 2u; }
    __device__ __forceinline__ void a_ready(const Unit& u) const {
        if (!rdy) return;
        if (threadIdx.x < 64) {
            unsigned* w = rdy + (u.rowbase / BM) * 32; unsigned sp = 0;
            while ((unsigned)__builtin_amdgcn_readfirstlane(__hip_atomic_load(w, __ATOMIC_RELAXED, __HIP_MEMORY_SCOPE_AGENT)) < need) {
                __builtin_amdgcn_s_sleep(1);
                if (++sp > (1u << 20)) break; }
            __builtin_amdgcn_fence(__ATOMIC_ACQUIRE, "agent");
            asm volatile("s_waitcnt vmcnt(0)" ::: "memory");
        }
        asm volatile("" ::: "memory"); __builtin_amdgcn_s_barrier(); asm volatile("" ::: "memory");
    }
};
template <bool GATHER>
struct MoeSched {
    const char* A; const char* Bt; int K; const int* lists; const LAS int* TS; const LAS int* CN; int G, c;
    __device__ __forceinline__ bool next(int i, Unit& u) const {
        const int L = i * G + c; const int TT = __builtin_amdgcn_readfirstlane(TS[32]);
        if (L >= TT * 4) return false;
        const int mt = L >> 2; int e = 0;
        while (e < 31 && __builtin_amdgcn_readfirstlane(TS[e + 1]) <= mt) ++e;
        u.e = e; u.rowbase = mt * BM; u.pn = L & 3; u.posbase = (mt - __builtin_amdgcn_readfirstlane(TS[e])) * BM; u.cnt = __builtin_amdgcn_readfirstlane(CN[e]); return true;
    }
    __device__ __forceinline__ void a_ready(const Unit&) const {}
    __device__ __forceinline__ const char* Abase(const Unit& u) const { return GATHER ? A : A + (size_t)u.rowbase * K * 2; }
    __device__ __forceinline__ const char* Bbase(const Unit& u) const { return Bt + ((size_t)u.e * 1024 + (size_t)u.pn * BM) * K * 2; }
    __device__ __forceinline__ unsigned aoff(const Unit& u, int half, int R, int C) const {
        if (GATHER) { const int pos = u.posbase + half * HALF + R; const int tok = pos < u.cnt ? lists[u.e * LCAP + pos] : 0; return (unsigned)(tok * K + C) * 2u; }
        return (unsigned)((half * HALF + R) * K + C) * 2u;
    }
};

struct UnitV { int rowbase, pn, e, posbase, cnt, kind, K, mt; };
template <class Epi, class Sched>
__device__ __forceinline__ void gemm_phase_v(LAS unsigned char* lds, const Sched& S, const Epi& E, const int tid) {
    const int wid = __builtin_amdgcn_readfirstlane(tid >> 6), lane = tid & 63, wr = wid >> 2, wc = wid & 3, fr = lane & 15, fq = lane >> 4;
    int R0, C0, R1, C1; stage_rc(tid * 16, R0, C0); stage_rc(tid * 16 + 8192, R1, C1);
    const int Rb0 = (R0 & ~31) + perm32(R0 & 31), Rb1 = (R1 & ~31) + perm32(R1 & 31);
    const size_t kstep = (size_t)(BK * 2);
    const unsigned ldsw = (unsigned)wid * 1024u;
    const int aoff = lds_byte(wr * 64 + fr, fq * 8), boff = lds_byte(wc * 32 + fr, fq * 8);
#define PG8_SA(b, h) (((b) * 2 + (h)) * HTB)
#define PG8_SB(b, h) ((4 + (b) * 2 + (h)) * HTB)
#define PG8_STAGE2(bufoff, gbase, o0, o1) do { \
        __builtin_amdgcn_global_load_lds((const unsigned*)((const char*)(gbase) + (o0)), (LAS unsigned*)(lds + (bufoff) + ldsw), 16, 0, 0); \
        __builtin_amdgcn_global_load_lds((const unsigned*)((const char*)(gbase) + (o1)), (LAS unsigned*)(lds + (bufoff) + ldsw + 8192), 16, 0, 0); } while (0)
#define PG8_LDA(dst, b, h) do { _Pragma("unroll") for (int m = 0; m < 4; ++m) _Pragma("unroll") for (int k = 0; k < 2; ++k) dst[m][k] = *(const LAS bf16x8*)(lds + PG8_SA(b, h) + aoff + m * 2048 + k * 1024); } while (0)
#define PG8_LDB(dst, b, h) do { _Pragma("unroll") for (int n = 0; n < 2; ++n) _Pragma("unroll") for (int k = 0; k < 2; ++k) dst[n][k] = *(const LAS bf16x8*)(lds + PG8_SB(b, h) + boff + n * 2048 + k * 1024); } while (0)
#define PG8_MMA(ai, bj, At, Bt) do { __builtin_amdgcn_s_setprio(1); _Pragma("unroll") for (int m = 0; m < 4; ++m) _Pragma("unroll") for (int n = 0; n < 2; ++n) _Pragma("unroll") for (int k = 0; k < 2; ++k) \
        acc[ai][bj][m][n] = __builtin_amdgcn_mfma_f32_16x16x32_bf16(Bt[n][k], At[m][k], acc[ai][bj][m][n], 0, 0, 0); __builtin_amdgcn_s_setprio(0); } while (0)
#define PG8_WAIT_V(n) asm volatile("s_waitcnt vmcnt(" #n ")" ::: "memory")
#define PG8_WAIT_L(n) asm volatile("s_waitcnt lgkmcnt(" #n ")" ::: "memory")
#define PG8_BAR __builtin_amdgcn_s_barrier()
#define PG8_SCHED __builtin_amdgcn_sched_barrier(0)
    UnitV cur, nxt; int ui = 0;
    if (!S.next(0, cur)) return;
    f32x4 acc[2][2][4][2];
#pragma unroll
    for (int a = 0; a < 2; ++a)
#pragma unroll
        for (int b = 0; b < 2; ++b)
#pragma unroll
            for (int m = 0; m < 4; ++m)
#pragma unroll
                for (int n = 0; n < 2; ++n) acc[a][b][m][n] = (f32x4){0.f, 0.f, 0.f, 0.f};
    bf16x8 At[4][2], B0[2][2], B1[2][2];
    S.a_ready(cur);
    const char* cA = S.Abase(cur); const char* cB = S.Bbase(cur);
    unsigned ca0 = S.aoff(cur, 0, R0, C0), ca1 = S.aoff(cur, 0, R1, C1), ca2 = S.aoff(cur, 1, R0, C0), ca3 = S.aoff(cur, 1, R1, C1);
    unsigned cb0 = (unsigned)(Rb0 * cur.K + C0) * 2u, cb1 = (unsigned)(Rb1 * cur.K + C1) * 2u; size_t chs = (size_t)HALF * cur.K * 2;
    PG8_STAGE2(PG8_SB(0, 0), cB, cb0, cb1); PG8_STAGE2(PG8_SB(0, 1), cB + chs, cb0, cb1); PG8_STAGE2(PG8_SA(0, 0), cA, ca0, ca1); PG8_STAGE2(PG8_SA(0, 1), cA, ca2, ca3);
    if (wr == 1) PG8_BAR;
    PG8_WAIT_V(2); PG8_BAR;
    PG8_STAGE2(PG8_SB(1, 0), cB + kstep, cb0, cb1); PG8_STAGE2(PG8_SA(1, 0), cA + kstep, ca0, ca1); PG8_STAGE2(PG8_SB(1, 1), cB + chs + kstep, cb0, cb1);
    PG8_WAIT_V(6); PG8_BAR;
    for (;;) {
        const bool has_next = S.next(ui + 1, nxt);
        const char* nA = has_next ? S.Abase(nxt) : cA; const char* nB = has_next ? S.Bbase(nxt) : cB;
        unsigned na0 = ca0, na1 = ca1, na2 = ca2, na3 = ca3, nb0 = cb0, nb1 = cb1; size_t nhs = chs;
        if (has_next) { na0 = S.aoff(nxt, 0, R0, C0); na1 = S.aoff(nxt, 0, R1, C1); na2 = S.aoff(nxt, 1, R0, C0); na3 = S.aoff(nxt, 1, R1, C1);
            nb0 = (unsigned)(Rb0 * nxt.K + C0) * 2u; nb1 = (unsigned)(Rb1 * nxt.K + C1) * 2u; nhs = (size_t)HALF * nxt.K * 2; }
        const int nt = cur.K / BK;
        for (int t = 0; t < nt; t += 2) {
            const bool last = (t == nt - 2);
            if (last && has_next) S.a_ready(nxt);
            const char* a1 = cA + (size_t)(t + 1) * kstep;
            const char* a2 = last ? nA : cA + (size_t)(t + 2) * kstep; const char* b2 = last ? nB : cB + (size_t)(t + 2) * kstep;
            const char* a3 = a2 + kstep; const char* b3 = b2 + kstep;
            const unsigned s0 = last ? na0 : ca0, s1 = last ? na1 : ca1, s2 = last ? na2 : ca2, s3 = last ? na3 : ca3, sb0 = last ? nb0 : cb0, sb1 = last ? nb1 : cb1;
            const size_t shs = last ? nhs : chs;
            PG8_LDB(B0, 0, 0); PG8_LDB(B1, 0, 1); PG8_SCHED; PG8_LDA(At, 0, 0); PG8_STAGE2(PG8_SA(1, 1), a1, ca2, ca3);
            PG8_WAIT_V(8); PG8_WAIT_L(0); PG8_BAR; PG8_MMA(0, 0, At, B0); PG8_MMA(0, 1, At, B1); PG8_BAR; PG8_SCHED;
            PG8_LDA(At, 0, 1); PG8_STAGE2(PG8_SB(0, 0), b2, sb0, sb1); PG8_STAGE2(PG8_SB(0, 1), b2 + shs, sb0, sb1); PG8_STAGE2(PG8_SA(0, 0), a2, s0, s1);
            PG8_WAIT_V(8); PG8_WAIT_L(0); PG8_BAR; PG8_MMA(1, 0, At, B0); PG8_MMA(1, 1, At, B1); PG8_BAR; PG8_SCHED;
            PG8_LDB(B0, 1, 0); PG8_LDB(B1, 1, 1); PG8_SCHED; PG8_LDA(At, 1, 0); PG8_STAGE2(PG8_SA(0, 1), a2, s2, s3);
            PG8_WAIT_V(8); PG8_WAIT_L(0); PG8_BAR; PG8_MMA(0, 0, At, B0); PG8_MMA(0, 1, At, B1); PG8_BAR; PG8_SCHED;
            PG8_LDA(At, 1, 1); PG8_STAGE2(PG8_SB(1, 0), b3, sb0, sb1); PG8_STAGE2(PG8_SB(1, 1), b3 + shs, sb0, sb1); PG8_STAGE2(PG8_SA(1, 0), a3, s0, s1);
            PG8_WAIT_V(8); PG8_WAIT_L(0); PG8_BAR; PG8_MMA(1, 0, At, B0); PG8_MMA(1, 1, At, B1); PG8_BAR; PG8_SCHED;
        }
        if (wr == 0) PG8_BAR;
        E(acc, cur, wr, wc, fr, fq);
        S.done(cur, lane);
        if (!has_next) break;
#pragma unroll
        for (int a = 0; a < 2; ++a)
#pragma unroll
            for (int b = 0; b < 2; ++b)
#pragma unroll
                for (int m = 0; m < 4; ++m)
#pragma unroll
                    for (int n = 0; n < 2; ++n) acc[a][b][m][n] = (f32x4){0.f, 0.f, 0.f, 0.f};
        cur = nxt; cA = nA; cB = nB; ca0 = na0; ca1 = na1; ca2 = na2; ca3 = na3; cb0 = nb0; cb1 = nb1; chs = nhs; ++ui;
        if (wr == 1) PG8_BAR;
    }
    PG8_WAIT_V(0);
    PG8_BAR;
#undef PG8_SA
#undef PG8_SB
#undef PG8_STAGE2
#undef PG8_LDA
#undef PG8_LDB
#undef PG8_MMA
#undef PG8_WAIT_V
#undef PG8_WAIT_L
#undef PG8_BAR
#undef PG8_SCHED
}
struct MoeFusedSched {
    const char *XNp, *Hp, *W13p, *W2p; const int* lists; const LAS int* TS; const LAS int* CN; unsigned* ready; unsigned* tmo; int G, c;
    __device__ __forceinline__ bool next(int i, UnitV& u) const {
        const int TT = __builtin_amdgcn_readfirstlane(TS[32]); const int n = 4 * TT, q = n / G, rem = n - q * G;
        const int k1 = q + (c < rem ? 1 : 0);
        int v, kind;
        if (i < k1) { v = c + i * G; kind = 0; }
        else { const int j = i - k1, GL = rem > 0 ? G - rem : 0;
            if (rem > 0 && c >= rem) { v = (j < 2) ? (c - rem) + j * GL : 2 * GL + c + (j - 2) * G; }
            else v = 2 * GL + c + j * G;
            if (v >= n) return false; kind = 1; }
        const int mt = v >> 2; const int e = __builtin_amdgcn_readfirstlane(TS[768 - 256 + mt]);
        u.kind = kind; u.K = kind ? DE : D; u.mt = mt; u.e = e; u.rowbase = mt * BM; u.pn = v & 3;
        u.posbase = (mt - __builtin_amdgcn_readfirstlane(TS[e])) * BM; u.cnt = __builtin_amdgcn_readfirstlane(CN[e]); return true;
    }
    __device__ __forceinline__ const char* Abase(const UnitV& u) const { return u.kind ? Hp + (size_t)u.rowbase * DE * 2 : XNp; }
    __device__ __forceinline__ const char* Bbase(const UnitV& u) const { return u.kind ? W2p + ((size_t)u.e * 1024 + (size_t)u.pn * BM) * DE * 2 : W13p + ((size_t)u.e * 1024 + (size_t)u.pn * BM) * D * 2; }
    __device__ __forceinline__ unsigned aoff(const UnitV& u, int half, int R, int C) const {
        if (u.kind == 0) { const int pos = u.posbase + half * HALF + R; const int tok = pos < u.cnt ? lists[u.e * LCAP + pos] : 0; return (unsigned)(tok * D + C) * 2u; }
        return (unsigned)((half * HALF + R) * DE + C) * 2u;
    }
    __device__ __forceinline__ void a_ready(const UnitV& u) const {
        if (u.kind == 0) return;
        if (threadIdx.x < 64) {
            unsigned* w = ready + 64 * u.mt; unsigned sp = 0;
            while ((unsigned)__builtin_amdgcn_readfirstlane(__hip_atomic_load(w, __ATOMIC_RELAXED, __HIP_MEMORY_SCOPE_AGENT)) < 32u) {
                __builtin_amdgcn_s_sleep(2);
                if (++sp > (1u << 20)) { if (threadIdx.x == 0) __hip_atomic_store(tmo, 1u, __ATOMIC_RELAXED, __HIP_MEMORY_SCOPE_AGENT); break; } }
            __builtin_amdgcn_fence(__ATOMIC_ACQUIRE, "agent");
            asm volatile("s_waitcnt vmcnt(0)" ::: "memory");
        }
        asm volatile("" ::: "memory"); __builtin_amdgcn_s_barrier(); asm volatile("" ::: "memory");
    }
    __device__ __forceinline__ void done(const UnitV& u, int lane) const {
        if (u.kind != 0) return;
        asm volatile("s_waitcnt vmcnt(0)" ::: "memory");
        if (lane == 0) __hip_atomic_fetch_add(ready + 64 * u.mt, 1u, __ATOMIC_RELAXED, __HIP_MEMORY_SCOPE_AGENT);
    }
};
}

typedef f32x4 AccT[2][2][4][2];
#ifndef PAN_FLAGS
#define PAN_FLAGS 1
#endif
__device__ __forceinline__ void st16(bf16* base, size_t eoff, u32x4 o) {
#if PAN_FLAGS
    const auto rs = __builtin_amdgcn_make_buffer_rsrc((void*)base, (short)0, 0x7fffffff, 0x00020000);
    __builtin_amdgcn_raw_buffer_store_b128(o, rs, (int)(eoff * 2), 0, 16);
#else
    *(u32x4*)(base + eoff) = o;
#endif
}
struct EpiInProj {
    static constexpr bool PERM = true;
    bf16 *QG, *KG, *VG, *GG, *QN, *KN, *VN; const float *qnw, *knw;
    __device__ __forceinline__ void operator()(const AccT& acc, const pg8::Unit& u, int wr, int wc, int fr, int fq) const {
        const int pn = u.pn; const int row0 = u.rowbase + wr * 64 + fr;
        if (pn >= 6 && pn < 10) {
            const bool isq = pn < 8; bf16* O = isq ? QN : KN; const float* nw = isq ? qnw : knw; const float sc = isq ? 0.125f : 1.0f;
            f32x4 w[2][2];
#pragma unroll
            for (int bj = 0; bj < 2; ++bj)
#pragma unroll
                for (int n = 0; n < 2; ++n) w[bj][n] = *(const f32x4*)(nw + 32 * bj + 8 * fq + 4 * n) * sc;
#pragma unroll
            for (int ai = 0; ai < 2; ++ai)
#pragma unroll
                for (int m = 0; m < 4; ++m) {
                    float ss = 0.f;
#pragma unroll
                    for (int bj = 0; bj < 2; ++bj)
#pragma unroll
                        for (int n = 0; n < 2; ++n) { const f32x4 v = acc[ai][bj][m][n]; ss += (v[0] * v[0] + v[1] * v[1]) + (v[2] * v[2] + v[3] * v[3]); }
                    ss += __shfl_xor(ss, 16); ss += __shfl_xor(ss, 32);
                    const float rstd = 1.0f / sqrtf(ss * (1.0f / 64.0f) + EPS);
                    const size_t rowo = (size_t)(row0 + ai * 128 + m * 16) * 512 + ((pn & 1) * 4 + wc) * 64 + 8 * fq;
#pragma unroll
                    for (int bj = 0; bj < 2; ++bj) { const f32x4 v0 = acc[ai][bj][m][0] * rstd * w[bj][0], v1 = acc[ai][bj][m][1] * rstd * w[bj][1];
                        u32x4 o; o.x = cvt_pk_bf16(v0[0], v0[1]); o.y = cvt_pk_bf16(v0[2], v0[3]); o.z = cvt_pk_bf16(v1[0], v1[1]); o.w = cvt_pk_bf16(v1[2], v1[3]);
                        st16(O, rowo + bj * 32, o); }
                }
        } else {
            bf16* O; int ldc, colt; float sc = 1.0f;
            if (pn == 0) { O = QG; ldc = 256; colt = 0; sc = 0.125f; }
            else if (pn == 1) { O = KG; ldc = 256; colt = 0; }
            else if (pn < 4) { O = VG; ldc = 512; colt = (pn - 2) * 256; }
            else if (pn < 6) { O = GG; ldc = 512; colt = (pn - 4) * 256; }
            else { O = VN; ldc = 512; colt = (pn - 10) * 256; }
            const int col0 = colt + wc * 32 + 8 * fq;
#pragma unroll
            for (int ai = 0; ai < 2; ++ai)
#pragma unroll
                for (int m = 0; m < 4; ++m) { const size_t rowo = (size_t)(row0 + ai * 128 + m * 16) * ldc + col0;
#pragma unroll
                    for (int bj = 0; bj < 2; ++bj) { const f32x4 v0 = acc[ai][bj][m][0] * sc, v1 = acc[ai][bj][m][1] * sc;
                        u32x4 o; o.x = cvt_pk_bf16(v0[0], v0[1]); o.y = cvt_pk_bf16(v0[2], v0[3]); o.z = cvt_pk_bf16(v1[0], v1[1]); o.w = cvt_pk_bf16(v1[2], v1[3]);
                        st16(O, rowo + bj * 128, o); } }
        }
    }
};
struct EpiResid {
    static constexpr bool PERM = true;
    const float* basef; bf16* X; const float* g1;
    __device__ __forceinline__ void operator()(const AccT& acc, const pg8::Unit& u, int wr, int wc, int fr, int fq) const {
        const int row0 = u.rowbase + wr * 64 + fr, col0 = u.pn * 256 + wc * 32 + 8 * fq; const int b = u.rowbase >> 12;
        f32x4 g[2][2];
#pragma unroll
        for (int bj = 0; bj < 2; ++bj)
#pragma unroll
            for (int n = 0; n < 2; ++n) g[bj][n] = *(const f32x4*)(g1 + (size_t)b * MODW + col0 + bj * 128 + n * 4);
#pragma unroll
        for (int ai = 0; ai < 2; ++ai)
#pragma unroll
            for (int m = 0; m < 4; ++m) { const size_t off = (size_t)(row0 + ai * 128 + m * 16) * D + col0;
#pragma unroll
                for (int bj = 0; bj < 2; ++bj) {
                    f32x4 b0, b1;
                    if (basef) { b0 = *(const f32x4*)(basef + off + bj * 128); b1 = *(const f32x4*)(basef + off + bj * 128 + 4); }
                    else { const u32x4 w = *(const u32x4*)(X + off + bj * 128); b0 = (f32x4){bf_lo(w.x), bf_hi(w.x), bf_lo(w.y), bf_hi(w.y)}; b1 = (f32x4){bf_lo(w.z), bf_hi(w.z), bf_lo(w.w), bf_hi(w.w)}; }
                    const f32x4 v0 = b0 + g[bj][0] * acc[ai][bj][m][0], v1 = b1 + g[bj][1] * acc[ai][bj][m][1];
                    u32x4 o; o.x = cvtpk(v0[0], v0[1]); o.y = cvtpk(v0[2], v0[3]); o.z = cvtpk(v1[0], v1[1]); o.w = cvtpk(v1[2], v1[3]);
                    st16(X, off + bj * 128, o); } }
    }
};
struct EpiSwiGLU {
    static constexpr bool PERM = true;
    bf16* H;
    __device__ __forceinline__ void operator()(const AccT& acc, const pg8::Unit& u, int wr, int wc, int fr, int fq) const {
        const int row0 = u.rowbase + wr * 64 + fr, col0 = u.pn * 128 + wc * 32 + 8 * fq;
#pragma unroll
        for (int ai = 0; ai < 2; ++ai)
#pragma unroll
            for (int m = 0; m < 4; ++m) { bf16* rowp = H + (size_t)(row0 + ai * 128 + m * 16) * DE + col0;
                float r[8];
#pragma unroll
                for (int n = 0; n < 2; ++n)
#pragma unroll
                    for (int i = 0; i < 4; ++i) { const float a = acc[ai][0][m][n][i], b = acc[ai][1][m][n][i]; r[n * 4 + i] = a * sigmoidf_(a) * b; }
                u32x4 o; o.x = cvt_pk_bf16(r[0], r[1]); o.y = cvt_pk_bf16(r[2], r[3]); o.z = cvt_pk_bf16(r[4], r[5]); o.w = cvt_pk_bf16(r[6], r[7]);
                *(u32x4*)rowp = o; }
    }
};
struct EpiY {
    static constexpr bool PERM = true;
    bf16* Y;
    __device__ __forceinline__ void operator()(const AccT& acc, const pg8::Unit& u, int wr, int wc, int fr, int fq) const {
        const int row0 = u.rowbase + wr * 64 + fr, col0 = u.pn * 256 + wc * 32 + 8 * fq;
#pragma unroll
        for (int ai = 0; ai < 2; ++ai)
#pragma unroll
            for (int m = 0; m < 4; ++m) { bf16* rowp = Y + (size_t)(row0 + ai * 128 + m * 16) * D + col0;
#pragma unroll
                for (int bj = 0; bj < 2; ++bj) { const f32x4 v0 = acc[ai][bj][m][0], v1 = acc[ai][bj][m][1];
                    u32x4 o; o.x = cvt_pk_bf16(v0[0], v0[1]); o.y = cvt_pk_bf16(v0[2], v0[3]); o.z = cvt_pk_bf16(v1[0], v1[1]); o.w = cvt_pk_bf16(v1[2], v1[3]);
                    *(u32x4*)(rowp + bj * 128) = o; } }
    }
};


struct EpiMoe {
    static constexpr bool PERM = true;
    bf16* H; bf16* Y;
    __device__ __forceinline__ void operator()(const AccT& acc, const pg8::UnitV& u, int wr, int wc, int fr, int fq) const {
        const int row0 = u.rowbase + wr * 64 + fr;
        if (u.kind == 0) {
            const auto rs = __builtin_amdgcn_make_buffer_rsrc((void*)H, (short)0, 0x7fffffff, 0x00020000);
            const int col0 = u.pn * 128 + wc * 32 + 8 * fq;
#pragma unroll
            for (int ai = 0; ai < 2; ++ai)
#pragma unroll
                for (int m = 0; m < 4; ++m) {
                    float r[8];
#pragma unroll
                    for (int n = 0; n < 2; ++n)
#pragma unroll
                        for (int i = 0; i < 4; ++i) { const float a = acc[ai][0][m][n][i], b = acc[ai][1][m][n][i]; r[n * 4 + i] = a * sigmoidf_(a) * b; }
                    u32x4 o; o.x = cvtpk(r[0], r[1]); o.y = cvtpk(r[2], r[3]); o.z = cvtpk(r[4], r[5]); o.w = cvtpk(r[6], r[7]);
                    __builtin_amdgcn_raw_buffer_store_b128(o, rs, (int)(((row0 + ai * 128 + m * 16) * DE + col0) * 2), 0, 16); }
        } else {
            const int col0 = u.pn * 256 + wc * 32 + 8 * fq;
#pragma unroll
            for (int ai = 0; ai < 2; ++ai)
#pragma unroll
                for (int m = 0; m < 4; ++m) { bf16* rowp = Y + (size_t)(row0 + ai * 128 + m * 16) * D + col0;
#pragma unroll
                    for (int bj = 0; bj < 2; ++bj) { const f32x4 v0 = acc[ai][bj][m][0], v1 = acc[ai][bj][m][1];
                        u32x4 o; o.x = cvtpk(v0[0], v0[1]); o.y = cvtpk(v0[2], v0[3]); o.z = cvtpk(v1[0], v1[1]); o.w = cvtpk(v1[2], v1[3]);
                        *(u32x4*)(rowp + bj * 128) = o; } }
        }
    }
};

#define XB_TMO      128
#define XB_XCNT(j)  (256  + 64 * (j))
#define XB_XSUB(j)  (1280 + 64 * (j))
#define XB_XGEN(j)  (2304 + 64 * (j))
#define XB_TOP      3328
#define XB_TOPGEN   3392
#define XCD_BAR_WORDS 3456
#define XB_SPIN_CAP (1u << 18)
__device__ __forceinline__ unsigned xb_ld(unsigned* p)              { return __hip_atomic_load(p, __ATOMIC_RELAXED, __HIP_MEMORY_SCOPE_AGENT); }
__device__ __forceinline__ unsigned xb_add(unsigned* p, unsigned v) { return __hip_atomic_fetch_add(p, v, __ATOMIC_RELAXED, __HIP_MEMORY_SCOPE_AGENT); }
__device__ __forceinline__ unsigned xb_xcc_id() { return (unsigned)__builtin_amdgcn_s_getreg((3 << 11) | 20) & 0xFu; }
#define XB_SPIN(cond, bar) do { unsigned _sp = 0; while (cond) { __builtin_amdgcn_s_sleep(1); \
    if ((++_sp & 255u) == 0u) { if (xb_ld(&(bar)[XB_TMO])) break; if (_sp > XB_SPIN_CAP) { atomicAdd(&(bar)[XB_TMO], 1u); break; } } } } while (0)
struct XcdBarrier { unsigned* bar; unsigned x; volatile LAS unsigned* st; };
__device__ __forceinline__ XcdBarrier xcd_barrier_post(unsigned* bar, volatile LAS unsigned* st) {
    XcdBarrier b; b.bar = bar; b.x = xb_xcc_id(); b.st = st;
    if (threadIdx.x == 0) (void)xb_add(&bar[XB_XCNT(b.x)], 1u);
    return b;
}
__device__ __forceinline__ void xcd_barrier_complete(unsigned* bar, unsigned x, unsigned& nloc, unsigned& nx) {
    const unsigned G = gridDim.x * gridDim.y * gridDim.z;
    unsigned sum, cnt, mine, sp = 0u;
    for (;;) {
        sum = 0u; cnt = 0u; mine = 0u;
#pragma unroll
        for (unsigned j = 0; j < 16; ++j) { const unsigned c = xb_ld(&bar[XB_XCNT(j)]); sum += c; cnt += (c > 0u) ? 1u : 0u; mine = (j == x) ? c : mine; }
        if (sum == G) break;
        __builtin_amdgcn_s_sleep(1);
        if ((++sp & 255u) == 0u) { if (xb_ld(&bar[XB_TMO])) break; if (sp > XB_SPIN_CAP) { atomicAdd(&bar[XB_TMO], 1u); break; } }
    }
    nloc = mine > 0u ? mine : 1u; nx = cnt > 0u ? cnt : 1u;
}
__device__ __forceinline__ void xcd_barrier(const XcdBarrier& b) {
    asm volatile("s_waitcnt vmcnt(0)" ::: "memory");
    __syncthreads();
    if (threadIdx.x == 0) {
        unsigned* bar = b.bar;
        __builtin_amdgcn_s_waitcnt(0);
        unsigned nloc = b.st[0], nx = b.st[1];
        if (nloc == 0u) { xcd_barrier_complete(bar, b.x, nloc, nx); b.st[0] = nloc; b.st[1] = nx; }
        const unsigned old = xb_add(&bar[XB_XSUB(b.x)], 1u);
        const unsigned gen = old / nloc;
        if (old + 1u == (gen + 1u) * nloc) {
            __builtin_amdgcn_fence(__ATOMIC_RELEASE, "agent");
            asm volatile("s_waitcnt vmcnt(0)" ::: "memory");
            const unsigned og = xb_add(&bar[XB_TOP], 1u);
            const unsigned tg = og / nx;
            if (og + 1u == (tg + 1u) * nx) xb_add(&bar[XB_TOPGEN], 1u);
            else XB_SPIN(xb_ld(&bar[XB_TOPGEN]) == tg, bar);
            __builtin_amdgcn_fence(__ATOMIC_ACQUIRE, "agent");
            xb_add(&bar[XB_XGEN(b.x)], 1u);
            asm volatile("s_waitcnt vmcnt(0)" ::: "memory");
        } else {
            XB_SPIN(xb_ld(&bar[XB_XGEN(b.x)]) == gen, bar);
            __builtin_amdgcn_fence(__ATOMIC_ACQUIRE, "agent");
            asm volatile("s_waitcnt vmcnt(0)" ::: "memory");
        }
    }
    __syncthreads();
}

__device__ __forceinline__ void team_arrive(unsigned* w, int tid) {
    asm volatile("s_waitcnt vmcnt(0)" ::: "memory");
    __syncthreads();
    if (tid == 0) (void)xb_add(w, 1u);
}
__device__ __forceinline__ void team_wait(unsigned* w, unsigned target, unsigned* bar, int tid) {
    if (tid == 0) {
        XB_SPIN(xb_ld(w) < target, bar);
        __builtin_amdgcn_fence(__ATOMIC_ACQUIRE, "agent");
        asm volatile("s_waitcnt vmcnt(0)" ::: "memory");
    }
    __syncthreads();
}

__device__ __forceinline__ void panels_arrive(const pg8::DenseSched& S, unsigned* pw, int lane) {
    asm volatile("s_waitcnt vmcnt(0)" ::: "memory");
    pg8::Unit u;
    for (int i = 0; S.next(i, u); ++i) if (lane == 0) (void)xb_add(pw + (u.rowbase / pg8::BM) * 32, 1u);
}
__device__ __forceinline__ void panels_wait(unsigned* w, bool act, unsigned target, unsigned* bar, int tid) {
    if (tid < 64) {
        unsigned sp = 0;
        for (;;) {
            const bool ok = !act || xb_ld(w) >= target;
            if (__builtin_amdgcn_ballot_w64(!ok) == 0ull) break;
            __builtin_amdgcn_s_sleep(1);
            if ((++sp & 255u) == 0u) { if (xb_ld(&bar[XB_TMO])) break; if (sp > XB_SPIN_CAP) { if (tid == 0) atomicAdd(&bar[XB_TMO], 1u); break; } }
        }
        __builtin_amdgcn_fence(__ATOMIC_ACQUIRE, "agent");
        asm volatile("s_waitcnt vmcnt(0)" ::: "memory");
    }
    __syncthreads();
}

__device__ __forceinline__ void transpose_item(const float* W, int K, int N, bf16* WT, int drow0, int k0, int n0, LAS float* scr, int lane) {
#pragma unroll 8
    for (int i = 0; i < 32; ++i) { const int kk = 2 * i + (lane >> 5); scr[kk * 33 + (lane & 31)] = __builtin_nontemporal_load(W + (size_t)(k0 + kk) * N + n0 + (lane & 31)); }
    asm volatile("s_waitcnt lgkmcnt(0)" ::: "memory");
    const int c = lane & 7;
#pragma unroll
    for (int j = 0; j < 4; ++j) { const int n = (lane >> 3) + 8 * j; const LAS float* s = scr + (8 * c) * 33 + n;
        u32x4 o; o.x = pk2(s[0 * 33], s[1 * 33]); o.y = pk2(s[2 * 33], s[3 * 33]); o.z = pk2(s[4 * 33], s[5 * 33]); o.w = pk2(s[6 * 33], s[7 * 33]);
        __builtin_nontemporal_store(o, (u32x4*)(WT + (size_t)(drow0 + n) * K + k0 + 8 * c)); }
    asm volatile("s_waitcnt lgkmcnt(0)" ::: "memory");
}
__device__ __forceinline__ void phase_p0(const Ctx& F) {
    {
        LAS float* cact = (LAS float*)F.lds;
        LAS float* part = (LAS float*)(F.lds + 16384);
        for (int i = F.tid; i < NB * D; i += 512) { const int b = i >> 10, k = i & 1023; const float cv = F.c[i]; cact[k * 4 + b] = cv * sigmoidf_(cv); }
        __syncthreads();
        for (int item = F.vcu; item < 192; item += F.G) {
            const int l = item / 96, n0 = (item % 96) * 64;
            const float* W = F.w_ada + (size_t)l * D * MODW + n0 + F.lane;
            float a0 = 0.f, a1 = 0.f, a2 = 0.f, a3 = 0.f; const int k0 = F.wave * 128;
#pragma unroll 8
            for (int k = 0; k < 128; ++k) { const float w = __builtin_nontemporal_load(W + (size_t)(k0 + k) * MODW); const f32x4 cv = *(const LAS f32x4*)(cact + (k0 + k) * 4);
                a0 += cv[0] * w; a1 += cv[1] * w; a2 += cv[2] * w; a3 += cv[3] * w; }
            part[(F.wave * 4 + 0) * 64 + F.lane] = a0; part[(F.wave * 4 + 1) * 64 + F.lane] = a1; part[(F.wave * 4 + 2) * 64 + F.lane] = a2; part[(F.wave * 4 + 3) * 64 + F.lane] = a3;
            __syncthreads();
            if (F.tid < 256) { const int b = F.tid >> 6, ln = F.tid & 63; float s = 0.f;
#pragma unroll
                for (int w = 0; w < 8; ++w) s += part[(w * 4 + b) * 64 + ln];
                F.mod[(size_t)(l * 4 + b) * MODW + n0 + ln] = s + F.b_ada[l * MODW + n0 + ln]; }
            __syncthreads();
        }
    }
    {
        LAS float* scr = (LAS float*)(F.lds + 32768 + F.wave * 10240);
        const int gw = F.vcu * 8 + F.wave, NGW = F.G * 8;
        constexpr int I_IN = 2 * 16 * 97, I_OUT = 2 * 16 * 32, I_W1 = 2 * 32 * 256, I_W2 = 2 * 32 * 256;
        constexpr int NITEMS = I_IN + I_OUT;
        for (int it = gw; it < NITEMS; it += NGW) {
            int r = it;
            if (r < I_IN) {
                const int l = r / 1552, q = r % 1552, kb = q / 97, nb = q % 97; if (nb == 48) continue;
                const int n0 = 32 * nb; int drow0;
                if (n0 < 1536) drow0 = n0;
                else { const int np = n0 - 32, t = np >> 8, cl = np & 255;
                    if (t >= 6 && t < 10) { const int hh = cl >> 6, d0 = cl & 63; drow0 = t * 256 + (d0 >> 5) * 128 + hh * 32; } else drow0 = np; }
                transpose_item(F.w_in + (size_t)l * D * INW, D, INW, F.win_t + (size_t)l * NPROJ * D, drow0, kb * 64, n0, scr, F.lane); continue; }
            r -= I_IN;
            if (r < I_OUT) { const int l = r / 512, q = r % 512, kb = q / 32, nb = q % 32;
                transpose_item(F.w_out + (size_t)l * D * D, D, D, F.wout_t + (size_t)l * D * D, 32 * nb, kb * 64, 32 * nb, scr, F.lane); continue; }
        }
    }
}
__device__ __forceinline__ void conv_moe_items(const Ctx& F, int l, int lo, int hi);
__device__ __forceinline__ void phase_p0b(const Ctx& F) { if (!PH_EN12) { __syncthreads(); conv_moe_items(F, 0, 0, 24576); conv_moe_items(F, 1, 0, 24576); } }
__device__ __forceinline__ void conv_moe_items(const Ctx& F, int l, int lo, int hi) {
    LAS float* scr = (LAS float*)(F.lds + F.wave * 10240);
    const int gw = F.vcu * 8 + F.wave, NGW = F.G * 8;
    for (int it = lo + gw; it < hi; it += NGW) {
        const int which = it >> 13, q = it & 8191, e = q >> 8, qq = q & 255, le = l * 32 + e;
        if (which < 2) { const int kb = qq >> 4, nb = qq & 15, n0 = 32 * nb;
            const float* srcp = (which ? F.w3 : F.w1) + (size_t)le * D * DE;
            transpose_item(srcp, D, DE, F.w13_t + (size_t)le * 1024 * D, (n0 >> 7) * 256 + which * 128 + (n0 & 127), kb * 64, n0, scr, F.lane); }
        else { const int kb = qq >> 5, nb = qq & 31;
            transpose_item(F.w2 + (size_t)le * DE * D, DE, D, F.w2_t + (size_t)le * D * DE, 32 * nb, kb * 64, 32 * nb, scr, F.lane); }
    }
}

__device__ __forceinline__ void moe_tables(const Ctx& F, int lp) {
    LAS int* TS = (LAS int*)(F.lds + TAB_OFF); LAS int* CN = TS + 40;
    if (F.tid < 64) {
        const int e = F.lane & 31;
        const int c = (int)__hip_atomic_load((unsigned*)(F.ctl + CW_CNT + (lp * 32 + e) * 64), RLX_AGENT);
        const int nt = (c + 255) >> 8; int inc = nt;
#pragma unroll
        for (int o = 1; o < 32; o <<= 1) { const int v = __shfl_up(inc, o, 32); if (e >= o) inc += v; }
        if (F.lane < 32) { CN[e] = c; TS[e] = inc - nt; if (e == 31) TS[32] = inc; }
    }
    __syncthreads();
    if (F.tid < 192) { int e = 0;
#pragma unroll 8
        for (int k = 1; k < 32; ++k) e += (TS[k] <= F.tid) ? 1 : 0;
        ((LAS int*)(F.lds + LDSCTL_OFF + 3072))[F.tid] = e; }
    __syncthreads();
}

#ifndef PREPASS_V2
#define PREPASS_V2 1
#endif
template <int MODE>
__device__ __forceinline__ void prepass2(const Ctx& F, int l, float pa = 0.f, float pe = 0.f) {
    constexpr int TST = 1028, NG = NTOK / 16;
    LAS float* tile = (LAS float*)F.lds;
    LAS float* part = (LAS float*)(F.lds + 65792);
    LAS int* LCNT = (LAS int*)(F.lds + 82176); LAS int* BASE = LCNT + 32; LAS int* TREC = (LAS int*)(F.lds + 82432);
    const LAS int* TS = (const LAS int*)(F.lds + TAB_OFF);
    const bool comb = (MODE == 2) || (MODE == 0 && l > 0);
    const int lp = (MODE == 2) ? DEPTH - 1 : l - 1;
    if (comb) moe_tables(F, lp);
    if (MODE == 1) { if (F.tid < 32) LCNT[F.tid] = 0; }
    const int i16 = F.lane & 15, g = F.lane >> 4;
    const float* nw = ((MODE == 0) ? F.attn_norm : F.ffn_norm) + l * D;
    const bool srcf = (MODE == 0 && l == 0);
    f32x4 v[2][4]; u32x2 rw[2][4];
    int grp = F.vcu;
    auto load_rows0 = [&]() {   const int g0 = min(grp, NG - 1);
#pragma unroll
        for (int tt = 0; tt < 2; ++tt)
#pragma unroll
            for (int j = 0; j < 4; ++j) { const size_t o = (size_t)(g0 * 16 + F.wave * 2 + tt) * D + 256 * j + 4 * F.lane;
                if (srcf) { v[tt][j] = __builtin_nontemporal_load((const f32x4*)(F.x_in + o)); rw[tt][j] = (u32x2){0u, 0u}; } else { rw[tt][j] = *(const u32x2*)(F.Xb + o); v[tt][j] = (f32x4){0.f, 0.f, 0.f, 0.f}; } }
    };
    if (!(PAN_FLAGS && MODE == 1)) load_rows0();
    bf16x8 whi[4][2], wlo[4][2];
    if (MODE != 2) {
        const float* W32 = (MODE == 0) ? F.w_in + (size_t)l * D * INW + 1536 : F.router_w; const int wst = (MODE == 0) ? INW : 32;
#pragma unroll
        for (int ks = 0; ks < 4; ++ks)
#pragma unroll
            for (int nt = 0; nt < 2; ++nt) {
                float w[8];
#pragma unroll
                for (int jj = 0; jj < 8; ++jj) w[jj] = W32[(size_t)(128 * F.wave + 32 * ks + 8 * g + jj) * wst + 16 * nt + i16];
                u32x4 h, lo;
                h.x = cvtpk(w[0], w[1]); h.y = cvtpk(w[2], w[3]); h.z = cvtpk(w[4], w[5]); h.w = cvtpk(w[6], w[7]);
                lo.x = cvtpk(w[0] - bf_lo(h.x), w[1] - bf_hi(h.x)); lo.y = cvtpk(w[2] - bf_lo(h.y), w[3] - bf_hi(h.y));
                lo.z = cvtpk(w[4] - bf_lo(h.z), w[5] - bf_hi(h.z)); lo.w = cvtpk(w[6] - bf_lo(h.w), w[7] - bf_hi(h.w));
                whi[ks][nt] = __builtin_bit_cast(bf16x8, h); wlo[ks][nt] = __builtin_bit_cast(bf16x8, lo);
            }
    }
    if (PAN_FLAGS && MODE == 1) {
        const int gw = F.vcu + F.tid * F.G; const bool act = F.tid < 64 && gw < NG;
        panels_wait((unsigned*)(F.ctl + CW_PAN + ((l * 4 + 1) * 64 + (act ? gw >> 4 : 0)) * 32), act, 32u, (unsigned*)(F.ctl + CW_BAR), F.tid);
        load_rows0();
    }
    int gi = 0;
    for (; grp < NG; grp += F.G, ++gi) {
        if (!srcf) {
#pragma unroll
            for (int tt = 0; tt < 2; ++tt)
#pragma unroll
                for (int j = 0; j < 4; ++j) v[tt][j] = (f32x4){bf_lo(rw[tt][j].x), bf_hi(rw[tt][j].x), bf_lo(rw[tt][j].y), bf_hi(rw[tt][j].y)};
        }
        if (comb) {
            unsigned ti[2][6];
#pragma unroll
            for (int tt = 0; tt < 2; ++tt) { const unsigned* tp = F.tokinfo + (size_t)(grp * 16 + F.wave * 2 + tt) * 8;
#pragma unroll
                for (int q = 0; q < 6; ++q) ti[tt][q] = tp[q]; }
            u32x2 y0[2][4], y1[2][4];
#pragma unroll
            for (int tt = 0; tt < 2; ++tt) { const size_t s0 = (size_t)TS[ti[tt][0]] * 256 + ti[tt][1], s1 = (size_t)TS[ti[tt][2]] * 256 + ti[tt][3];
#pragma unroll
                for (int j = 0; j < 4; ++j) { y0[tt][j] = __builtin_nontemporal_load((const u32x2*)(F.Y + s0 * D + 256 * j + 4 * F.lane)); y1[tt][j] = __builtin_nontemporal_load((const u32x2*)(F.Y + s1 * D + 256 * j + 4 * F.lane)); } }
#pragma unroll
            for (int tt = 0; tt < 2; ++tt) { const int m = grp * 16 + F.wave * 2 + tt; const int b = m >> 12;
                const float gw0 = __builtin_bit_cast(float, ti[tt][4]), gw1 = __builtin_bit_cast(float, ti[tt][5]);
                const float* g2 = F.mod + (size_t)(lp * 4 + b) * MODW + 5 * D;
#pragma unroll
                for (int j = 0; j < 4; ++j) { const f32x4 gg = *(const f32x4*)(g2 + 256 * j + 4 * F.lane); const u32x2 a = y0[tt][j], c = y1[tt][j];
                    v[tt][j][0] += gg[0] * (gw0 * bf_lo(a.x) + gw1 * bf_lo(c.x)); v[tt][j][1] += gg[1] * (gw0 * bf_hi(a.x) + gw1 * bf_hi(c.x));
                    v[tt][j][2] += gg[2] * (gw0 * bf_lo(a.y) + gw1 * bf_lo(c.y)); v[tt][j][3] += gg[3] * (gw0 * bf_hi(a.y) + gw1 * bf_hi(c.y));
                    f32x4 o = v[tt][j];
                    if (MODE == 2) { if (pa != 0.f) { o[0] *= 1.f + pa; o[1] *= 1.f - pa; o[2] *= 1.f + pa; o[3] *= 1.f - pa; if (m == 0 && j == 0 && F.lane == 0) o[0] += pe; }
                        __builtin_nontemporal_store(o, (f32x4*)(F.out + (size_t)m * D + 256 * j + 4 * F.lane)); }
                    else { u32x2 ob; ob.x = cvtpk(o[0], o[1]); ob.y = cvtpk(o[2], o[3]); *(u32x2*)(F.Xb + (size_t)m * D + 256 * j + 4 * F.lane) = ob; } } }
        }
        if (MODE != 2) {
#pragma unroll
            for (int tt = 0; tt < 2; ++tt) { const int m = grp * 16 + F.wave * 2 + tt; const int b = m >> 12;
                float ss = 0.f;
#pragma unroll
                for (int j = 0; j < 4; ++j) ss += (v[tt][j][0] * v[tt][j][0] + v[tt][j][1] * v[tt][j][1]) + (v[tt][j][2] * v[tt][j][2] + v[tt][j][3] * v[tt][j][3]);
                const float rstd = 1.0f / sqrtf(wave_sum(ss) * (1.0f / D) + EPS);
                const float* scp = F.mod + (size_t)(l * 4 + b) * MODW + ((MODE == 0) ? 1 : 4) * D;
                const float* shp = F.mod + (size_t)(l * 4 + b) * MODW + ((MODE == 0) ? 0 : 3) * D;
#pragma unroll
                for (int j = 0; j < 4; ++j) { const int k = 256 * j + 4 * F.lane;
                    const f32x4 w = *(const f32x4*)(nw + k), sc = *(const f32x4*)(scp + k), sh = *(const f32x4*)(shp + k);
                    f32x4 hh;
#pragma unroll
                    for (int i = 0; i < 4; ++i) hh[i] = (v[tt][j][i] * rstd) * w[i] * (1.0f + sc[i]) + sh[i];
                    u32x2 o; o.x = cvtpk(hh[0], hh[1]); o.y = cvtpk(hh[2], hh[3]);
                    *(u32x2*)(F.XN + (size_t)m * D + k) = o;
                    *(LAS f32x4*)(tile + (F.wave * 2 + tt) * TST + k) = hh; } }
        }
        { const int ng = min(grp + F.G, NG - 1);
#pragma unroll
            for (int tt = 0; tt < 2; ++tt)
#pragma unroll
                for (int j = 0; j < 4; ++j) { const size_t o = (size_t)(ng * 16 + F.wave * 2 + tt) * D + 256 * j + 4 * F.lane;
                    if (srcf) v[tt][j] = __builtin_nontemporal_load((const f32x4*)(F.x_in + o)); else rw[tt][j] = *(const u32x2*)(F.Xb + o); } }
        if (MODE != 2) {
            __syncthreads();
            f32x4 acc0 = (f32x4){0.f, 0.f, 0.f, 0.f}, acc1 = (f32x4){0.f, 0.f, 0.f, 0.f};
#pragma unroll
            for (int ks = 0; ks < 4; ++ks) {
                const LAS float* ap = tile + i16 * TST + 128 * F.wave + 32 * ks + 8 * g;
                const f32x4 a0 = *(const LAS f32x4*)ap, a1 = *(const LAS f32x4*)(ap + 4);
                u32x4 h, lo;
                h.x = cvtpk(a0[0], a0[1]); h.y = cvtpk(a0[2], a0[3]); h.z = cvtpk(a1[0], a1[1]); h.w = cvtpk(a1[2], a1[3]);
                lo.x = cvtpk(a0[0] - bf_lo(h.x), a0[1] - bf_hi(h.x)); lo.y = cvtpk(a0[2] - bf_lo(h.y), a0[3] - bf_hi(h.y));
                lo.z = cvtpk(a1[0] - bf_lo(h.z), a1[1] - bf_hi(h.z)); lo.w = cvtpk(a1[2] - bf_lo(h.w), a1[3] - bf_hi(h.w));
                const bf16x8 ah = __builtin_bit_cast(bf16x8, h), al = __builtin_bit_cast(bf16x8, lo);
                acc0 = mfma16(ah, whi[ks][0], acc0); acc0 = mfma16(al, whi[ks][0], acc0); acc0 = mfma16(ah, wlo[ks][0], acc0);
                acc1 = mfma16(ah, whi[ks][1], acc1); acc1 = mfma16(al, whi[ks][1], acc1); acc1 = mfma16(ah, wlo[ks][1], acc1);
            }
#pragma unroll
            for (int r = 0; r < 4; ++r) { part[(F.wave * 16 + 4 * g + r) * 32 + i16] = acc0[r]; part[(F.wave * 16 + 4 * g + r) * 32 + 16 + i16] = acc1[r]; }
            __syncthreads();
            const int e = F.lane & 31, tok = F.wave * 2 + (F.lane >> 5); const int m = grp * 16 + tok;
            float logit = 0.f;
#pragma unroll
            for (int w = 0; w < 8; ++w) logit += part[(w * 16 + tok) * 32 + e];
            if (MODE == 0) F.lfb[(size_t)m * 32 + e] = logit;
            else {
                const float s = 1.0f / (1.0f + expf(-logit)); const float sl = s + F.router_b[e];
                int rank = 0;
#pragma unroll
                for (int k = 1; k < 8; ++k) { const int p = (F.lane & ~7) | ((F.lane + k) & 7); const float o = __shfl(sl, p); rank += (o > sl || (o == sl && (p & 7) < (F.lane & 7))) ? 1 : 0; }
                float gs = rank < 2 ? sl : 0.f; gs += __shfl_xor(gs, 1); gs += __shfl_xor(gs, 2); gs += __shfl_xor(gs, 4);
                const int hb = F.lane & 32;
                const float g0 = __shfl(gs, hb), g1 = __shfl(gs, hb + 8), g2 = __shfl(gs, hb + 16), g3 = __shfl(gs, hb + 24);
                int best = 0; float gb = g0; if (g1 > gb) { gb = g1; best = 1; } if (g2 > gb) { gb = g2; best = 2; } if (g3 > gb) { gb = g3; best = 3; }
                const unsigned long long mk0 = __ballot((e >> 3) == best && rank == 0), mk1 = __ballot((e >> 3) == best && rank == 1);
                const int e0 = __builtin_ctz((unsigned)(mk0 >> hb)), e1 = __builtin_ctz((unsigned)(mk1 >> hb));
                float gw0 = __shfl(s, hb + e0), gw1 = __shfl(s, hb + e1); const float gsum = gw0 + gw1; gw0 /= gsum; gw1 /= gsum;
                if (e == 0) {
                    const int lp0 = __hip_atomic_fetch_add(LCNT + e0, 1, __ATOMIC_RELAXED, __HIP_MEMORY_SCOPE_WORKGROUP);
                    const int lp1 = __hip_atomic_fetch_add(LCNT + e1, 1, __ATOMIC_RELAXED, __HIP_MEMORY_SCOPE_WORKGROUP);
                    const int lt = gi * 16 + tok;
                    TREC[lt * 4 + 0] = e0; TREC[lt * 4 + 1] = lp0; TREC[lt * 4 + 2] = e1; TREC[lt * 4 + 3] = lp1;
                    unsigned* ti = F.tokinfo + (size_t)m * 8;
                    ti[0] = (unsigned)e0; ti[2] = (unsigned)e1; ti[4] = __builtin_bit_cast(unsigned, gw0); ti[5] = __builtin_bit_cast(unsigned, gw1);
                }
            }
        }
    }
    if (MODE == 1) {
        __syncthreads();
        if (F.tid < 32) { const int c = LCNT[F.tid]; BASE[F.tid] = c > 0 ? (int)__hip_atomic_fetch_add((unsigned*)(F.ctl + CW_CNT + (l * 32 + F.tid) * 64), (unsigned)c, RLX_AGENT) : 0; }
        __syncthreads();
        const int ntl = gi * 16;
        for (int lt = F.tid; lt < ntl; lt += 512) { const int m = (F.vcu + (lt >> 4) * F.G) * 16 + (lt & 15);
            const int e0 = TREC[lt * 4 + 0], e1 = TREC[lt * 4 + 2]; const int p0 = BASE[e0] + TREC[lt * 4 + 1], p1 = BASE[e1] + TREC[lt * 4 + 3];
            unsigned* ti = F.tokinfo + (size_t)m * 8; ti[1] = (unsigned)p0; ti[3] = (unsigned)p1;
            F.lists[e0 * LCAP + p0] = m; F.lists[e1 * LCAP + p1] = m; }
    }
}

__device__ __forceinline__ void gla_front(const Ctx& F, int l, int h, int m0, LAS float* BF, LAS float* BR, LAS float* LFBT, LAS float* GWT, LAS float* GBT) {
    { const int tok = F.tid >> 3, c4 = F.tid & 7; *(LAS f32x4*)(LFBT + tok * 32 + c4 * 4) = *(const f32x4*)(F.lfb + (size_t)(m0 + tok) * 32 + c4 * 4); }
#pragma unroll
    for (int k = 0; k < 4; ++k) { const int idx = F.tid + 512 * k; const int dir = idx >> 10, r = (idx >> 6) & 15, d = idx & 63;
        GWT[idx] = F.gate_w[(size_t)((l * 2 + dir) * 16 + r) * 256 + h * 64 + d]; }
    if (F.tid < 128) { const int dir = F.tid >> 6, d = F.tid & 63; GBT[F.tid] = F.gate_b[(l * 2 + dir) * 256 + h * 64 + d]; }
    __syncthreads();
    for (int k = 0; k < 16; ++k) { const int idx = F.tid + 512 * k; const int dir = idx >> 12, i = (idx >> 6) & 63, d = idx & 63;
        float z = GBT[dir * 64 + d];
#pragma unroll
        for (int r = 0; r < 16; ++r) z += LFBT[i * 32 + dir * 16 + r] * GWT[(dir * 16 + r) * 64 + d];
        const float la = logsigf_(z) * (1.0f / 16.0f);
        (dir ? BR : BF)[i * 64 + d] = la; }
    __syncthreads();
    if (F.tid < 64) { const int d = F.tid; float run = 0.f; for (int i = 0; i < 64; ++i) { run += BF[i * 64 + d]; BF[i * 64 + d] = run; } }
    else if (F.tid < 128) { const int d = F.tid - 64; float run = 0.f; for (int i = 63; i >= 0; --i) { run += BR[i * 64 + d]; BR[i * 64 + d] = run; } }
    __syncthreads();
}
__device__ __forceinline__ void gla_a_item(const Ctx& F, int l, int it) {
    const int b = it >> 8, h = (it >> 6) & 3, c = it & 63, bh = b * 4 + h, m0 = b * T + c * 64;
    LAS float* BF = (LAS float*)F.lds; LAS float* BR = (LAS float*)(F.lds + 16384);
    LAS float* LFBT = (LAS float*)(F.lds + 32768); LAS float* GWT = (LAS float*)(F.lds + 40960); LAS float* GBT = (LAS float*)(F.lds + 49152);
    LAS bf16* KRAW = (LAS bf16*)(F.lds + 49664); LAS bf16* VRAW = (LAS bf16*)(F.lds + 57856);
    LAS float* KF = (LAS float*)(F.lds + 74240); LAS float* KB = (LAS float*)(F.lds + 90624);
    { const int tok = F.tid >> 3, ch = F.tid & 7; *(LAS u32x4*)(KRAW + tok * 64 + ch * 8) = *(const u32x4*)(F.KG + (size_t)(m0 + tok) * 256 + h * 64 + ch * 8); }
#pragma unroll
    for (int k = 0; k < 2; ++k) { const int idx = F.tid + 512 * k; const int tok = idx >> 4, ch = idx & 15;
        *(LAS u32x4*)(VRAW + tok * 128 + ch * 8) = *(const u32x4*)(F.VG + (size_t)(m0 + tok) * 512 + h * 128 + ch * 8); }
    gla_front(F, l, h, m0, BF, BR, LFBT, GWT, GBT);
#pragma unroll
    for (int k = 0; k < 8; ++k) { const int idx = F.tid + 512 * k; const int j = idx >> 6, d = idx & 63; const float kv = bf2f(KRAW[idx]);
        KF[idx] = kv * expf(BF[63 * 64 + d] - BF[j * 64 + d]); KB[idx] = kv * expf(BR[d] - BR[j * 64 + d]); }
    if (F.tid < 128) { const int dir = F.tid >> 6, d = F.tid & 63; F.gdec[(size_t)((bh * 2 + dir) * 64 + c) * 64 + d] = expf(dir ? BR[d] : BF[63 * 64 + d]); }
    __syncthreads();
    {
        const int dir = F.tid >> 8, tt = F.tid & 255, db = tt >> 4, eb = tt & 15;
        const LAS float* src = dir ? KB : KF;
        float acc[4][8];
#pragma unroll
        for (int a = 0; a < 4; ++a)
#pragma unroll
            for (int q = 0; q < 8; ++q) acc[a][q] = 0.f;
        for (int j = 0; j < 64; ++j) {
            const f32x4 kd = *(const LAS f32x4*)(src + j * 64 + db * 4); const u32x4 vv = *(const LAS u32x4*)(VRAW + j * 128 + eb * 8);
            float ve[8]; ve[0] = bf_lo(vv.x); ve[1] = bf_hi(vv.x); ve[2] = bf_lo(vv.y); ve[3] = bf_hi(vv.y); ve[4] = bf_lo(vv.z); ve[5] = bf_hi(vv.z); ve[6] = bf_lo(vv.w); ve[7] = bf_hi(vv.w);
#pragma unroll
            for (int a = 0; a < 4; ++a)
#pragma unroll
                for (int q = 0; q < 8; ++q) acc[a][q] += kd[a] * ve[q];
        }
        float* Ub = F.U + ((size_t)((bh * 2 + dir) * 64 + c) * 64) * 128;
#pragma unroll
        for (int a = 0; a < 4; ++a) { float* p = Ub + (size_t)(db * 4 + a) * 128 + eb * 8;
            *(f32x4*)p = (f32x4){acc[a][0], acc[a][1], acc[a][2], acc[a][3]}; *(f32x4*)(p + 4) = (f32x4){acc[a][4], acc[a][5], acc[a][6], acc[a][7]}; }
    }
    __syncthreads();
}
__device__ __forceinline__ void gla_b(const Ctx& F) {
    for (int id = F.vcu * 512 + F.tid; id < 32 * 2048; id += F.G * 512) {
        const int s = id >> 11, q4 = id & 2047, d = q4 >> 5, dir = s & 1;
        float* base = F.U + (size_t)s * 64 * 8192 + 4 * q4; const float* gd = F.gdec + (size_t)s * 64 * 64 + d;
        f32x4 S = (f32x4){0.f, 0.f, 0.f, 0.f};
#pragma unroll 8
        for (int step = 0; step < 64; ++step) { const int c = dir ? 63 - step : step;
            const f32x4 u = *(const f32x4*)(base + (size_t)c * 8192); const float g = gd[c * 64];
            *(f32x4*)(base + (size_t)c * 8192) = S; S = S * g + u; }
    }
}
__device__ __forceinline__ void gla_c_item(const Ctx& F, int l, int it) {
    const int b = it >> 8, h = (it >> 6) & 3, c = it & 63, bh = b * 4 + h, m0 = b * T + c * 64;
    LAS float* BF = (LAS float*)F.lds; LAS float* BR = (LAS float*)(F.lds + 17408); LAS float* P = BF;
    LAS float* LFBT = (LAS float*)(F.lds + 34816); LAS float* GWT = (LAS float*)(F.lds + 43008); LAS float* GBT = (LAS float*)(F.lds + 51200);
    LAS float* QF = (LAS float*)(F.lds + 51712); LAS float* QB = (LAS float*)(F.lds + 69120); LAS float* KF = (LAS float*)(F.lds + 86528); LAS float* KB = (LAS float*)(F.lds + 103936);
    LAS float* SST = KF;
    LAS bf16* VRAW = (LAS bf16*)(F.lds + 121344);
#pragma unroll
    for (int k = 0; k < 2; ++k) { const int idx = F.tid + 512 * k; const int tok = idx >> 4, ch = idx & 15;
        *(LAS u32x4*)(VRAW + tok * 128 + ch * 8) = *(const u32x4*)(F.VG + (size_t)(m0 + tok) * 512 + h * 128 + ch * 8); }
    gla_front(F, l, h, m0, BF, BR, LFBT, GWT, GBT);
#pragma unroll
    for (int k = 0; k < 8; ++k) { const int idx = F.tid + 512 * k; const int i = idx >> 6, d = idx & 63;
        const float qv = bf2f(F.QG[(size_t)(m0 + i) * 256 + h * 64 + d]), kv = bf2f(F.KG[(size_t)(m0 + i) * 256 + h * 64 + d]);
        const float bfv = BF[idx], brv = BR[idx];
        QF[i * 68 + d] = qv * expf(bfv); KF[i * 68 + d] = kv * expf(-bfv); QB[i * 68 + d] = qv * expf(brv); KB[i * 68 + d] = kv * expf(-brv); }
    __syncthreads();
    {
        float pf[8], pb[8];
#pragma unroll
        for (int ii = 0; ii < 8; ++ii) { pf[ii] = 0.f; pb[ii] = 0.f; }
        for (int d4 = 0; d4 < 16; ++d4) {
            const f32x4 kf4 = *(const LAS f32x4*)(KF + F.lane * 68 + d4 * 4), kb4 = *(const LAS f32x4*)(KB + F.lane * 68 + d4 * 4);
#pragma unroll
            for (int ii = 0; ii < 8; ++ii) { const f32x4 qf4 = *(const LAS f32x4*)(QF + (F.wave * 8 + ii) * 68 + d4 * 4), qb4 = *(const LAS f32x4*)(QB + (F.wave * 8 + ii) * 68 + d4 * 4);
                pf[ii] += (qf4[0] * kf4[0] + qf4[1] * kf4[1]) + (qf4[2] * kf4[2] + qf4[3] * kf4[3]);
                pb[ii] += (qb4[0] * kb4[0] + qb4[1] * kb4[1]) + (qb4[2] * kb4[2] + qb4[3] * kb4[3]); }
        }
        __syncthreads();
#pragma unroll
        for (int ii = 0; ii < 8; ++ii) { const int i = F.wave * 8 + ii; P[i * 68 + F.lane] = (F.lane <= i) ? pf[ii] : pb[ii]; }
    }
    __syncthreads();
    const int ib = F.tid >> 5, e4 = F.tid & 31;
    f32x4 acc[4];
#pragma unroll
    for (int ii = 0; ii < 4; ++ii) acc[ii] = (f32x4){0.f, 0.f, 0.f, 0.f};
#pragma unroll
    for (int k = 0; k < 4; ++k) { const int idx = F.tid + 512 * k; *(LAS f32x4*)(SST + idx * 4) = *(const f32x4*)(F.U + ((size_t)((bh * 2 + 0) * 64 + c) * 8192) + idx * 4); }
    for (int j4 = 0; j4 < 16; ++j4) {
        f32x4 p4[4];
#pragma unroll
        for (int ii = 0; ii < 4; ++ii) p4[ii] = *(const LAS f32x4*)(P + (ib * 4 + ii) * 68 + j4 * 4);
#pragma unroll
        for (int jj = 0; jj < 4; ++jj) { const u32x2 vv = *(const LAS u32x2*)(VRAW + (j4 * 4 + jj) * 128 + e4 * 4);
            const f32x4 v4 = (f32x4){bf_lo(vv.x), bf_hi(vv.x), bf_lo(vv.y), bf_hi(vv.y)};
#pragma unroll
            for (int ii = 0; ii < 4; ++ii) acc[ii] += v4 * p4[ii][jj]; }
    }
    __syncthreads();
    for (int d4 = 0; d4 < 16; ++d4) {
        f32x4 q4[4];
#pragma unroll
        for (int ii = 0; ii < 4; ++ii) q4[ii] = *(const LAS f32x4*)(QF + (ib * 4 + ii) * 68 + d4 * 4);
#pragma unroll
        for (int dd = 0; dd < 4; ++dd) { const f32x4 s4 = *(const LAS f32x4*)(SST + (d4 * 4 + dd) * 128 + e4 * 4);
#pragma unroll
            for (int ii = 0; ii < 4; ++ii) acc[ii] += s4 * q4[ii][dd]; }
    }
    __syncthreads();
#pragma unroll
    for (int k = 0; k < 4; ++k) { const int idx = F.tid + 512 * k; *(LAS f32x4*)(SST + idx * 4) = *(const f32x4*)(F.U + ((size_t)((bh * 2 + 1) * 64 + c) * 8192) + idx * 4); }
    __syncthreads();
    for (int d4 = 0; d4 < 16; ++d4) {
        f32x4 q4[4];
#pragma unroll
        for (int ii = 0; ii < 4; ++ii) q4[ii] = *(const LAS f32x4*)(QB + (ib * 4 + ii) * 68 + d4 * 4);
#pragma unroll
        for (int dd = 0; dd < 4; ++dd) { const f32x4 s4 = *(const LAS f32x4*)(SST + (d4 * 4 + dd) * 128 + e4 * 4);
#pragma unroll
            for (int ii = 0; ii < 4; ++ii) acc[ii] += s4 * q4[ii][dd]; }
    }
    const f32x4 gn = *(const f32x4*)(F.gla_norm + l * 128 + e4 * 4);
#pragma unroll
    for (int ii = 0; ii < 4; ++ii) {
        float ss = (acc[ii][0] * acc[ii][0] + acc[ii][1] * acc[ii][1]) + (acc[ii][2] * acc[ii][2] + acc[ii][3] * acc[ii][3]);
        ss += __shfl_xor(ss, 1); ss += __shfl_xor(ss, 2); ss += __shfl_xor(ss, 4); ss += __shfl_xor(ss, 8); ss += __shfl_xor(ss, 16);
        const float rstd = 1.0f / sqrtf(ss * (1.0f / 128.0f) + EPS);
        const int m = m0 + ib * 4 + ii;
        const u32x2 gg = *(const u32x2*)(F.GG + (size_t)m * 512 + h * 128 + e4 * 4);
        const float g0 = bf_lo(gg.x), g1 = bf_hi(gg.x), g2 = bf_lo(gg.y), g3 = bf_hi(gg.y);
        const float o0 = acc[ii][0] * rstd * gn[0] * (g0 * sigmoidf_(g0)), o1 = acc[ii][1] * rstd * gn[1] * (g1 * sigmoidf_(g1));
        const float o2 = acc[ii][2] * rstd * gn[2] * (g2 * sigmoidf_(g2)), o3 = acc[ii][3] * rstd * gn[3] * (g3 * sigmoidf_(g3));
        u32x2 o; o.x = pk2(o0, o1); o.y = pk2(o2, o3);
        *(u32x2*)(F.XN + (size_t)m * D + h * 128 + e4 * 4) = o;
    }
    __syncthreads();
}

__device__ __forceinline__ void natten_item(const Ctx& F, int l, int it) {
    const int b = it >> 9, hh = (it >> 6) & 7, r = it & 63;
    const int rs = min(max(r - 4, 0), 56); const int tok0 = b * T + rs * 64;
    LAS bf16* KT = (LAS bf16*)F.lds; LAS bf16* VT = (LAS bf16*)(F.lds + 65536); LAS float* RPB = (LAS float*)(F.lds + 131072);
#pragma unroll
    for (int k = 0; k < 8; ++k) { const int idx = F.tid + 512 * k; const int kk = idx >> 3, ch = idx & 7;
        *(LAS u32x4*)(KT + kk * 64 + ch * 8) = *(const u32x4*)(F.KN + (size_t)(tok0 + kk) * 512 + hh * 64 + ch * 8);
        *(LAS u32x4*)(VT + kk * 64 + ch * 8) = *(const u32x4*)(F.VN + (size_t)(tok0 + kk) * 512 + hh * 64 + ch * 8); }
    if (F.tid < 465) RPB[F.tid] = F.rpb[(size_t)(l * 8 + hh) * 465 + F.tid];
    __syncthreads();
    const int i = F.tid >> 3, dc = F.tid & 7; const int m = b * T + r * 64 + i; const int cs = min(max(i - 8, 0), 48);
    float qf[8];
    { const u32x4 q8 = *(const u32x4*)(F.QN + (size_t)m * 512 + hh * 64 + dc * 8);
      qf[0] = bf_lo(q8.x); qf[1] = bf_hi(q8.x); qf[2] = bf_lo(q8.y); qf[3] = bf_hi(q8.y); qf[4] = bf_lo(q8.z); qf[5] = bf_hi(q8.z); qf[6] = bf_lo(q8.w); qf[7] = bf_hi(q8.w); }
    float sc[16];
    const bool b4 = (dc & 4) != 0, b2 = (dc & 2) != 0, b1 = (dc & 1) != 0;
#pragma unroll
    for (int g = 0; g < 16; ++g) {
        float p[8];
#pragma unroll
        for (int t = 0; t < 8; ++t) { const int key = (g >> 1) * 64 + cs + (g & 1) * 8 + t; const u32x4 k8 = *(const LAS u32x4*)(KT + key * 64 + dc * 8);
            p[t] = (qf[0] * bf_lo(k8.x) + qf[1] * bf_hi(k8.x)) + (qf[2] * bf_lo(k8.y) + qf[3] * bf_hi(k8.y)) + (qf[4] * bf_lo(k8.z) + qf[5] * bf_hi(k8.z)) + (qf[6] * bf_lo(k8.w) + qf[7] * bf_hi(k8.w)); }
        float p4[4], p2[2];
#pragma unroll
        for (int t = 0; t < 4; ++t) { const float snd = b4 ? p[t] : p[t + 4]; const float rcv = __shfl_xor(snd, 4); p4[t] = (b4 ? p[t + 4] : p[t]) + rcv; }
#pragma unroll
        for (int t = 0; t < 2; ++t) { const float snd = b2 ? p4[t] : p4[t + 2]; const float rcv = __shfl_xor(snd, 2); p2[t] = (b2 ? p4[t + 2] : p4[t]) + rcv; }
        const float snd = b1 ? p2[0] : p2[1]; const float rcv = __shfl_xor(snd, 1); const float s = (b1 ? p2[1] : p2[0]) + rcv;
        const int kr = g >> 1, cc = (g & 1) * 8 + dc;
        sc[g] = s + RPB[(rs + kr - r + 7) * 31 + (cs + cc - i + 15)];
    }
    float mx = sc[0];
#pragma unroll
    for (int g = 1; g < 16; ++g) mx = fmaxf(mx, sc[g]);
    mx = fmaxf(mx, __shfl_xor(mx, 1)); mx = fmaxf(mx, __shfl_xor(mx, 2)); mx = fmaxf(mx, __shfl_xor(mx, 4));
    float sum = 0.f;
#pragma unroll
    for (int g = 0; g < 16; ++g) { sc[g] = expf(sc[g] - mx); sum += sc[g]; }
    sum += __shfl_xor(sum, 1); sum += __shfl_xor(sum, 2); sum += __shfl_xor(sum, 4);
    const float inv = 1.0f / sum;
    float o[8];
#pragma unroll
    for (int q = 0; q < 8; ++q) o[q] = 0.f;
    const int lbase = F.lane & ~7;
#pragma unroll
    for (int g = 0; g < 16; ++g)
#pragma unroll
        for (int t = 0; t < 8; ++t) { const float pk = __shfl(sc[g], lbase + t); const int key = (g >> 1) * 64 + cs + (g & 1) * 8 + t;
            const u32x4 v8 = *(const LAS u32x4*)(VT + key * 64 + dc * 8);
            o[0] += pk * bf_lo(v8.x); o[1] += pk * bf_hi(v8.x); o[2] += pk * bf_lo(v8.y); o[3] += pk * bf_hi(v8.y);
            o[4] += pk * bf_lo(v8.z); o[5] += pk * bf_hi(v8.z); o[6] += pk * bf_lo(v8.w); o[7] += pk * bf_hi(v8.w); }
    u32x4 ov; ov.x = pk2(o[0] * inv, o[1] * inv); ov.y = pk2(o[2] * inv, o[3] * inv); ov.z = pk2(o[4] * inv, o[5] * inv); ov.w = pk2(o[6] * inv, o[7] * inv);
    *(u32x4*)(F.XN + (size_t)m * D + 512 + hh * 64 + dc * 8) = ov;
    __syncthreads();
}


#ifndef GLA_V2
#define GLA_V2 1
#endif
#ifndef NATTEN_V2
#define NATTEN_V2 1
#endif
constexpr int KST = 80, VST = 144;
__device__ __forceinline__ void gla_gate_col(const Ctx& F, int l, int h) {
    LAS float* GWT = (LAS float*)(F.lds + 40960); LAS float* GBT = (LAS float*)(F.lds + 49152);
    __syncthreads();
#pragma unroll
    for (int k = 0; k < 4; ++k) { const int idx = F.tid + 512 * k; const int dir = idx >> 10, r = (idx >> 6) & 15, d = idx & 63;
        GWT[idx] = F.gate_w[(size_t)((l * 2 + dir) * 16 + r) * 256 + h * 64 + d]; }
    if (F.tid < 128) { const int dir = F.tid >> 6, d = F.tid & 63; GBT[F.tid] = F.gate_b[(l * 2 + dir) * 256 + h * 64 + d]; }
    __syncthreads();
}
__device__ __forceinline__ void gla_front2(const Ctx& F, int l, int h, int m0, LAS float* BF, LAS float* BR, LAS float* LFBT, LAS float* SEG) {
    const int dir = F.tid >> 8, sg = (F.tid >> 6) & 3, d = F.tid & 63;
    float gwr[16];
    { const LAS float* GWT = (const LAS float*)(F.lds + 40960);
#pragma unroll
      for (int r = 0; r < 16; ++r) gwr[r] = GWT[(dir * 16 + r) * 64 + d]; }
    const float gbv = ((const LAS float*)(F.lds + 49152))[dir * 64 + d];
    __syncthreads();
    float v[16];
#pragma unroll
    for (int q = 0; q < 16; ++q) {
        const LAS float* lp = LFBT + (sg * 16 + q) * 32 + dir * 16;
        const f32x4 a0 = *(const LAS f32x4*)lp, a1 = *(const LAS f32x4*)(lp + 4), a2 = *(const LAS f32x4*)(lp + 8), a3 = *(const LAS f32x4*)(lp + 12);
        float z = gbv;
        z += a0[0] * gwr[0]; z += a0[1] * gwr[1]; z += a0[2] * gwr[2]; z += a0[3] * gwr[3];
        z += a1[0] * gwr[4]; z += a1[1] * gwr[5]; z += a1[2] * gwr[6]; z += a1[3] * gwr[7];
        z += a2[0] * gwr[8]; z += a2[1] * gwr[9]; z += a2[2] * gwr[10]; z += a2[3] * gwr[11];
        z += a3[0] * gwr[12]; z += a3[1] * gwr[13]; z += a3[2] * gwr[14]; z += a3[3] * gwr[15];
        v[q] = (fminf(z, 0.f) - __logf(1.0f + __expf(-fabsf(z)))) * (1.0f / 16.0f);
    }
    float run = 0.f;
    if (dir == 0) {
#pragma unroll
        for (int q = 0; q < 16; ++q) { run += v[q]; v[q] = run; }
    } else {
#pragma unroll
        for (int q = 15; q >= 0; --q) { run += v[q]; v[q] = run; }
    }
    SEG[(dir * 4 + sg) * 64 + d] = run;
    __syncthreads();
    float pre = 0.f;
    if (dir == 0) { for (int s = 0; s < 4; ++s) if (s < sg) pre += SEG[s * 64 + d]; }
    else { for (int s = 0; s < 4; ++s) if (s > sg) pre += SEG[(4 + s) * 64 + d]; }
    LAS float* A = dir ? BR : BF;
#pragma unroll
    for (int q = 0; q < 16; ++q) A[(sg * 16 + q) * 64 + d] = v[q] + pre;
    __syncthreads();
}
struct GlaPre { u32x4 v0, v1, s0, s1, s2, s3; f32x4 lf, g1, g2, g3; unsigned bfp[4], brp[4]; };
__device__ __forceinline__ void gla_a2_load(const Ctx& F, int it, GlaPre& P) {
    const int b = it >> 8, h = (it >> 6) & 3, c = it & 63, m0 = b * T + c * 64;
    { const int tok = F.tid >> 4, ch = F.tid & 15; P.v0 = *(const u32x4*)(F.VG + (size_t)(m0 + tok) * 512 + h * 128 + ch * 8); P.v1 = *(const u32x4*)(F.VG + (size_t)(m0 + 32 + tok) * 512 + h * 128 + ch * 8); }
    { const int tok = F.tid >> 3, c4 = F.tid & 7; P.lf = *(const f32x4*)(F.lfb + (size_t)(m0 + tok) * 32 + c4 * 4); }
#pragma unroll
    for (int k = 0; k < 4; ++k) { P.bfp[k] = 0u; P.brp[k] = 0u; }
    P.s0 = P.s1 = P.s2 = P.s3 = (u32x4){0u, 0u, 0u, 0u}; P.g1 = P.g2 = P.g3 = (f32x4){0.f, 0.f, 0.f, 0.f};
}
__device__ __forceinline__ void gla_a2_item(const Ctx& F, int l, int it, GlaPre& P, int itn) {
    const int b = it >> 8, h = (it >> 6) & 3, c = it & 63, bh = b * 4 + h, m0 = b * T + c * 64;
    LAS float* BF = (LAS float*)F.lds; LAS float* BR = (LAS float*)(F.lds + 16384);
    LAS float* LFBT = (LAS float*)(F.lds + 32768); LAS float* GWT = (LAS float*)(F.lds + 40960); LAS float* GBT = (LAS float*)(F.lds + 49152);
    LAS bf16* KHF = (LAS bf16*)(F.lds + 49664); LAS bf16* KHB = (LAS bf16*)(F.lds + 59904); LAS bf16* VT = (LAS bf16*)(F.lds + 70144);
    LAS float* SEG = (LAS float*)(F.lds + 88576);
    { const int tok = F.tid >> 4, ch = F.tid & 15; *(LAS u32x4*)(VT + tok * VST + ch * 8) = P.v0; *(LAS u32x4*)(VT + (tok + 32) * VST + ch * 8) = P.v1; }
    { const int tok = F.tid >> 3, c4 = F.tid & 7; *(LAS f32x4*)(LFBT + tok * 32 + c4 * 4) = P.lf; }
    unsigned kraw[4];
#pragma unroll
    for (int k = 0; k < 4; ++k) { const int idx = F.tid + 512 * k; const int j = idx >> 5, d = (idx & 31) * 2; kraw[k] = *(const unsigned*)(F.KG + (size_t)(m0 + j) * 256 + h * 64 + d); }
    gla_a2_load(F, min(itn, 1023), P);
    gla_front2(F, l, h, m0, BF, BR, LFBT, SEG);
#pragma unroll
    for (int k = 0; k < 4; ++k) { const int idx = F.tid + 512 * k; const int j = idx >> 5, d = (idx & 31) * 2;
        const unsigned kk = kraw[k]; const float k0 = bf_lo(kk), k1 = bf_hi(kk);
        *(LAS unsigned*)(KHF + j * KST + d) = cvtpk(k0 * __expf(BF[63 * 64 + d] - BF[j * 64 + d]), k1 * __expf(BF[63 * 64 + d + 1] - BF[j * 64 + d + 1]));
        *(LAS unsigned*)(KHB + j * KST + d) = cvtpk(k0 * __expf(BR[d] - BR[j * 64 + d]), k1 * __expf(BR[d + 1] - BR[j * 64 + d + 1])); }
    if (F.tid < 128) { const int dir = F.tid >> 6, d = F.tid & 63; F.gdec[(size_t)((bh * 2 + dir) * 64 + c) * 64 + d] = __expf(dir ? BR[d] : BF[63 * 64 + d]); }
    {   unsigned* ob = (unsigned*)F.bfbr + (size_t)it * 4096;
#pragma unroll
        for (int k = 0; k < 2; ++k) { const int idx = F.tid + 512 * k; const f32x4 a = *(const LAS f32x4*)(BF + idx * 8), b = *(const LAS f32x4*)(BF + idx * 8 + 4);
            u32x4 o; o.x = pkh2(a[0], a[1]); o.y = pkh2(a[2], a[3]); o.z = pkh2(b[0], b[1]); o.w = pkh2(b[2], b[3]); __builtin_nontemporal_store(o, (u32x4*)(ob + idx * 4)); } }
    __syncthreads();
    {
        const int dir = F.wave >> 2, etq = F.wave & 3, i16 = F.lane & 15, g = F.lane >> 4;
        const LAS bf16* KH = dir ? KHB : KHF;
        f32x4 acc[4][2];
#pragma unroll
        for (int dt = 0; dt < 4; ++dt) { acc[dt][0] = (f32x4){0.f, 0.f, 0.f, 0.f}; acc[dt][1] = (f32x4){0.f, 0.f, 0.f, 0.f}; }
#pragma unroll
        for (int ks = 0; ks < 2; ++ks) {
            const int row0 = 32 * ks + 8 * g + (i16 >> 2), cc = 4 * (i16 & 3);
            bf16x8 vb[2];
#pragma unroll
            for (int e2 = 0; e2 < 2; ++e2) { const int et = etq * 2 + e2; vb[e2] = cat8(tr16(VT + row0 * VST + 16 * et + cc), tr16(VT + (row0 + 4) * VST + 16 * et + cc)); }
#pragma unroll
            for (int dt = 0; dt < 4; ++dt) { const bf16x8 ka = cat8(tr16(KH + row0 * KST + 16 * dt + cc), tr16(KH + (row0 + 4) * KST + 16 * dt + cc));
                acc[dt][0] = mfma16(ka, vb[0], acc[dt][0]); acc[dt][1] = mfma16(ka, vb[1], acc[dt][1]); }
        }
        bf16* Ub = F.UB + (size_t)((bh * 2 + dir) * 64 + c) * 8192;
#pragma unroll
        for (int dt = 0; dt < 4; ++dt)
#pragma unroll
            for (int e2 = 0; e2 < 2; ++e2) { u32x2 o; o.x = cvtpk(acc[dt][e2][0], acc[dt][e2][1]); o.y = cvtpk(acc[dt][e2][2], acc[dt][e2][3]);
                *(u32x2*)(Ub + (size_t)(16 * (etq * 2 + e2) + i16) * 64 + 16 * dt + 4 * g) = o; }
    }
    __syncthreads();
}
__device__ __forceinline__ void gla_b2(const Ctx& F) {
    const bf16* __restrict__ U = F.UB; bf16* __restrict__ SP = F.SP; const float* __restrict__ GD = F.gdec;
    for (int id = F.vcu * 512 + F.tid; id < 32 * 4096; id += F.G * 512) {
        const int s = id >> 12, q2 = id & 4095, d2 = (q2 & 31) * 2, dir = s & 1;
        const bf16* base = U + (size_t)s * 64 * 8192 + 2 * q2; bf16* ob = SP + (size_t)s * 64 * 8192 + 2 * q2; const float* gd = GD + (size_t)s * 64 * 64 + d2;
        float S0 = 0.f, S1 = 0.f;
#pragma unroll 16
        for (int step = 0; step < 64; ++step) { const int c = dir ? 63 - step : step;
            const unsigned uu = __builtin_nontemporal_load((const unsigned*)(base + (size_t)c * 8192)); const f32x2 g = *(const f32x2*)(gd + c * 64);
            *(unsigned*)(ob + (size_t)c * 8192) = cvtpk(S0, S1);
            S0 = S0 * g[0] + bf_lo(uu); S1 = S1 * g[1] + bf_hi(uu); }
    }
}
__device__ __forceinline__ void gla_c2_load(const Ctx& F, int it, GlaPre& P) {
    const int b = it >> 8, h = (it >> 6) & 3, c = it & 63, bh = b * 4 + h, m0 = b * T + c * 64;
    { const int tok = F.tid >> 4, ch = F.tid & 15; P.v0 = *(const u32x4*)(F.VG + (size_t)(m0 + tok) * 512 + h * 128 + ch * 8); P.v1 = *(const u32x4*)(F.VG + (size_t)(m0 + 32 + tok) * 512 + h * 128 + ch * 8); }
    { const int e = F.tid >> 3, ch = F.tid & 7; const bf16* sf = F.SP + (size_t)((bh * 2 + 0) * 64 + c) * 8192 + ch * 8; const bf16* sb = F.SP + (size_t)((bh * 2 + 1) * 64 + c) * 8192 + ch * 8;
      P.s0 = __builtin_nontemporal_load((const u32x4*)(sf + e * 64)); P.s1 = __builtin_nontemporal_load((const u32x4*)(sf + (e + 64) * 64)); P.s2 = __builtin_nontemporal_load((const u32x4*)(sb + e * 64)); P.s3 = __builtin_nontemporal_load((const u32x4*)(sb + (e + 64) * 64)); }
    P.lf = (f32x4){0.f, 0.f, 0.f, 0.f}; P.g1 = P.g2 = P.g3 = (f32x4){0.f, 0.f, 0.f, 0.f};
#pragma unroll
    for (int k = 0; k < 4; ++k) { const int idx = F.tid + 512 * k; const unsigned* p = (const unsigned*)F.bfbr + (size_t)it * 4096 + idx; P.bfp[k] = __builtin_nontemporal_load(p); P.brp[k] = __builtin_nontemporal_load(p + 2048); }
}
__device__ __forceinline__ void gla_c2_item(const Ctx& F, int l, int it, GlaPre& P, int itn) {
    const int b = it >> 8, h = (it >> 6) & 3, c = it & 63, bh = b * 4 + h, m0 = b * T + c * 64;
    LAS float* BF = (LAS float*)F.lds; LAS float* BR = (LAS float*)(F.lds + 16384);
    LAS float* LFBT = (LAS float*)(F.lds + 32768); LAS float* GWT = (LAS float*)(F.lds + 40960); LAS float* GBT = (LAS float*)(F.lds + 49152);
    LAS bf16* QF = (LAS bf16*)(F.lds + 49664); LAS bf16* QB = (LAS bf16*)(F.lds + 59904); LAS bf16* KF = (LAS bf16*)(F.lds + 70144); LAS bf16* KB = (LAS bf16*)(F.lds + 80384);
    LAS bf16* VT = (LAS bf16*)(F.lds + 90624);
    LAS bf16* SFT = (LAS bf16*)(F.lds + 109056); LAS bf16* SBT = (LAS bf16*)(F.lds + 129536);
    LAS float* SEG = (LAS float*)(F.lds + 150016); LAS float* SSX = SEG + 512;
    { const int tok = F.tid >> 4, ch = F.tid & 15; *(LAS u32x4*)(VT + tok * VST + ch * 8) = P.v0; *(LAS u32x4*)(VT + (tok + 32) * VST + ch * 8) = P.v1; }
    { const int e = F.tid >> 3, ch = F.tid & 7; *(LAS u32x4*)(SFT + e * KST + ch * 8) = P.s0; *(LAS u32x4*)(SFT + (e + 64) * KST + ch * 8) = P.s1;
      *(LAS u32x4*)(SBT + e * KST + ch * 8) = P.s2; *(LAS u32x4*)(SBT + (e + 64) * KST + ch * 8) = P.s3; }
    unsigned qraw[4], kraw[4]; f32x2 bfv[4], brv[4];
#pragma unroll
    for (int k = 0; k < 4; ++k) { const int idx = F.tid + 512 * k; const int i = idx >> 5, d = (idx & 31) * 2; bfv[k] = unh2(P.bfp[k]); brv[k] = unh2(P.brp[k]);
        qraw[k] = *(const unsigned*)(F.QG + (size_t)(m0 + i) * 256 + h * 64 + d); kraw[k] = *(const unsigned*)(F.KG + (size_t)(m0 + i) * 256 + h * 64 + d); }
    gla_c2_load(F, min(itn, 1023), P);
#pragma unroll
    for (int k = 0; k < 4; ++k) { const int idx = F.tid + 512 * k; const int i = idx >> 5, d = (idx & 31) * 2;
        const unsigned qq = qraw[k], kk = kraw[k];
        const float q0 = bf_lo(qq), q1 = bf_hi(qq), k0 = bf_lo(kk), k1 = bf_hi(kk);
        const float f0 = bfv[k][0], f1 = bfv[k][1], r0 = brv[k][0], r1 = brv[k][1];
        *(LAS unsigned*)(QF + i * KST + d) = cvtpk(q0 * __expf(f0), q1 * __expf(f1)); *(LAS unsigned*)(KF + i * KST + d) = cvtpk(k0 * __expf(-f0), k1 * __expf(-f1));
        *(LAS unsigned*)(QB + i * KST + d) = cvtpk(q0 * __expf(r0), q1 * __expf(r1)); *(LAS unsigned*)(KB + i * KST + d) = cvtpk(k0 * __expf(-r0), k1 * __expf(-r1)); }
    __syncthreads();
    const int itile = F.wave & 3, eh = F.wave >> 2, i16 = F.lane & 15, g = F.lane >> 4;
    bf16x8 qf[2], qb[2];
#pragma unroll
    for (int ks = 0; ks < 2; ++ks) { qf[ks] = *(const LAS bf16x8*)(QF + (16 * itile + i16) * KST + 32 * ks + 8 * g); qb[ks] = *(const LAS bf16x8*)(QB + (16 * itile + i16) * KST + 32 * ks + 8 * g); }
    f32x4 pt[4];
#pragma unroll
    for (int jt = 0; jt < 4; ++jt) {
        f32x4 pf = (f32x4){0.f, 0.f, 0.f, 0.f}, pb = (f32x4){0.f, 0.f, 0.f, 0.f};
#pragma unroll
        for (int ks = 0; ks < 2; ++ks) {
            const bf16x8 kf = *(const LAS bf16x8*)(KF + (16 * jt + i16) * KST + 32 * ks + 8 * g), kb = *(const LAS bf16x8*)(KB + (16 * jt + i16) * KST + 32 * ks + 8 * g);
            pf = mfma16(kf, qf[ks], pf); pb = mfma16(kb, qb[ks], pb); }
        const int iq = 16 * itile + i16;
#pragma unroll
        for (int r = 0; r < 4; ++r) pt[jt][r] = (16 * jt + 4 * g + r <= iq) ? pf[r] : pb[r];
    }
    const bf16x8 pp0 = pack8(pt[0], pt[1]), pp1 = pack8(pt[2], pt[3]);
    f32x4 acc[4];
#pragma unroll
    for (int e4 = 0; e4 < 4; ++e4) {
        const int et = eh * 4 + e4; f32x4 a = (f32x4){0.f, 0.f, 0.f, 0.f};
        const int rr = 4 * g + (i16 >> 2), cc = 16 * et + 4 * (i16 & 3);
        a = mfma16(cat8(tr16(VT + rr * VST + cc), tr16(VT + (rr + 16) * VST + cc)), pp0, a);
        a = mfma16(cat8(tr16(VT + (rr + 32) * VST + cc), tr16(VT + (rr + 48) * VST + cc)), pp1, a);
#pragma unroll
        for (int ks = 0; ks < 2; ++ks) {
            a = mfma16(*(const LAS bf16x8*)(SFT + (16 * et + i16) * KST + 32 * ks + 8 * g), qf[ks], a);
            a = mfma16(*(const LAS bf16x8*)(SBT + (16 * et + i16) * KST + 32 * ks + 8 * g), qb[ks], a); }
        acc[e4] = a;
    }
    float ss = 0.f;
#pragma unroll
    for (int e4 = 0; e4 < 4; ++e4) ss += (acc[e4][0] * acc[e4][0] + acc[e4][1] * acc[e4][1]) + (acc[e4][2] * acc[e4][2] + acc[e4][3] * acc[e4][3]);
    ss += __shfl_xor(ss, 16); ss += __shfl_xor(ss, 32);
    if (g == 0) SSX[eh * 64 + 16 * itile + i16] = ss;
    __syncthreads();
    const float rstd = 1.0f / sqrtf((SSX[16 * itile + i16] + SSX[64 + 16 * itile + i16]) * (1.0f / 128.0f) + EPS);
    const int m = m0 + 16 * itile + i16;
#pragma unroll
    for (int e4 = 0; e4 < 4; ++e4) {
        const int e0 = 16 * (eh * 4 + e4) + 4 * g;
        const f32x4 gn = *(const f32x4*)(F.gla_norm + l * 128 + e0);
        const u32x2 gg = *(const u32x2*)(F.GG + (size_t)m * 512 + h * 128 + e0);
        const float g0 = bf_lo(gg.x), g1 = bf_hi(gg.x), g2 = bf_lo(gg.y), g3 = bf_hi(gg.y);
        u32x2 o; o.x = cvtpk(acc[e4][0] * rstd * gn[0] * (g0 * sigmoidf_(g0)), acc[e4][1] * rstd * gn[1] * (g1 * sigmoidf_(g1)));
        o.y = cvtpk(acc[e4][2] * rstd * gn[2] * (g2 * sigmoidf_(g2)), acc[e4][3] * rstd * gn[3] * (g3 * sigmoidf_(g3)));
        *(u32x2*)(F.XN + (size_t)m * D + h * 128 + e0) = o;
    }
    __syncthreads();
}


#ifndef GLA_V3
#define GLA_V3 1
#endif
struct GlaPre3 { u32x4 vf0, vf1, vb0, vb1; f32x4 lf; };
__device__ __forceinline__ void gla_a3_load(const Ctx& F, int p, int j, int k, GlaPre3& P) {
    const int b = p >> 2, h = p & 3, mf = b * T + (4 * j + k) * 64, mb = b * T + (4 * j + 3 - k) * 64;
    { const int tok = F.tid >> 4, ch = F.tid & 15;
      P.vf0 = *(const u32x4*)(F.VG + (size_t)(mf + tok) * 512 + h * 128 + ch * 8); P.vf1 = *(const u32x4*)(F.VG + (size_t)(mf + 32 + tok) * 512 + h * 128 + ch * 8);
      P.vb0 = *(const u32x4*)(F.VG + (size_t)(mb + tok) * 512 + h * 128 + ch * 8); P.vb1 = *(const u32x4*)(F.VG + (size_t)(mb + 32 + tok) * 512 + h * 128 + ch * 8); }
    { const int tok = F.tid >> 3, c4 = F.tid & 7; P.lf = *(const f32x4*)(F.lfb + (size_t)((c4 < 4 ? mf : mb) + tok) * 32 + c4 * 4); }
}
__device__ __forceinline__ void gla_a3_group(const Ctx& F, int l, int gidx) {
    const int p = gidx >> 4, j = gidx & 15, b = p >> 2, h = p & 3;
    LAS float* BF = (LAS float*)F.lds; LAS float* BR = (LAS float*)(F.lds + 16384);
    LAS float* LFBT = (LAS float*)(F.lds + 32768);
    LAS bf16* KHF = (LAS bf16*)(F.lds + 49664); LAS bf16* KHB = (LAS bf16*)(F.lds + 59904);
    LAS bf16* VTF = (LAS bf16*)(F.lds + 70144); LAS bf16* VTB = (LAS bf16*)(F.lds + 88576);
    LAS float* SEG = (LAS float*)(F.lds + 107008);
    const int dir = F.wave >> 2, etq = F.wave & 3, i16 = F.lane & 15, g = F.lane >> 4;
    bf16* TB = F.SP; float* GT = (float*)(F.SP + (size_t)8 * 1024 * 1024);
    f32x4 R[4][2];
#pragma unroll
    for (int dt = 0; dt < 4; ++dt) { R[dt][0] = (f32x4){0.f, 0.f, 0.f, 0.f}; R[dt][1] = (f32x4){0.f, 0.f, 0.f, 0.f}; }
    float glog = 0.f;
    GlaPre3 P; gla_a3_load(F, p, j, 0, P);
    for (int k = 0; k < 4; ++k) {
        const int cf = 4 * j + k, cb = 4 * j + 3 - k, mf = b * T + cf * 64, mb = b * T + cb * 64, itf = p * 64 + cf, itb = p * 64 + cb;
        { const int tok = F.tid >> 4, ch = F.tid & 15;
          *(LAS u32x4*)(VTF + tok * VST + ch * 8) = P.vf0; *(LAS u32x4*)(VTF + (tok + 32) * VST + ch * 8) = P.vf1;
          *(LAS u32x4*)(VTB + tok * VST + ch * 8) = P.vb0; *(LAS u32x4*)(VTB + (tok + 32) * VST + ch * 8) = P.vb1; }
        { const int tok = F.tid >> 3, c4 = F.tid & 7; *(LAS f32x4*)(LFBT + tok * 32 + c4 * 4) = P.lf; }
        unsigned kfr[4], kbr[4];
#pragma unroll
        for (int q = 0; q < 4; ++q) { const int idx = F.tid + 512 * q; const int jr = idx >> 5, d = (idx & 31) * 2;
            kfr[q] = *(const unsigned*)(F.KG + (size_t)(mf + jr) * 256 + h * 64 + d); kbr[q] = *(const unsigned*)(F.KG + (size_t)(mb + jr) * 256 + h * 64 + d); }
        gla_a3_load(F, p, j, min(k + 1, 3), P);
        gla_front2(F, l, h, 0, BF, BR, LFBT, SEG);
#pragma unroll
        for (int q = 0; q < 4; ++q) { const int idx = F.tid + 512 * q; const int jr = idx >> 5, d = (idx & 31) * 2;
            const float f0 = bf_lo(kfr[q]), f1 = bf_hi(kfr[q]), r0 = bf_lo(kbr[q]), r1 = bf_hi(kbr[q]);
            *(LAS unsigned*)(KHF + jr * KST + d) = cvtpk(f0 * __expf(BF[63 * 64 + d] - BF[jr * 64 + d]), f1 * __expf(BF[63 * 64 + d + 1] - BF[jr * 64 + d + 1]));
            *(LAS unsigned*)(KHB + jr * KST + d) = cvtpk(r0 * __expf(BR[d] - BR[jr * 64 + d]), r1 * __expf(BR[d + 1] - BR[jr * 64 + d + 1])); }
        if (F.tid < 128) { const int dr = F.tid >> 6, d = F.tid & 63;
            F.gdec[(size_t)(dr ? itb : itf) * 128 + dr * 64 + d] = __expf(glog); glog += dr ? BR[d] : BF[63 * 64 + d]; }
#pragma unroll
        for (int q = 0; q < 2; ++q) { const int idx = F.tid + 512 * q; const f32x4 a = *(const LAS f32x4*)(BF + idx * 8), c = *(const LAS f32x4*)(BF + idx * 8 + 4);
            unsigned* ob = (unsigned*)F.bfbr + (size_t)(idx < 512 ? itf : itb) * 4096;
            u32x4 o; o.x = pkh2(a[0], a[1]); o.y = pkh2(a[2], a[3]); o.z = pkh2(c[0], c[1]); o.w = pkh2(c[2], c[3]); __builtin_nontemporal_store(o, (u32x4*)(ob + idx * 4)); }
        __syncthreads();
        {
            const LAS bf16* KH = dir ? KHB : KHF; const LAS bf16* VT = dir ? VTB : VTF;
            f32x4 acc[4][2];
#pragma unroll
            for (int dt = 0; dt < 4; ++dt) { acc[dt][0] = (f32x4){0.f, 0.f, 0.f, 0.f}; acc[dt][1] = (f32x4){0.f, 0.f, 0.f, 0.f}; }
#pragma unroll
            for (int ks = 0; ks < 2; ++ks) {
                const int row0 = 32 * ks + 8 * g + (i16 >> 2), cc = 4 * (i16 & 3);
                bf16x8 vb[2];
#pragma unroll
                for (int e2 = 0; e2 < 2; ++e2) { const int et = etq * 2 + e2; vb[e2] = cat8(tr16(VT + row0 * VST + 16 * et + cc), tr16(VT + (row0 + 4) * VST + 16 * et + cc)); }
#pragma unroll
                for (int dt = 0; dt < 4; ++dt) { const bf16x8 ka = cat8(tr16(KH + row0 * KST + 16 * dt + cc), tr16(KH + (row0 + 4) * KST + 16 * dt + cc));
                    acc[dt][0] = mfma16(ka, vb[0], acc[dt][0]); acc[dt][1] = mfma16(ka, vb[1], acc[dt][1]); }
            }
            bf16* Lb = F.UB + (size_t)((p * 2 + dir) * 64 + (dir ? cb : cf)) * 8192;
#pragma unroll
            for (int dt = 0; dt < 4; ++dt) {
                const f32x4 lg = *(const LAS f32x4*)((dir ? BR : BF + 63 * 64) + 16 * dt + 4 * g);
                const f32x4 gq = (f32x4){__expf(lg[0]), __expf(lg[1]), __expf(lg[2]), __expf(lg[3])};
#pragma unroll
                for (int e2 = 0; e2 < 2; ++e2) { u32x2 o; o.x = cvtpk(R[dt][e2][0], R[dt][e2][1]); o.y = cvtpk(R[dt][e2][2], R[dt][e2][3]);
                    *(u32x2*)(Lb + (size_t)(16 * (etq * 2 + e2) + i16) * 64 + 16 * dt + 4 * g) = o;
                    R[dt][e2] = R[dt][e2] * gq + acc[dt][e2]; } }
        }
        __syncthreads();
    }
    {   bf16* Tb = TB + (size_t)((p * 2 + dir) * 16 + j) * 8192;
#pragma unroll
        for (int dt = 0; dt < 4; ++dt)
#pragma unroll
            for (int e2 = 0; e2 < 2; ++e2) { u32x2 o; o.x = cvtpk(R[dt][e2][0], R[dt][e2][1]); o.y = cvtpk(R[dt][e2][2], R[dt][e2][3]);
                __hip_atomic_store((unsigned long long*)(Tb + (size_t)(16 * (etq * 2 + e2) + i16) * 64 + 16 * dt + 4 * g), (unsigned long long)o.x | ((unsigned long long)o.y << 32), RLX_AGENT); }
        if (F.tid < 128) { const int dr = F.tid >> 6, d = F.tid & 63; __hip_atomic_store((unsigned*)GT + (size_t)((p * 2 + dr) * 16 + j) * 64 + d, __float_as_uint(__expf(glog)), RLX_AGENT); }
    }
}
__device__ __forceinline__ void gla_b3(const Ctx& F) {
    const bf16* __restrict__ TB = F.SP; bf16* __restrict__ S0B = F.SP + (size_t)4 * 1024 * 1024; const float* __restrict__ GT = (const float*)(F.SP + (size_t)8 * 1024 * 1024);
    if (F.tid < 256)
    for (int id = F.vcu * 256 + F.tid; id < 32 * 2048; id += F.G * 256) {
        const int s = id >> 11, q4 = id & 2047, d4 = (q4 & 15) * 4, dir = s & 1;
        const bf16* base = TB + (size_t)s * 16 * 8192 + 4 * q4; bf16* ob = S0B + (size_t)s * 16 * 8192 + 4 * q4; const float* gd = GT + (size_t)s * 16 * 64 + d4;
        float S0 = 0.f, S1 = 0.f, S2 = 0.f, S3 = 0.f;
#pragma unroll
        for (int step = 0; step < 16; ++step) { const int jj = dir ? 15 - step : step;
            const u32x2 uu = *(const u32x2*)(base + (size_t)jj * 8192); const f32x4 gq = *(const f32x4*)(gd + jj * 64);
            __hip_atomic_store((unsigned long long*)(ob + (size_t)jj * 8192), (unsigned long long)cvtpk(S0, S1) | ((unsigned long long)cvtpk(S2, S3) << 32), RLX_AGENT);
            S0 = S0 * gq[0] + bf_lo(uu.x); S1 = S1 * gq[1] + bf_hi(uu.x); S2 = S2 * gq[2] + bf_lo(uu.y); S3 = S3 * gq[3] + bf_hi(uu.y); }
    }
}
__device__ __forceinline__ void pair16(const u32x2 (&o)[4], bool odd, u32x4& a, u32x4& b) {
    const u32x2 s0 = odd ? o[0] : o[1], s1 = odd ? o[2] : o[3], k0 = odd ? o[1] : o[0], k1 = odd ? o[3] : o[2];
    u32x2 r0, r1; r0.x = __shfl_xor(s0.x, 16); r0.y = __shfl_xor(s0.y, 16); r1.x = __shfl_xor(s1.x, 16); r1.y = __shfl_xor(s1.y, 16);
    a = odd ? (u32x4){r0.x, r0.y, k0.x, k0.y} : (u32x4){k0.x, k0.y, r0.x, r0.y};
    b = odd ? (u32x4){r1.x, r1.y, k1.x, k1.y} : (u32x4){k1.x, k1.y, r1.x, r1.y};
}
struct S0R { u32x4 a, b, c, d; };
__device__ __forceinline__ u32x4 s0_comb(u32x4 L, u32x4 Z, f32x4 g0, f32x4 g1) {
    u32x4 o;
    o.x = cvtpk(bf_lo(L.x) + g0[0] * bf_lo(Z.x), bf_hi(L.x) + g0[1] * bf_hi(Z.x)); o.y = cvtpk(bf_lo(L.y) + g0[2] * bf_lo(Z.y), bf_hi(L.y) + g0[3] * bf_hi(Z.y));
    o.z = cvtpk(bf_lo(L.z) + g1[0] * bf_lo(Z.z), bf_hi(L.z) + g1[1] * bf_hi(Z.z)); o.w = cvtpk(bf_lo(L.w) + g1[2] * bf_lo(Z.w), bf_hi(L.w) + g1[3] * bf_hi(Z.w));
    return o;
}
__device__ __forceinline__ void gla_c3_load(const Ctx& F, int it, GlaPre& P) {
    const int b = it >> 8, h = (it >> 6) & 3, c = it & 63, bh = b * 4 + h, m0 = b * T + c * 64;
    { const int tok = F.tid >> 4, ch = F.tid & 15; P.v0 = *(const u32x4*)(F.VG + (size_t)(m0 + tok) * 512 + h * 128 + ch * 8); P.v1 = *(const u32x4*)(F.VG + (size_t)(m0 + 32 + tok) * 512 + h * 128 + ch * 8); }
    { const int e = F.tid >> 3, ch = F.tid & 7; const bf16* sf = F.UB + (size_t)((bh * 2 + 0) * 64 + c) * 8192 + ch * 8; const bf16* sb = F.UB + (size_t)((bh * 2 + 1) * 64 + c) * 8192 + ch * 8;
      P.s0 = __builtin_nontemporal_load((const u32x4*)(sf + e * 64)); P.s1 = __builtin_nontemporal_load((const u32x4*)(sf + (e + 64) * 64)); P.s2 = __builtin_nontemporal_load((const u32x4*)(sb + e * 64)); P.s3 = __builtin_nontemporal_load((const u32x4*)(sb + (e + 64) * 64)); }
    { const int ch = F.tid & 7; const float* gp = F.gdec + (size_t)it * 128 + ch * 8; P.lf = *(const f32x4*)gp; P.g1 = *(const f32x4*)(gp + 4); P.g2 = *(const f32x4*)(gp + 64); P.g3 = *(const f32x4*)(gp + 68); }
#pragma unroll
    for (int k = 0; k < 4; ++k) { const int idx = F.tid + 512 * k; const unsigned* p = (const unsigned*)F.bfbr + (size_t)it * 4096 + idx; P.bfp[k] = __builtin_nontemporal_load(p); P.brp[k] = __builtin_nontemporal_load(p + 2048); }
}
__device__ __forceinline__ void gla_c3_item(const Ctx& F, int l, int it, GlaPre& P, int itn, const S0R& Z) {
    const int b = it >> 8, h = (it >> 6) & 3, c = it & 63, bh = b * 4 + h, m0 = b * T + c * 64;
    LAS float* BF = (LAS float*)F.lds; LAS float* BR = (LAS float*)(F.lds + 16384);
    LAS float* LFBT = (LAS float*)(F.lds + 32768); LAS float* GWT = (LAS float*)(F.lds + 40960); LAS float* GBT = (LAS float*)(F.lds + 49152);
    LAS bf16* QF = (LAS bf16*)(F.lds + 49664); LAS bf16* QB = (LAS bf16*)(F.lds + 59904); LAS bf16* KF = (LAS bf16*)(F.lds + 70144); LAS bf16* KB = (LAS bf16*)(F.lds + 80384);
    LAS bf16* VT = (LAS bf16*)(F.lds + 90624);
    LAS bf16* SFT = (LAS bf16*)(F.lds + 109056); LAS bf16* SBT = (LAS bf16*)(F.lds + 129536);
    LAS float* SEG = (LAS float*)(F.lds + 150016); LAS float* SSX = SEG + 512;
    { const int tok = F.tid >> 4, ch = F.tid & 15; *(LAS u32x4*)(VT + tok * VST + ch * 8) = P.v0; *(LAS u32x4*)(VT + (tok + 32) * VST + ch * 8) = P.v1; }
    { const int e = F.tid >> 3, ch = F.tid & 7;
      *(LAS u32x4*)(SFT + e * KST + ch * 8) = s0_comb(P.s0, Z.a, P.lf, P.g1); *(LAS u32x4*)(SFT + (e + 64) * KST + ch * 8) = s0_comb(P.s1, Z.b, P.lf, P.g1);
      *(LAS u32x4*)(SBT + e * KST + ch * 8) = s0_comb(P.s2, Z.c, P.g2, P.g3); *(LAS u32x4*)(SBT + (e + 64) * KST + ch * 8) = s0_comb(P.s3, Z.d, P.g2, P.g3); }
    unsigned qraw[4], kraw[4]; f32x2 bfv[4], brv[4];
#pragma unroll
    for (int k = 0; k < 4; ++k) { const int idx = F.tid + 512 * k; const int i = idx >> 5, d = (idx & 31) * 2; bfv[k] = unh2(P.bfp[k]); brv[k] = unh2(P.brp[k]);
        qraw[k] = *(const unsigned*)(F.QG + (size_t)(m0 + i) * 256 + h * 64 + d); kraw[k] = *(const unsigned*)(F.KG + (size_t)(m0 + i) * 256 + h * 64 + d); }
    gla_c3_load(F, min(itn, 1023), P);
#pragma unroll
    for (int k = 0; k < 4; ++k) { const int idx = F.tid + 512 * k; const int i = idx >> 5, d = (idx & 31) * 2;
        const unsigned qq = qraw[k], kk = kraw[k];
        const float q0 = bf_lo(qq), q1 = bf_hi(qq), k0 = bf_lo(kk), k1 = bf_hi(kk);
        const float f0 = bfv[k][0], f1 = bfv[k][1], r0 = brv[k][0], r1 = brv[k][1];
        *(LAS unsigned*)(QF + i * KST + d) = cvtpk(q0 * __expf(f0), q1 * __expf(f1)); *(LAS unsigned*)(KF + i * KST + d) = cvtpk(k0 * __expf(-f0), k1 * __expf(-f1));
        *(LAS unsigned*)(QB + i * KST + d) = cvtpk(q0 * __expf(r0), q1 * __expf(r1)); *(LAS unsigned*)(KB + i * KST + d) = cvtpk(k0 * __expf(-r0), k1 * __expf(-r1)); }
    __syncthreads();
    const int itile = F.wave & 3, eh = F.wave >> 2, i16 = F.lane & 15, g = F.lane >> 4;
    bf16x8 qf[2], qb[2];
#pragma unroll
    for (int ks = 0; ks < 2; ++ks) { qf[ks] = *(const LAS bf16x8*)(QF + (16 * itile + i16) * KST + 32 * ks + 8 * g); qb[ks] = *(const LAS bf16x8*)(QB + (16 * itile + i16) * KST + 32 * ks + 8 * g); }
    f32x4 pt[4];
#pragma unroll
    for (int jt = 0; jt < 4; ++jt) {
        f32x4 pf = (f32x4){0.f, 0.f, 0.f, 0.f}, pb = (f32x4){0.f, 0.f, 0.f, 0.f};
#pragma unroll
        for (int ks = 0; ks < 2; ++ks) {
            const bf16x8 kf = *(const LAS bf16x8*)(KF + (16 * jt + i16) * KST + 32 * ks + 8 * g), kb = *(const LAS bf16x8*)(KB + (16 * jt + i16) * KST + 32 * ks + 8 * g);
            pf = mfma16(kf, qf[ks], pf); pb = mfma16(kb, qb[ks], pb); }
        const int iq = 16 * itile + i16;
#pragma unroll
        for (int r = 0; r < 4; ++r) pt[jt][r] = (16 * jt + 4 * g + r <= iq) ? pf[r] : pb[r];
    }
    const bf16x8 pp0 = pack8(pt[0], pt[1]), pp1 = pack8(pt[2], pt[3]);
    f32x4 acc[4];
#pragma unroll
    for (int e4 = 0; e4 < 4; ++e4) {
        const int et = eh * 4 + e4; f32x4 a = (f32x4){0.f, 0.f, 0.f, 0.f};
        const int rr = 4 * g + (i16 >> 2), cc = 16 * et + 4 * (i16 & 3);
        a = mfma16(cat8(tr16(VT + rr * VST + cc), tr16(VT + (rr + 16) * VST + cc)), pp0, a);
        a = mfma16(cat8(tr16(VT + (rr + 32) * VST + cc), tr16(VT + (rr + 48) * VST + cc)), pp1, a);
#pragma unroll
        for (int ks = 0; ks < 2; ++ks) {
            a = mfma16(*(const LAS bf16x8*)(SFT + (16 * et + i16) * KST + 32 * ks + 8 * g), qf[ks], a);
            a = mfma16(*(const LAS bf16x8*)(SBT + (16 * et + i16) * KST + 32 * ks + 8 * g), qb[ks], a); }
        acc[e4] = a;
    }
    float ss = 0.f;
#pragma unroll
    for (int e4 = 0; e4 < 4; ++e4) ss += (acc[e4][0] * acc[e4][0] + acc[e4][1] * acc[e4][1]) + (acc[e4][2] * acc[e4][2] + acc[e4][3] * acc[e4][3]);
    ss += __shfl_xor(ss, 16); ss += __shfl_xor(ss, 32);
    if (g == 0) SSX[eh * 64 + 16 * itile + i16] = ss;
    __syncthreads();
    const float rstd = 1.0f / sqrtf((SSX[16 * itile + i16] + SSX[64 + 16 * itile + i16]) * (1.0f / 128.0f) + EPS);
    const int m = m0 + 16 * itile + i16;
    u32x2 ov[4];
#pragma unroll
    for (int e4 = 0; e4 < 4; ++e4) {
        const int e0 = 16 * (eh * 4 + e4) + 4 * g;
        const f32x4 gn = *(const f32x4*)(F.gla_norm + l * 128 + e0);
        const u32x2 gg = *(const u32x2*)(F.GG + (size_t)m * 512 + h * 128 + e0);
        const float g0 = bf_lo(gg.x), g1 = bf_hi(gg.x), g2 = bf_lo(gg.y), g3 = bf_hi(gg.y);
        u32x2 o; o.x = cvtpk(acc[e4][0] * rstd * gn[0] * (g0 * sigmoidf_(g0)), acc[e4][1] * rstd * gn[1] * (g1 * sigmoidf_(g1)));
        o.y = cvtpk(acc[e4][2] * rstd * gn[2] * (g2 * sigmoidf_(g2)), acc[e4][3] * rstd * gn[3] * (g3 * sigmoidf_(g3)));
#if PAN_FLAGS
        ov[e4] = o;
#else
        *(u32x2*)(F.XN + (size_t)m * D + h * 128 + e0) = o;
#endif
    }
#if PAN_FLAGS
    {   const bool odd = g & 1; u32x4 oa, ob; pair16(ov, odd, oa, ob);
        const size_t ro = (size_t)m * D + h * 128 + 16 * (eh * 4) + 4 * (g & 2);
        st16(F.XN, ro + (odd ? 16 : 0), oa); st16(F.XN, ro + (odd ? 48 : 32), ob); }
#endif
    __syncthreads();
}


__device__ __forceinline__ int na_rs(int r) { return min(max(r - 4, 0), 56); }
__device__ __forceinline__ void natten2_task(const Ctx& F, int l, int task) {
    const int b = task >> 6, hh = (task >> 3) & 7, seg = task & 7;
    LAS unsigned char* KR = F.lds; LAS unsigned char* VR = F.lds + 73728; LAS float* RPB = (LAS float*)(F.lds + 147456);
    const bf16* KNb = F.KN + (size_t)b * T * 512 + hh * 64; const bf16* VNb = F.VN + (size_t)b * T * 512 + hh * 64;
    if (F.tid < 465) RPB[F.tid] = F.rpb[(size_t)(l * 8 + hh) * 465 + F.tid];
    const int lkey = F.tid >> 3, lch = F.tid & 7;
    const int kdst = lkey * 128 + ((lch ^ (lkey & 7)) << 4), vdst = lkey * 128 + ((lch ^ (((lkey >> 1) & 3) << 1)) << 4);
    int Lhi = na_rs(seg * 8);
    {
        const int lo = Lhi, hi = na_rs(seg * 8 + 1) + 8;
        u32x4 tk[9], tv[9];
#pragma unroll
        for (int q = 0; q < 9; ++q) { const int gr = lo + q; if (gr < hi) {
            tk[q] = *(const u32x4*)(KNb + (size_t)(gr * 64 + lkey) * 512 + lch * 8); tv[q] = *(const u32x4*)(VNb + (size_t)(gr * 64 + lkey) * 512 + lch * 8); } }
#pragma unroll
        for (int q = 0; q < 9; ++q) { const int gr = lo + q; if (gr < hi) { const int slot = gr % 9;
            *(LAS u32x4*)(KR + slot * 8192 + kdst) = tk[q]; *(LAS u32x4*)(VR + slot * 8192 + vdst) = tv[q]; } }
        Lhi = hi;
    }
    __syncthreads();
    const int n = F.wave & 3, rp = F.wave >> 2, i16 = F.lane & 15, g = F.lane >> 4;
    const int bs = min(max(16 * n - 8, 0), 32);
    const int cq = 16 * n + i16, cs = min(max(cq - 8, 0), 48);
    bf16x8 qn0, qn1;
    { const size_t mq = (size_t)(b * T + (seg * 8 + rp) * 64 + cq) * 512 + hh * 64 + 8 * g; qn0 = *(const bf16x8*)(F.QN + mq); qn1 = *(const bf16x8*)(F.QN + mq + 32); }
    for (int step = 0; step < 4; ++step) {
        const int r0 = seg * 8 + step * 2, r = r0 + rp, rs = na_rs(r);
        u32x4 pk0, pk1, pv0, pv1; int nr0 = -1, nr1 = -1;
        if (step < 3) { const int hin = na_rs(r0 + 3) + 8; if (Lhi < hin) nr0 = Lhi; if (Lhi + 1 < hin) nr1 = Lhi + 1; }
        if (nr0 >= 0) { pk0 = *(const u32x4*)(KNb + (size_t)(nr0 * 64 + lkey) * 512 + lch * 8); pv0 = *(const u32x4*)(VNb + (size_t)(nr0 * 64 + lkey) * 512 + lch * 8); }
        if (nr1 >= 0) { pk1 = *(const u32x4*)(KNb + (size_t)(nr1 * 64 + lkey) * 512 + lch * 8); pv1 = *(const u32x4*)(VNb + (size_t)(nr1 * 64 + lkey) * 512 + lch * 8); }
        const int m = b * T + r * 64 + cq;
        bf16x8 qf[2]; qf[0] = qn0; qf[1] = qn1;
        if (step < 3) { const size_t mn = (size_t)(m + 128) * 512 + hh * 64 + 8 * g; qn0 = *(const bf16x8*)(F.QN + mn); qn1 = *(const bf16x8*)(F.QN + mn + 32); }
        f32x4 S[16];
#pragma unroll
        for (int t = 0; t < 16; ++t) {
            const int slot = (rs + (t >> 1)) % 9, kc = bs + (t & 1) * 16 + i16;
            const LAS unsigned char* kp = KR + slot * 8192 + kc * 128;
            f32x4 a = (f32x4){0.f, 0.f, 0.f, 0.f};
#pragma unroll
            for (int ks = 0; ks < 2; ++ks) a = mfma16(*(const LAS bf16x8*)(kp + (((4 * ks + g) ^ (kc & 7)) << 4)), qf[ks], a);
            S[t] = a;
        }
        float mx = -3.0e38f;
        {
            f32x4 bv[16];
            const LAS float* rb = RPB + (rs - r + 7) * 31 + (bs + 4 * g - cq + 15);
#pragma unroll
            for (int t = 0; t < 16; ++t)
#pragma unroll
                for (int rr = 0; rr < 4; ++rr) { const int co = (t & 1) * 16 + rr; const int cidx = min(max(bs + 4 * g - cq + 15 + co, 0), 30) - (bs + 4 * g - cq + 15);
                    bv[t][rr] = rb[(t >> 1) * 31 + cidx]; }
            __builtin_amdgcn_sched_barrier(0);
#pragma unroll
            for (int t = 0; t < 16; ++t)
#pragma unroll
                for (int rr = 0; rr < 4; ++rr) {
                    const int kcol = bs + (t & 1) * 16 + 4 * g + rr; const bool ok = (unsigned)(kcol - cs) < 16u;
                    const float v = ok ? S[t][rr] + bv[t][rr] : -1.0e30f;
                    S[t][rr] = v; mx = fmaxf(mx, v); }
        }
        mx = fmaxf(mx, __shfl_xor(mx, 16)); mx = fmaxf(mx, __shfl_xor(mx, 32));
        float sum = 0.f;
#pragma unroll
        for (int t = 0; t < 16; ++t)
#pragma unroll
            for (int rr = 0; rr < 4; ++rr) { const float p = __expf(S[t][rr] - mx); S[t][rr] = p; sum += p; }
        sum += __shfl_xor(sum, 16); sum += __shfl_xor(sum, 32);
        const float inv = 1.0f / sum;
        f32x4 o[4];
#pragma unroll
        for (int dt = 0; dt < 4; ++dt) o[dt] = (f32x4){0.f, 0.f, 0.f, 0.f};
#pragma unroll
        for (int pp = 0; pp < 8; ++pp) {
            const bf16x8 pf = pack8(S[2 * pp], S[2 * pp + 1]);
            const int slot = (rs + pp) % 9; const int key0 = bs + 4 * g + (i16 >> 2), key1 = key0 + 16;
            const LAS unsigned char* v0 = VR + slot * 8192 + key0 * 128; const LAS unsigned char* v1 = VR + slot * 8192 + key1 * 128;
            const int sw0 = ((key0 >> 1) & 3) << 1, sw1 = ((key1 >> 1) & 3) << 1, half = (i16 & 1) * 8, cpair = (i16 & 3) >> 1;
#pragma unroll
            for (int dt = 0; dt < 4; ++dt) {
                const int ch = 2 * dt + cpair;
                const bf16x8 vf = cat8(tr16(v0 + ((ch ^ sw0) << 4) + half), tr16(v1 + ((ch ^ sw1) << 4) + half));
                o[dt] = mfma16(vf, pf, o[dt]); }
        }
#if PAN_FLAGS
        {   u32x2 ov[4];
#pragma unroll
            for (int dt = 0; dt < 4; ++dt) { ov[dt].x = cvtpk(o[dt][0] * inv, o[dt][1] * inv); ov[dt].y = cvtpk(o[dt][2] * inv, o[dt][3] * inv); }
            const bool odd = g & 1; u32x4 oa, ob; pair16(ov, odd, oa, ob);
            const size_t ro = (size_t)m * D + 512 + hh * 64 + 4 * (g & 2);
            st16(F.XN, ro + (odd ? 16 : 0), oa); st16(F.XN, ro + (odd ? 48 : 32), ob); }
#else
#pragma unroll
        for (int dt = 0; dt < 4; ++dt) { u32x2 ov; ov.x = cvtpk(o[dt][0] * inv, o[dt][1] * inv); ov.y = cvtpk(o[dt][2] * inv, o[dt][3] * inv);
            *(u32x2*)(F.XN + (size_t)m * D + 512 + hh * 64 + 16 * dt + 4 * g) = ov; }
#endif
        __syncthreads();
        if (nr0 >= 0) { const int slot = nr0 % 9; *(LAS u32x4*)(KR + slot * 8192 + kdst) = pk0; *(LAS u32x4*)(VR + slot * 8192 + vdst) = pv0; Lhi = nr0 + 1; }
        if (nr1 >= 0) { const int slot = nr1 % 9; *(LAS u32x4*)(KR + slot * 8192 + kdst) = pk1; *(LAS u32x4*)(VR + slot * 8192 + vdst) = pv1; Lhi = nr1 + 1; }
        __syncthreads();
    }
}

__global__ void __launch_bounds__(512, 2) fwd_kernel(Args args) {
    extern __shared__ __attribute__((aligned(16))) unsigned char lds_raw[];
    Base B;
    B.lds = (LAS unsigned char*)lds_raw;
    B.tid = threadIdx.x; B.lane = B.tid & 63; B.wave = __builtin_amdgcn_readfirstlane(B.tid >> 6);
    B.G = gridDim.x; { const int bx = blockIdx.x; B.vcu = (B.G % 8 == 0) ? (bx % 8) * (B.G / 8) + bx / 8 : bx; }
    for (int u = B.tid; u < (LDS_BYTES - LDSCTL_OFF) / 4; u += 512) ((LAS unsigned*)(B.lds + LDSCTL_OFF))[u] = 0u;
    __syncthreads();
    volatile LAS unsigned* MISC = (volatile LAS unsigned*)(B.lds + MISC_OFF);
    unsigned* const barw = (unsigned*)(args.ws + WS_CTL) + CW_BAR;
    XcdBarrier bar; bar.bar = barw; bar.x = 0; bar.st = nullptr;
    const bool multi = (args.ph_hi - args.ph_lo) > 1;
    if (multi) bar = xcd_barrier_post(barw, MISC + 8);

#ifndef PHM
#define PHM 0xfff
#endif
#define PH_EN(bit) ((PHM >> (bit)) & 1)
#ifndef TPROBE
#define TPROBE 0
#endif
#ifndef TPA
#define TPA 0
#endif
#ifndef TPB
#define TPB 1
#endif
#if TPROBE
    volatile LAS unsigned long long* TBL = (volatile LAS unsigned long long*)(B.lds + LDSCTL_OFF + 2048);
    if (B.tid == 0) TBL[0] = __builtin_amdgcn_s_memrealtime();
#endif
#ifndef REPM
#define REPM 0
#endif
#ifndef REPN
#define REPN 3
#endif
#define NREP(bit, l) ((((REPM >> (bit)) & 1) && (l) == 0) ? REPN : 1)
    for (int ph = args.ph_lo; ph < args.ph_hi; ++ph) {
        if (ph == 0) { if (PH_EN(0)) { for (int rep = 0; rep < NREP(0, 0); ++rep) { const Ctx F = make_ctx(B); phase_p0(F); phase_p0b(F); __syncthreads(); } } }
        else if (ph == NPHASES - 1) { if (PH_EN(1)) for (int rep = 0; rep < NREP(1, 0); ++rep) { const Ctx F = make_ctx(B);
#if TPROBE
            __syncthreads();
            const float ia = (float)(TBL[TPA + 1] - TBL[TPA]) * 0.01f, ib = (float)(TBL[TPB + 1] - TBL[TPB]) * 0.01f;
            prepass2<2>(F, 0, sqrtf(ia * 1.0e-6f), 3.0f + ib * 0.03f);
#else
            prepass2<2>(F, 0);
#endif
            __syncthreads(); } }
        else {
            const int l = (ph - 1) / PPL, sp = (ph - 1) % PPL;
            if (sp == 0) { if (PH_EN(2)) { for (int rep = 0; rep < NREP(2, l); ++rep) { const Ctx F = make_ctx(B); prepass2<0>(F, l); __syncthreads(); } } }
            else if (sp == 1) { if (PH_EN(3)) for (int rep = 0; rep < NREP(3, l); ++rep) { const Ctx F = make_ctx(B);
                pg8::DenseSched S; S.init(F.XN, F.win_t + (size_t)l * NPROJ * D, NTOK, NPROJ, D, F.G, F.bx);
                EpiInProj E{F.QG, F.KG, F.VG, F.GG, F.QN, F.KN, F.VN, F.q_norm + l * 64, F.k_norm + l * 64};
                pg8::gemm_phase<EpiInProj, pg8::DenseSched>(F.lds, D, S, E, F.tid);
#if PAN_FLAGS
                panels_arrive(S, (unsigned*)(F.ctl + CW_PAN + (l * 4 + 0) * 64 * 32), F.lane);
#endif
            }
#if GLA_TEAM
            } else if (sp == 2) { const Ctx F = make_ctx(B);
                const bool team = (F.G == 256);
                unsigned* const tw = (unsigned*)(F.ctl + CW_TEAM + (l * 16 + (F.vcu >> 4)) * 64);
                { int curh = -1;
                  if (PH_EN(4)) for (int gidx = F.vcu; gidx < 256; gidx += F.G) { const int hq = (gidx >> 4) & 3; if (hq != curh) { gla_gate_col(F, l, hq); curh = hq; }
#if PAN_FLAGS
                    panels_wait((unsigned*)(F.ctl + CW_PAN + ((l * 4 + 0) * 64 + (gidx >> 6) * 16 + (gidx & 15)) * 32), F.tid == 0, 96u, barw, F.tid);
#endif
                    gla_a3_group(F, l, gidx); } }
                if (team) team_arrive(tw, F.tid);
                if (PH_EN(5)) for (int tk = F.vcu; tk < 256; tk += F.G) {
#if PAN_FLAGS
                    { const int b = tk >> 6, seg = tk & 7, p0 = na_rs(seg * 8) >> 2, p1 = (na_rs(seg * 8 + 7) + 7) >> 2;
                      panels_wait((unsigned*)(F.ctl + CW_PAN + ((l * 4 + 0) * 64 + b * 16 + min(p0 + F.tid, 15)) * 32), p0 + F.tid <= p1, 96u, barw, F.tid); }
#endif
                    natten2_task(F, l, tk);
#if PAN_FLAGS
                    asm volatile("s_waitcnt vmcnt(0)" ::: "memory");
                    if (F.lane == 0) { unsigned* pw = (unsigned*)(F.ctl + CW_PAN + ((l * 4 + 2) * 64 + (tk >> 6) * 16 + (tk & 7) * 2) * 32); (void)xb_add(pw, 1u); (void)xb_add(pw + 32, 1u); }
#endif
                }
                if (team) team_wait(tw, 16u, barw, F.tid); else xcd_barrier(bar);
                if (PH_EN(6)) gla_b3(F);
                if (team) { team_arrive(tw, F.tid); team_wait(tw, 32u, barw, F.tid); } else xcd_barrier(bar);
                if (PH_EN(7)) for (int gidx = F.vcu; gidx < 256; gidx += F.G) { const int p = gidx >> 4, j = gidx & 15; const bf16* S0B = F.SP + (size_t)4 * 1024 * 1024;
                    S0R Z; { const int e = F.tid >> 3, ch = F.tid & 7; const bf16* zf = S0B + (size_t)((p * 2 + 0) * 16 + j) * 8192 + ch * 8; const bf16* zb = S0B + (size_t)((p * 2 + 1) * 16 + j) * 8192 + ch * 8;
                        Z.a = *(const u32x4*)(zf + e * 64); Z.b = *(const u32x4*)(zf + (e + 64) * 64); Z.c = *(const u32x4*)(zb + e * 64); Z.d = *(const u32x4*)(zb + (e + 64) * 64); }
                    const int itb = p * 64 + 4 * j; GlaPre P; gla_c3_load(F, itb, P);
                    for (int k = 0; k < 4; ++k) gla_c3_item(F, l, itb + k, P, itb + min(k + 1, 3), Z);
#if PAN_FLAGS
                    asm volatile("s_waitcnt vmcnt(0)" ::: "memory");
                    if (F.lane == 0) (void)xb_add((unsigned*)(F.ctl + CW_PAN + ((l * 4 + 2) * 64 + (p >> 2) * 16 + j) * 32), 1u);
#endif
                }
            }
#else
            } else if (sp == 2) { const Ctx F = make_ctx(B);
#if GLA_V2 || NATTEN_V2
                if (PH_EN(12) && (F.vcu & 1)) { conv_moe_items(F, l, 0, 8192); __syncthreads(); }
                if (PH_EN(5)) for (int rep = 0; rep < NREP(5, l); ++rep) for (int tk = F.vcu; tk < 256; tk += F.G) {
#if NATTEN_V2
                    natten2_task(F, l, tk);
#else
                    for (int q = 0; q < 8; ++q) natten_item(F, l, ((tk >> 3) << 6) + (tk & 7) * 8 + q);
#endif
                }
                int curh = -1;
#if GLA_V3
                if (PH_EN(4)) for (int gidx = F.vcu; gidx < 256; gidx += F.G) { const int hq = (gidx >> 4) & 3; if (hq != curh) { gla_gate_col(F, l, hq); curh = hq; }
                    gla_a3_group(F, l, gidx); }
#else
                if (PH_EN(4)) for (int rep = 0; rep < NREP(4, l); ++rep) { GlaPre P; gla_a2_load(F, min(F.vcu, 1023), P);
                  for (int it = F.vcu; it < 1024; it += F.G) {
#if GLA_V2
                    { const int hq = (it >> 6) & 3; if (hq != curh) { gla_gate_col(F, l, hq); curh = hq; } }
                    gla_a2_item(F, l, it, P, it + F.G);
#else
                    gla_a_item(F, l, it);
#endif
                } }
#endif
                if (PH_EN(12) && !(F.vcu & 1)) { conv_moe_items(F, l, 0, 8192); __syncthreads(); }
#else
                for (int it = F.vcu; it < 3072; it += F.G) { if (it < 1024) { if (PH_EN(4)) for (int rep = 0; rep < NREP(4, l); ++rep) gla_a_item(F, l, it); } else { if (PH_EN(5)) for (int rep = 0; rep < NREP(5, l); ++rep) natten_item(F, l, it - 1024); } }
#endif
            } else if (sp == 3) { if (PH_EN(6)) for (int rep = 0; rep < NREP(6, l); ++rep) { const Ctx F = make_ctx(B);
                if (PH_EN(12) && (F.vcu & 1)) { conv_moe_items(F, l, 8192, 16384); __syncthreads(); }
#if GLA_V3
                gla_b3(F);
#elif GLA_V2
                gla_b2(F);
#else
                gla_b(F);
#endif
                if (PH_EN(12) && !(F.vcu & 1)) { conv_moe_items(F, l, 8192, 16384); __syncthreads(); }
            } }
            else if (sp == 4) { if (PH_EN(7)) for (int rep = 0; rep < NREP(7, l); ++rep) { const Ctx F = make_ctx(B);
                if (PH_EN(12) && (F.vcu & 1)) { conv_moe_items(F, l, 16384, 24576); __syncthreads(); }
#if GLA_V3
                for (int gidx = F.vcu; gidx < 256; gidx += F.G) { const int p = gidx >> 4, j = gidx & 15; const bf16* S0B = F.SP + (size_t)4 * 1024 * 1024;
                    S0R Z; { const int e = F.tid >> 3, ch = F.tid & 7; const bf16* zf = S0B + (size_t)((p * 2 + 0) * 16 + j) * 8192 + ch * 8; const bf16* zb = S0B + (size_t)((p * 2 + 1) * 16 + j) * 8192 + ch * 8;
                        Z.a = *(const u32x4*)(zf + e * 64); Z.b = *(const u32x4*)(zf + (e + 64) * 64); Z.c = *(const u32x4*)(zb + e * 64); Z.d = *(const u32x4*)(zb + (e + 64) * 64); }
                    const int itb = p * 64 + 4 * j; GlaPre P; gla_c3_load(F, itb, P);
                    for (int k = 0; k < 4; ++k) gla_c3_item(F, l, itb + k, P, itb + min(k + 1, 3), Z); }
#else
                int curh = -1; GlaPre P; gla_c2_load(F, min(F.vcu, 1023), P);
                for (int it = F.vcu; it < 1024; it += F.G) {
#if GLA_V2
                gla_c2_item(F, l, it, P, it + F.G);
#else
                gla_c_item(F, l, it);
#endif
                }
#endif
                if (PH_EN(12) && !(F.vcu & 1)) { conv_moe_items(F, l, 16384, 24576); __syncthreads(); } } }
#endif
            else if (sp == SP_OUT) { if (PH_EN(8)) for (int rep = 0; rep < NREP(8, l); ++rep) { const Ctx F = make_ctx(B);
                pg8::DenseSched S; S.init(F.XN, F.wout_t + (size_t)l * D * D, NTOK, D, D, F.G, F.bx);
#if PAN_FLAGS
                S.rdy = (unsigned*)(F.ctl + CW_PAN + (l * 4 + 2) * 64 * 32); S.need = 96u;
#endif
                EpiResid E{l == 0 ? F.x_in : nullptr, F.Xb, F.mod + (size_t)(l * 4) * MODW + 2 * D};
                pg8::gemm_phase<EpiResid, pg8::DenseSched>(F.lds, D, S, E, F.tid);
#if PAN_FLAGS
                panels_arrive(S, (unsigned*)(F.ctl + CW_PAN + (l * 4 + 1) * 64 * 32), F.lane);
#endif
            } } else if (sp == SP_OUT + 1) { if (PH_EN(9)) for (int rep = 0; rep < NREP(9, l); ++rep) { const Ctx F = make_ctx(B);
                prepass2<1>(F, l); __syncthreads(); } }
#if MOE_FUSED
            else if (sp == SP_OUT + 2) { if (PH_EN(10)) { const Ctx F = make_ctx(B);
                moe_tables(F, l);
                pg8::MoeFusedSched S; S.XNp = (const char*)F.XN; S.Hp = (const char*)F.H; S.W13p = (const char*)(F.w13_t + (size_t)l * NE * 1024 * D); S.W2p = (const char*)(F.w2_t + (size_t)l * NE * D * DE);
                S.lists = F.lists; S.TS = (const LAS int*)(F.lds + TAB_OFF); S.CN = S.TS + 40; S.ready = (unsigned*)(F.ctl + CW_RDY + l * 192 * 64); S.tmo = (unsigned*)(F.ctl + 2); S.G = F.G; S.c = F.vcu;
                EpiMoe E{F.H, F.Y};
                pg8::gemm_phase_v<EpiMoe, pg8::MoeFusedSched>(F.lds, S, E, F.tid);
            } }
#else
            else if (sp == SP_OUT + 2) { if (PH_EN(10)) for (int rep = 0; rep < NREP(10, l); ++rep) { const Ctx F = make_ctx(B);
                moe_tables(F, l);
                pg8::MoeSched<true> S; S.A = (const char*)F.XN; S.Bt = (const char*)(F.w13_t + (size_t)l * NE * 1024 * D); S.K = D; S.lists = F.lists;
                S.TS = (const LAS int*)(F.lds + TAB_OFF); S.CN = S.TS + 40; S.G = F.G; S.c = F.vcu;
                EpiSwiGLU E{F.H};
                pg8::gemm_phase<EpiSwiGLU, pg8::MoeSched<true>>(F.lds, D, S, E, F.tid);
            } } else { if (PH_EN(11)) for (int rep = 0; rep < NREP(11, l); ++rep) { const Ctx F = make_ctx(B);
                moe_tables(F, l);
                pg8::MoeSched<false> S; S.A = (const char*)F.H; S.Bt = (const char*)(F.w2_t + (size_t)l * NE * D * DE); S.K = DE; S.lists = F.lists;
                S.TS = (const LAS int*)(F.lds + TAB_OFF); S.CN = S.TS + 40; S.G = F.G; S.c = F.vcu;
                EpiY E{F.Y};
                pg8::gemm_phase<EpiY, pg8::MoeSched<false>>(F.lds, DE, S, E, F.tid);
            } }
#endif
        }
        bool gbar = ph + 1 < args.ph_hi;
#if PAN_FLAGS
        if (ph >= 1 && ph < NPHASES - 1) { const int spx = (ph - 1) % PPL; if (spx == 1 || spx == 2 || spx == SP_OUT) gbar = false; }
#endif
        if (gbar) { xcd_barrier(bar); if ((REPM >> 12) & 1) { xcd_barrier(bar); xcd_barrier(bar); } }
#if TPROBE
        if (B.tid == 0) TBL[ph + 1] = __builtin_amdgcn_s_memrealtime();
#endif
    }
}

extern "C" void kernel_launch(void* const* d_in, const int* in_sizes, int n_in, void* d_out, int out_size, void* d_ws, size_t ws_size, hipStream_t stream) {
    static int grid = 0;
    if (grid == 0) {
        if (n_in != 19 || in_sizes[0] != NTOK * D || out_size != NTOK * D || ws_size < WS_END) {
            fprintf(stderr, "kernel_launch: unexpected shapes (n_in %d, in0 %d, out %d, ws %zu, need %zu); nothing launched\n", n_in, n_in > 0 ? in_sizes[0] : -1, out_size, ws_size, (size_t)WS_END); grid = -1; return; }
        int dev = 0, cus = 0;
        if (hipGetDevice(&dev) != hipSuccess || hipDeviceGetAttribute(&cus, hipDeviceAttributeMultiprocessorCount, dev) != hipSuccess) { fprintf(stderr, "kernel_launch: device query failed\n"); grid = -1; return; }
        if (hipFuncSetAttribute((const void*)fwd_kernel, hipFuncAttributeMaxDynamicSharedMemorySize, LDS_BYTES) != hipSuccess) { fprintf(stderr, "kernel_launch: hipFuncSetAttribute failed\n"); grid = -1; return; }
        (void)hipGetLastError();
        grid = cus;
    }
    if (grid < 0) return;
    if (hipMemsetAsync((char*)d_ws + WS_CTL, 0, CTL_ZERO_BYTES, stream) != hipSuccess) { fprintf(stderr, "kernel_launch: memset failed\n"); return; }
    Args a{};
    for (int i = 0; i < 19; ++i) a.in[i] = (const float*)d_in[i];
    a.out = (float*)d_out; a.ws = (unsigned char*)d_ws;
#if MK_PER_PHASE
    for (int ph = 0; ph < NPHASES; ++ph) { a.ph_lo = ph; a.ph_hi = ph + 1; hipLaunchKernelGGL(fwd_kernel, dim3(grid), dim3(512), LDS_BYTES, stream, a); }
#else
    a.ph_lo = 0; a.ph_hi = NPHASES;
    hipLaunchKernelGGL(fwd_kernel, dim3(grid), dim3(512), LDS_BYTES, stream, a);
#endif
    const hipError_t le = hipPeekAtLastError();
    if (le != hipSuccess) fprintf(stderr, "kernel_launch: launch failed: %s\n", hipGetErrorName(le));
}
```

```cpp
#include <hip/hip_runtime.h>
#include <cstdio>
#include <cstdint>

#ifndef MK_PER_PHASE
#define MK_PER_PHASE 0
#endif

#define LAS __attribute__((address_space(3)))
#define GAS __attribute__((address_space(1)))
typedef unsigned short bf16;
typedef short bf16x8 __attribute__((ext_vector_type(8)));
typedef float f32x4 __attribute__((ext_vector_type(4)));
typedef float f32x2 __attribute__((ext_vector_type(2)));
typedef unsigned u32x4 __attribute__((ext_vector_type(4)));
typedef unsigned u32x2 __attribute__((ext_vector_type(2)));
typedef GAS unsigned gu32;

constexpr int NB = 4, T = 4096, D = 1024, NTOK = NB * T, DEPTH = 2, INW = 3104, NPROJ = 3072, MODW = 6144;
constexpr int NE = 32, DE = 512, LCAP = 16384;
constexpr float EPS = 1e-6f;
#ifndef MOE_FUSED
#define MOE_FUSED 1
#endif
#ifndef GLA_TEAM
#define GLA_TEAM 1
#endif
constexpr int PPL = (MOE_FUSED ? 8 : 9) - (GLA_TEAM ? 2 : 0);
constexpr int SP_OUT = GLA_TEAM ? 3 : 5;
constexpr int NPHASES = 2 + 2 * PPL;

constexpr size_t MiB = 1u << 20;
constexpr size_t WS_CTL = 0, CTL_ZERO_BYTES = 256 * 1024;
constexpr size_t WS_MOD = 1 * MiB;
constexpr size_t WS_LFB = 2 * MiB;
constexpr size_t WS_TOKINFO = 4 * MiB;
constexpr size_t WS_GDEC = 4 * MiB + 512 * 1024;
constexpr size_t WS_LISTS = 5 * MiB;
constexpr size_t WS_W32T = 7 * MiB;
constexpr size_t WS_WIN = 8 * MiB;
constexpr size_t WS_WOUT = 20 * MiB;
constexpr size_t WS_W13 = 24 * MiB;
constexpr size_t WS_W2 = 152 * MiB;
constexpr size_t WS_XN = 216 * MiB;
constexpr size_t WS_X = 248 * MiB;
constexpr size_t WS_QG = 312 * MiB, WS_KG = 320 * MiB, WS_VG = 328 * MiB, WS_GG = 344 * MiB, WS_QN = 360 * MiB, WS_KN = 376 * MiB, WS_VN = 392 * MiB;
constexpr size_t WS_U = 408 * MiB;
constexpr size_t WS_BFBR = 440 * MiB;
constexpr size_t WS_H = 312 * MiB;
constexpr size_t WS_Y = 352 * MiB;
constexpr size_t WS_SP = 472 * MiB;
constexpr size_t WS_END = 504 * MiB;
constexpr int CW_BAR = 4096, CW_CNT = 8192, CW_RDY = 12288, CW_TEAM = 36864, CW_PAN = 38912, CW_PPA = 55296, CW_P0A = 55424;

constexpr int SCR_BYTES = 155648;
constexpr int LDSCTL_OFF = SCR_BYTES, MISC_OFF = LDSCTL_OFF + 320, TAB_OFF = LDSCTL_OFF + 1024;
constexpr int LDS_BYTES = 163840;

#define RLX_AGENT __ATOMIC_RELAXED, __HIP_MEMORY_SCOPE_AGENT
__device__ __forceinline__ unsigned f2bf(float f) { unsigned u = __builtin_bit_cast(unsigned, f); return (u + 0x7fffu + ((u >> 16) & 1u)) >> 16; }
__device__ __forceinline__ unsigned pk2(float lo, float hi) { return f2bf(lo) | (f2bf(hi) << 16); }
__device__ __forceinline__ float bf_lo(unsigned w) { return __builtin_bit_cast(float, w << 16); }
__device__ __forceinline__ float bf_hi(unsigned w) { return __builtin_bit_cast(float, w & 0xffff0000u); }
__device__ __forceinline__ float bf2f(bf16 b) { return __builtin_bit_cast(float, (unsigned)b << 16); }
__device__ __forceinline__ unsigned cvt_pk_bf16(float lo, float hi) { unsigned r; asm volatile("v_cvt_pk_bf16_f32 %0, %1, %2" : "=v"(r) : "v"(lo), "v"(hi)); return r; }
__device__ __forceinline__ float wave_sum(float v) {
#pragma unroll
    for (int o = 1; o < 64; o <<= 1) v += __shfl_xor(v, o);
    return v;
}
__device__ __forceinline__ float sigmoidf_(float x) { return __builtin_amdgcn_rcpf(1.0f + __expf(-x)); }
__device__ __forceinline__ float logsigf_(float z) { return fminf(z, 0.f) - log1pf(expf(-fabsf(z))); }


typedef short s16x4 __attribute__((ext_vector_type(4)));
typedef __bf16 bf16x2_t __attribute__((ext_vector_type(2)));
__device__ __forceinline__ unsigned cvtpk(float lo, float hi) { f32x2 v = {lo, hi}; bf16x2_t b = __builtin_convertvector(v, bf16x2_t); return __builtin_bit_cast(unsigned, b); }
__device__ __forceinline__ unsigned pkh2(float a, float b) { typedef _Float16 h2 __attribute__((ext_vector_type(2))); h2 v = {(_Float16)a, (_Float16)b}; return __builtin_bit_cast(unsigned, v); }
__device__ __forceinline__ f32x2 unh2(unsigned w) { typedef _Float16 h2 __attribute__((ext_vector_type(2))); const h2 v = __builtin_bit_cast(h2, w); return (f32x2){(float)v[0], (float)v[1]}; }
__device__ __forceinline__ f32x4 mfma16(bf16x8 a, bf16x8 b, f32x4 c) { return __builtin_amdgcn_mfma_f32_16x16x32_bf16(a, b, c, 0, 0, 0); }
__device__ __forceinline__ s16x4 tr16(const LAS void* p) { return __builtin_amdgcn_ds_read_tr16_b64_v4i16((LAS s16x4*)p); }
__device__ __forceinline__ bf16x8 cat8(s16x4 lo, s16x4 hi) { return __builtin_shufflevector(lo, hi, 0, 1, 2, 3, 4, 5, 6, 7); }
__device__ __forceinline__ bf16x8 pack8(f32x4 a, f32x4 b) { u32x4 p; p.x = cvtpk(a[0], a[1]); p.y = cvtpk(a[2], a[3]); p.z = cvtpk(b[0], b[1]); p.w = cvtpk(b[2], b[3]); return __builtin_bit_cast(bf16x8, p); }

struct Ctx {
    LAS unsigned char* lds;
    int tid, lane, wave, vcu, G, bx;
    const float *x_in, *c, *w_ada, *b_ada, *attn_norm, *ffn_norm, *w_in, *gate_w, *gate_b, *gla_norm, *q_norm, *k_norm, *rpb, *w_out, *router_w, *router_b, *w1, *w3, *w2;
    float* out;
    gu32* ctl;
    float *mod, *lfb, *gdec, *U, *bfbr; bf16* Xb; bf16* SP; bf16* UB;
    unsigned* tokinfo; int* lists; unsigned char* w32t;
    bf16 *win_t, *wout_t, *w13_t, *w2_t, *XN, *QG, *KG, *VG, *GG, *QN, *KN, *VN, *H, *Y;
};

#ifndef PHM
#define PHM 0xfff
#endif
#define PH_EN12 ((PHM >> 12) & 1)
struct Args { const float* in[19]; float* out; unsigned char* ws; int ph_lo, ph_hi; };
struct Base { LAS unsigned char* lds; int tid, lane, wave, vcu, G; };
typedef __attribute__((address_space(4))) const Args CArgs;
__device__ __forceinline__ CArgs* kargs() { CArgs* p = (CArgs*)__builtin_amdgcn_kernarg_segment_ptr(); asm volatile("" : "+s"(p)); return p; }
__device__ __forceinline__ Ctx make_ctx(const Base& B) {
    CArgs* A = kargs(); Ctx F;
    { int t = B.tid; asm volatile("" : "+v"(t)); F.tid = t; F.lane = t & 63; F.wave = __builtin_amdgcn_readfirstlane(t >> 6); }
    { int v = B.vcu, g = B.G; asm volatile("" : "+s"(v), "+s"(g)); F.vcu = v; F.G = g; int bx = (int)blockIdx.x; asm volatile("" : "+s"(bx)); F.bx = bx; }
    { LAS unsigned char* lp = B.lds; asm volatile("" : "+s"(lp)); F.lds = lp; }
    F.x_in = A->in[0]; F.c = A->in[1]; F.w_ada = A->in[2]; F.b_ada = A->in[3]; F.attn_norm = A->in[4]; F.ffn_norm = A->in[5]; F.w_in = A->in[6];
    F.gate_w = A->in[7]; F.gate_b = A->in[8]; F.gla_norm = A->in[9]; F.q_norm = A->in[10]; F.k_norm = A->in[11]; F.rpb = A->in[12]; F.w_out = A->in[13];
    F.router_w = A->in[14]; F.router_b = A->in[15]; F.w1 = A->in[16]; F.w3 = A->in[17]; F.w2 = A->in[18];
    F.out = A->out;
    unsigned char* ws = A->ws;
    F.ctl = (gu32*)(ws + WS_CTL);
    F.mod = (float*)(ws + WS_MOD); F.lfb = (float*)(ws + WS_LFB); F.gdec = (float*)(ws + WS_GDEC); F.Xb = (bf16*)(ws + WS_X); F.U = (float*)(ws + WS_U); F.bfbr = (float*)(ws + WS_BFBR); F.SP = (bf16*)(ws + WS_SP); F.UB = (bf16*)(ws + WS_U);
    F.tokinfo = (unsigned*)(ws + WS_TOKINFO); F.lists = (int*)(ws + WS_LISTS); F.w32t = (unsigned char*)(ws + WS_W32T);
    F.win_t = (bf16*)(ws + WS_WIN); F.wout_t = (bf16*)(ws + WS_WOUT); F.w13_t = (bf16*)(ws + WS_W13); F.w2_t = (bf16*)(ws + WS_W2);
    F.XN = (bf16*)(ws + WS_XN); F.QG = (bf16*)(ws + WS_QG); F.KG = (bf16*)(ws + WS_KG); F.VG = (bf16*)(ws + WS_VG); F.GG = (bf16*)(ws + WS_GG);
    F.QN = (bf16*)(ws + WS_QN); F.KN = (bf16*)(ws + WS_KN); F.VN = (bf16*)(ws + WS_VN); F.H = (bf16*)(ws + WS_H); F.Y = (bf16*)(ws + WS_Y);
    return F;
}

namespace pg8 {
constexpr int BM = 256, BK = 64, HALF = 128, HTB = HALF * BK * 2, STAGE_BYTES = 8 * HTB;
__host__ __device__ __forceinline__ int lds_byte(int r, int c) { const int st = (r >> 4) * 2 + (c >> 5), rr = r & 15, cc = c & 31, ob = rr * 64 + cc * 2; return st * 1024 + (ob ^ (((ob >> 9) & 1) << 5)); }
__host__ __device__ __forceinline__ void stage_rc(int b, int& R, int& C) { const int st = b / 1024, sb = b % 1024, swz = sb ^ (((sb >> 9) & 1) << 5); R = (st >> 1) * 16 + swz / 64; C = (st & 1) * 32 + (swz % 64) / 2; }
__host__ __device__ __forceinline__ int perm32(int rho) { const int n = rho >> 4, i = rho & 15; return 8 * (i >> 2) + 4 * n + (i & 3); }

struct Unit { int rowbase, pn, e, posbase, cnt; };

template <class Epi, class Sched>
__device__ __forceinline__ void gemm_phase(LAS unsigned char* lds, const int K, const Sched& S, const Epi& E, const int tid) {
    const int wid = __builtin_amdgcn_readfirstlane(tid >> 6), lane = tid & 63, wr = wid >> 2, wc = wid & 3, fr = lane & 15, fq = lane >> 4;
    const int nt = K / BK;
    int R0, C0, R1, C1; stage_rc(tid * 16, R0, C0); stage_rc(tid * 16 + 8192, R1, C1);
    const int Rb0 = Epi::PERM ? ((R0 & ~31) + perm32(R0 & 31)) : R0, Rb1 = Epi::PERM ? ((R1 & ~31) + perm32(R1 & 31)) : R1;
    const unsigned vb0 = (unsigned)(Rb0 * K + C0) * 2u, vb1 = (unsigned)(Rb1 * K + C1) * 2u;
    const size_t kstep = (size_t)(BK * 2);
    const size_t hstepB = (size_t)HALF * K * 2;
    const unsigned ldsw = (unsigned)wid * 1024u;
    const int aoff = lds_byte(wr * 64 + fr, fq * 8), boff = lds_byte(wc * 32 + fr, fq * 8);
#define PG8_SA(b, h) (((b) * 2 + (h)) * HTB)
#define PG8_SB(b, h) ((4 + (b) * 2 + (h)) * HTB)
#define PG8_STAGE2(bufoff, gbase, o0, o1) do { \
        __builtin_amdgcn_global_load_lds((const unsigned*)((const char*)(gbase) + (o0)), (LAS unsigned*)(lds + (bufoff) + ldsw), 16, 0, 0); \
        __builtin_amdgcn_global_load_lds((const unsigned*)((const char*)(gbase) + (o1)), (LAS unsigned*)(lds + (bufoff) + ldsw + 8192), 16, 0, 0); } while (0)
#define PG8_LDA(dst, b, h) do { _Pragma("unroll") for (int m = 0; m < 4; ++m) _Pragma("unroll") for (int k = 0; k < 2; ++k) dst[m][k] = *(const LAS bf16x8*)(lds + PG8_SA(b, h) + aoff + m * 2048 + k * 1024); } while (0)
#define PG8_LDB(dst, b, h) do { _Pragma("unroll") for (int n = 0; n < 2; ++n) _Pragma("unroll") for (int k = 0; k < 2; ++k) dst[n][k] = *(const LAS bf16x8*)(lds + PG8_SB(b, h) + boff + n * 2048 + k * 1024); } while (0)
#define PG8_MMA(ai, bj, At, Bt) do { __builtin_amdgcn_s_setprio(1); _Pragma("unroll") for (int m = 0; m < 4; ++m) _Pragma("unroll") for (int n = 0; n < 2; ++n) _Pragma("unroll") for (int k = 0; k < 2; ++k) \
        acc[ai][bj][m][n] = __builtin_amdgcn_mfma_f32_16x16x32_bf16(Bt[n][k], At[m][k], acc[ai][bj][m][n], 0, 0, 0); __builtin_amdgcn_s_setprio(0); } while (0)
#define PG8_WAIT_V(n) asm volatile("s_waitcnt vmcnt(" #n ")" ::: "memory")
#define PG8_WAIT_L(n) asm volatile("s_waitcnt lgkmcnt(" #n ")" ::: "memory")
#define PG8_BAR __builtin_amdgcn_s_barrier()
#define PG8_SCHED __builtin_amdgcn_sched_barrier(0)
    Unit cur, nxt; int ui = 0;
    if (!S.next(0, cur)) return;
    f32x4 acc[2][2][4][2];
#pragma unroll
    for (int a = 0; a < 2; ++a)
#pragma unroll
        for (int b = 0; b < 2; ++b)
#pragma unroll
            for (int m = 0; m < 4; ++m)
#pragma unroll
                for (int n = 0; n < 2; ++n) acc[a][b][m][n] = (f32x4){0.f, 0.f, 0.f, 0.f};
    bf16x8 At[4][2], B0[2][2], B1[2][2];
    const char* cA = S.Abase(cur); const char* cB = S.Bbase(cur);
    unsigned ca0 = S.aoff(cur, 0, R0, C0), ca1 = S.aoff(cur, 0, R1, C1), ca2 = S.aoff(cur, 1, R0, C0), ca3 = S.aoff(cur, 1, R1, C1);
    PG8_STAGE2(PG8_SB(0, 0), cB, vb0, vb1); PG8_STAGE2(PG8_SB(0, 1), cB + hstepB, vb0, vb1);
    S.a_ready(cur);
    PG8_STAGE2(PG8_SA(0, 0), cA, ca0, ca1); PG8_STAGE2(PG8_SA(0, 1), cA, ca2, ca3);
    if (wr == 1) PG8_BAR;
    PG8_WAIT_V(2); PG8_BAR;
    PG8_STAGE2(PG8_SB(1, 0), cB + kstep, vb0, vb1); PG8_STAGE2(PG8_SA(1, 0), cA + kstep, ca0, ca1); PG8_STAGE2(PG8_SB(1, 1), cB + hstepB + kstep, vb0, vb1);
    PG8_WAIT_V(6); PG8_BAR;
    for (;;) {
        const bool has_next = S.next(ui + 1, nxt);
        const char* nA = has_next ? S.Abase(nxt) : cA; const char* nB = has_next ? S.Bbase(nxt) : cB;
        unsigned na0 = ca0, na1 = ca1, na2 = ca2, na3 = ca3;
        if (has_next) { na0 = S.aoff(nxt, 0, R0, C0); na1 = S.aoff(nxt, 0, R1, C1); na2 = S.aoff(nxt, 1, R0, C0); na3 = S.aoff(nxt, 1, R1, C1); }
        for (int t = 0; t < nt; t += 2) {
            const bool last = (t == nt - 2);
            if (last && has_next) S.a_ready(nxt);
            const char* a1 = cA + (size_t)(t + 1) * kstep;
            const char* a2 = last ? nA : cA + (size_t)(t + 2) * kstep; const char* b2 = last ? nB : cB + (size_t)(t + 2) * kstep;
            const char* a3 = a2 + kstep; const char* b3 = b2 + kstep;
            const unsigned s0 = last ? na0 : ca0, s1 = last ? na1 : ca1, s2 = last ? na2 : ca2, s3 = last ? na3 : ca3;
            PG8_LDB(B0, 0, 0); PG8_LDB(B1, 0, 1); PG8_SCHED; PG8_LDA(At, 0, 0); PG8_STAGE2(PG8_SA(1, 1), a1, ca2, ca3);
            PG8_WAIT_V(8); PG8_WAIT_L(0); PG8_BAR; PG8_MMA(0, 0, At, B0); PG8_MMA(0, 1, At, B1); PG8_BAR; PG8_SCHED;
            PG8_LDA(At, 0, 1); PG8_STAGE2(PG8_SB(0, 0), b2, vb0, vb1); PG8_STAGE2(PG8_SB(0, 1), b2 + hstepB, vb0, vb1); PG8_STAGE2(PG8_SA(0, 0), a2, s0, s1);
            PG8_WAIT_V(8); PG8_WAIT_L(0); PG8_BAR; PG8_MMA(1, 0, At, B0); PG8_MMA(1, 1, At, B1); PG8_BAR; PG8_SCHED;
            PG8_LDB(B0, 1, 0); PG8_LDB(B1, 1, 1); PG8_SCHED; PG8_LDA(At, 1, 0); PG8_STAGE2(PG8_SA(0, 1), a2, s2, s3);
            PG8_WAIT_V(8); PG8_WAIT_L(0); PG8_BAR; PG8_MMA(0, 0, At, B0); PG8_MMA(0, 1, At, B1); PG8_BAR; PG8_SCHED;
            PG8_LDA(At, 1, 1); PG8_STAGE2(PG8_SB(1, 0), b3, vb0, vb1); PG8_STAGE2(PG8_SB(1, 1), b3 + hstepB, vb0, vb1); PG8_STAGE2(PG8_SA(1, 0), a3, s0, s1);
            PG8_WAIT_V(8); PG8_WAIT_L(0); PG8_BAR; PG8_MMA(1, 0, At, B0); PG8_MMA(1, 1, At, B1); PG8_BAR; PG8_SCHED;
        }
        if (wr == 0) PG8_BAR;
        E(acc, cur, wr, wc, fr, fq);
        if (!has_next) break;
#pragma unroll
        for (int a = 0; a < 2; ++a)
#pragma unroll
            for (int b = 0; b < 2; ++b)
#pragma unroll
                for (int m = 0; m < 4; ++m)
#pragma unroll
                    for (int n = 0; n < 2; ++n) acc[a][b][m][n] = (f32x4){0.f, 0.f, 0.f, 0.f};
        cur = nxt; cA = nA; cB = nB; ca0 = na0; ca1 = na1; ca2 = na2; ca3 = na3; ++ui;
        if (wr == 1) PG8_BAR;
    }
    PG8_WAIT_V(0);
    PG8_BAR;
#undef PG8_SA
#undef PG8_SB
#undef PG8_STAGE2
#undef PG8_LDA
#undef PG8_LDB
#undef PG8_MMA
#undef PG8_WAIT_V
#undef PG8_WAIT_L
#undef PG8_BAR
#undef PG8_SCHED
}

struct DenseSched {
    const char* A; const char* Bt; int K, nM, nN, nwg, G, c; unsigned* rdy = nullptr; unsigned need = 0; unsigned* rdy2 = nullptr; unsigned need2 = 0; int pn2 = 0; mutable int okrow = -1; mutable bool okg = false;
    __device__ __forceinline__ void init(const void* A_, const void* Bt_, int M, int N, int K_, int G_, int c_) { A = (const char*)A_; Bt = (const char*)Bt_; K = K_; nM = M / BM; nN = N / BM; nwg = nM * nN; G = G_; c = c_; }
    __device__ __forceinline__ bool next(int i, Unit& u) const {
        const long L = (long)i * G + c; if (L >= nwg) return false;
        int wgid = (int)L; { const int q = nwg / 8, r = nwg % 8, xcd = wgid % 8, off = wgid / 8; wgid = (xcd < r ? xcd * (q + 1) : r * (q + 1) + (xcd - r) * q) + off; }
        const int nig = 8 * nN, gid = wgid / nig, fm = gid * 8, gsz = (nM - fm) < 8 ? (nM - fm) : 8;
        const int pm = fm + ((wgid % nig) % gsz); u.pn = (wgid % nig) / gsz; u.rowbase = pm * BM; u.e = 0; u.posbase = 0; u.cnt = 0; return true;
    }
    __device__ __forceinline__ const char* Abase(const Unit& u) const { return A + (size_t)u.rowbase * K * 2; }
    __device__ __forceinline__ const char* Bbase(const Unit& u) const { return Bt + (size_t)u.pn * BM * K * 2; }
    __device__ __forceinline__ unsigned aoff(const Unit&, int half, int R, int C) const { return (unsigned)((half * HALF + R) * K + C) * 2u; }
    __device__ __forceinline__ void a_ready(const Unit& u) const {
        if (!rdy) return;
        const bool np = u.rowbase != okrow, ng = rdy2 && u.pn >= pn2 && !okg;
        if (!np && !ng) return;
        okrow = u.rowbase; if (ng) okg = true;
        if (threadIdx.x < 64) {
            unsigned* w = rdy + (u.rowbase / BM) * 32; unsigned sp = 0;
            if (np) while ((unsigned)__builtin_amdgcn_readfirstlane(__hip_atomic_load(w, __ATOMIC_RELAXED, __HIP_MEMORY_SCOPE_AGENT)) < need) {
                __builtin_amdgcn_s_sleep(1);
                if (++sp > (1u << 20)) break; }
            if (ng) {
                while ((unsigned)__builtin_amdgcn_readfirstlane(__hip_atomic_load(rdy2, __ATOMIC_RELAXED, __HIP_MEMORY_SCOPE_AGENT)) < need2) {
                    __builtin_amdgcn_s_sleep(1);
                    if (++sp > (1u << 20)) break; } }
            __builtin_amdgcn_fence(__ATOMIC_ACQUIRE, "agent");
            asm volatile("s_waitcnt vmcnt(0)" ::: "memory");
        }
        asm volatile("" ::: "memory"); __builtin_amdgcn_s_barrier(); asm volatile("" ::: "memory");
    }
};
template <bool GATHER>
struct MoeSched {
    const char* A; const char* Bt; int K; const int* lists; const LAS int* TS; const LAS int* CN; int G, c;
    __device__ __forceinline__ bool next(int i, Unit& u) const {
        const int L = i * G + c; const int TT = __builtin_amdgcn_readfirstlane(TS[32]);
        if (L >= TT * 4) return false;
        const int mt = L >> 2; int e = 0;
        while (e < 31 && __builtin_amdgcn_readfirstlane(TS[e + 1]) <= mt) ++e;
        u.e = e; u.rowbase = mt * BM; u.pn = L & 3; u.posbase = (mt - __builtin_amdgcn_readfirstlane(TS[e])) * BM; u.cnt = __builtin_amdgcn_readfirstlane(CN[e]); return true;
    }
    __device__ __forceinline__ void a_ready(const Unit&) const {}
    __device__ __forceinline__ const char* Abase(const Unit& u) const { return GATHER ? A : A + (size_t)u.rowbase * K * 2; }
    __device__ __forceinline__ const char* Bbase(const Unit& u) const { return Bt + ((size_t)u.e * 1024 + (size_t)u.pn * BM) * K * 2; }
    __device__ __forceinline__ unsigned aoff(const Unit& u, int half, int R, int C) const {
        if (GATHER) { const int pos = u.posbase + half * HALF + R; const int tok = pos < u.cnt ? lists[u.e * LCAP + pos] : 0; return (unsigned)(tok * K + C) * 2u; }
        return (unsigned)((half * HALF + R) * K + C) * 2u;
    }
};

struct UnitV { int rowbase, pn, e, posbase, cnt, kind, K, mt; };
template <class Epi, class Sched>
__device__ __forceinline__ void gemm_phase_v(LAS unsigned char* lds, const Sched& S, const Epi& E, const int tid) {
    const int wid = __builtin_amdgcn_readfirstlane(tid >> 6), lane = tid & 63, wr = wid >> 2, wc = wid & 3, fr = lane & 15, fq = lane >> 4;
    int R0, C0, R1, C1; stage_rc(tid * 16, R0, C0); stage_rc(tid * 16 + 8192, R1, C1);
    const int Rb0 = (R0 & ~31) + perm32(R0 & 31), Rb1 = (R1 & ~31) + perm32(R1 & 31);
    const size_t kstep = (size_t)(BK * 2);
    const unsigned ldsw = (unsigned)wid * 1024u;
    const int aoff = lds_byte(wr * 64 + fr, fq * 8), boff = lds_byte(wc * 32 + fr, fq * 8);
#define PG8_SA(b, h) (((b) * 2 + (h)) * HTB)
#define PG8_SB(b, h) ((4 + (b) * 2 + (h)) * HTB)
#define PG8_STAGE2(bufoff, gbase, o0, o1) do { \
        __builtin_amdgcn_global_load_lds((const unsigned*)((const char*)(gbase) + (o0)), (LAS unsigned*)(lds + (bufoff) + ldsw), 16, 0, 0); \
        __builtin_amdgcn_global_load_lds((const unsigned*)((const char*)(gbase) + (o1)), (LAS unsigned*)(lds + (bufoff) + ldsw + 8192), 16, 0, 0); } while (0)
#define PG8_LDA(dst, b, h) do { _Pragma("unroll") for (int m = 0; m < 4; ++m) _Pragma("unroll") for (int k = 0; k < 2; ++k) dst[m][k] = *(const LAS bf16x8*)(lds + PG8_SA(b, h) + aoff + m * 2048 + k * 1024); } while (0)
#define PG8_LDB(dst, b, h) do { _Pragma("unroll") for (int n = 0; n < 2; ++n) _Pragma("unroll") for (int k = 0; k < 2; ++k) dst[n][k] = *(const LAS bf16x8*)(lds + PG8_SB(b, h) + boff + n * 2048 + k * 1024); } while (0)
#define PG8_MMA(ai, bj, At, Bt) do { __builtin_amdgcn_s_setprio(1); _Pragma("unroll") for (int m = 0; m < 4; ++m) _Pragma("unroll") for (int n = 0; n < 2; ++n) _Pragma("unroll") for (int k = 0; k < 2; ++k) \
        acc[ai][bj][m][n] = __builtin_amdgcn_mfma_f32_16x16x32_bf16(Bt[n][k], At[m][k], acc[ai][bj][m][n], 0, 0, 0); __builtin_amdgcn_s_setprio(0); } while (0)
#define PG8_WAIT_V(n) asm volatile("s_waitcnt vmcnt(" #n ")" ::: "memory")
#define PG8_WAIT_L(n) asm volatile("s_waitcnt lgkmcnt(" #n ")" ::: "memory")
#define PG8_BAR __builtin_amdgcn_s_barrier()
#define PG8_SCHED __builtin_amdgcn_sched_barrier(0)
    UnitV cur, nxt; int ui = 0;
    if (!S.next(0, cur)) return;
    f32x4 acc[2][2][4][2];
#pragma unroll
    for (int a = 0; a < 2; ++a)
#pragma unroll
        for (int b = 0; b < 2; ++b)
#pragma unroll
            for (int m = 0; m < 4; ++m)
#pragma unroll
                for (int n = 0; n < 2; ++n) acc[a][b][m][n] = (f32x4){0.f, 0.f, 0.f, 0.f};
    bf16x8 At[4][2], B0[2][2], B1[2][2];
    S.a_ready(cur);
    const char* cA = S.Abase(cur); const char* cB = S.Bbase(cur);
    unsigned ca0 = S.aoff(cur, 0, R0, C0), ca1 = S.aoff(cur, 0, R1, C1), ca2 = S.aoff(cur, 1, R0, C0), ca3 = S.aoff(cur, 1, R1, C1);
    unsigned cb0 = (unsigned)(Rb0 * cur.K + C0) * 2u, cb1 = (unsigned)(Rb1 * cur.K + C1) * 2u; size_t chs = (size_t)HALF * cur.K * 2;
    PG8_STAGE2(PG8_SB(0, 0), cB, cb0, cb1); PG8_STAGE2(PG8_SB(0, 1), cB + chs, cb0, cb1); PG8_STAGE2(PG8_SA(0, 0), cA, ca0, ca1); PG8_STAGE2(PG8_SA(0, 1), cA, ca2, ca3);
    if (wr == 1) PG8_BAR;
    PG8_WAIT_V(2); PG8_BAR;
    PG8_STAGE2(PG8_SB(1, 0), cB + kstep, cb0, cb1); PG8_STAGE2(PG8_SA(1, 0), cA + kstep, ca0, ca1); PG8_STAGE2(PG8_SB(1, 1), cB + chs + kstep, cb0, cb1);
    PG8_WAIT_V(6); PG8_BAR;
    for (;;) {
        const bool has_next = S.next(ui + 1, nxt);
        const char* nA = has_next ? S.Abase(nxt) : cA; const char* nB = has_next ? S.Bbase(nxt) : cB;
        unsigned na0 = ca0, na1 = ca1, na2 = ca2, na3 = ca3, nb0 = cb0, nb1 = cb1; size_t nhs = chs;
        if (has_next) { na0 = S.aoff(nxt, 0, R0, C0); na1 = S.aoff(nxt, 0, R1, C1); na2 = S.aoff(nxt, 1, R0, C0); na3 = S.aoff(nxt, 1, R1, C1);
            nb0 = (unsigned)(Rb0 * nxt.K + C0) * 2u; nb1 = (unsigned)(Rb1 * nxt.K + C1) * 2u; nhs = (size_t)HALF * nxt.K * 2; }
        const int nt = cur.K / BK;
        for (int t = 0; t < nt; t += 2) {
            const bool last = (t == nt - 2);
            if (last && has_next) S.a_ready(nxt);
            const char* a1 = cA + (size_t)(t + 1) * kstep;
            const char* a2 = last ? nA : cA + (size_t)(t + 2) * kstep; const char* b2 = last ? nB : cB + (size_t)(t + 2) * kstep;
            const char* a3 = a2 + kstep; const char* b3 = b2 + kstep;
            const unsigned s0 = last ? na0 : ca0, s1 = last ? na1 : ca1, s2 = last ? na2 : ca2, s3 = last ? na3 : ca3, sb0 = last ? nb0 : cb0, sb1 = last ? nb1 : cb1;
            const size_t shs = last ? nhs : chs;
            PG8_LDB(B0, 0, 0); PG8_LDB(B1, 0, 1); PG8_SCHED; PG8_LDA(At, 0, 0); PG8_STAGE2(PG8_SA(1, 1), a1, ca2, ca3);
            PG8_WAIT_V(8); PG8_WAIT_L(0); PG8_BAR; PG8_MMA(0, 0, At, B0); PG8_MMA(0, 1, At, B1); PG8_BAR; PG8_SCHED;
            PG8_LDA(At, 0, 1); PG8_STAGE2(PG8_SB(0, 0), b2, sb0, sb1); PG8_STAGE2(PG8_SB(0, 1), b2 + shs, sb0, sb1); PG8_STAGE2(PG8_SA(0, 0), a2, s0, s1);
            PG8_WAIT_V(8); PG8_WAIT_L(0); PG8_BAR; PG8_MMA(1, 0, At, B0); PG8_MMA(1, 1, At, B1); PG8_BAR; PG8_SCHED;
            PG8_LDB(B0, 1, 0); PG8_LDB(B1, 1, 1); PG8_SCHED; PG8_LDA(At, 1, 0); PG8_STAGE2(PG8_SA(0, 1), a2, s2, s3);
            PG8_WAIT_V(8); PG8_WAIT_L(0); PG8_BAR; PG8_MMA(0, 0, At, B0); PG8_MMA(0, 1, At, B1); PG8_BAR; PG8_SCHED;
            PG8_LDA(At, 1, 1); PG8_STAGE2(PG8_SB(1, 0), b3, sb0, sb1); PG8_STAGE2(PG8_SB(1, 1), b3 + shs, sb0, sb1); PG8_STAGE2(PG8_SA(1, 0), a3, s0, s1);
            PG8_WAIT_V(8); PG8_WAIT_L(0); PG8_BAR; PG8_MMA(1, 0, At, B0); PG8_MMA(1, 1, At, B1); PG8_BAR; PG8_SCHED;
        }
        if (wr == 0) PG8_BAR;
        E(acc, cur, wr, wc, fr, fq);
        S.done(cur, lane);
        if (!has_next) break;
#pragma unroll
        for (int a = 0; a < 2; ++a)
#pragma unroll
            for (int b = 0; b < 2; ++b)
#pragma unroll
                for (int m = 0; m < 4; ++m)
#pragma unroll
                    for (int n = 0; n < 2; ++n) acc[a][b][m][n] = (f32x4){0.f, 0.f, 0.f, 0.f};
        cur = nxt; cA = nA; cB = nB; ca0 = na0; ca1 = na1; ca2 = na2; ca3 = na3; cb0 = nb0; cb1 = nb1; chs = nhs; ++ui;
        if (wr == 1) PG8_BAR;
    }
    PG8_WAIT_V(0);
    PG8_BAR;
#undef PG8_SA
#undef PG8_SB
#undef PG8_STAGE2
#undef PG8_LDA
#undef PG8_LDB
#undef PG8_MMA
#undef PG8_WAIT_V
#undef PG8_WAIT_L
#undef PG8_BAR
#undef PG8_SCHED
}
struct MoeFusedSched {
    const char *XNp, *Hp, *W13p, *W2p; const int* lists; const LAS int* TS; const LAS int* CN; unsigned* ready; unsigned* tmo; int G, c;
    __device__ __forceinline__ bool next(int i, UnitV& u) const {
        const int TT = __builtin_amdgcn_readfirstlane(TS[32]); const int n = 4 * TT, q = n / G, rem = n - q * G;
        const int k1 = q + (c < rem ? 1 : 0);
        int v, kind;
        if (i < k1) { v = c + i * G; kind = 0; }
        else { const int j = i - k1, GL = rem > 0 ? G - rem : 0;
            if (rem > 0 && c >= rem) { v = (j < 2) ? (c - rem) + j * GL : 2 * GL + c + (j - 2) * G; }
            else v = 2 * GL + c + j * G;
            if (v >= n) return false; kind = 1; }
        const int mt = v >> 2; const int e = __builtin_amdgcn_readfirstlane(TS[768 - 256 + mt]);
        u.kind = kind; u.K = kind ? DE : D; u.mt = mt; u.e = e; u.rowbase = mt * BM; u.pn = v & 3;
        u.posbase = (mt - __builtin_amdgcn_readfirstlane(TS[e])) * BM; u.cnt = __builtin_amdgcn_readfirstlane(CN[e]); return true;
    }
    __device__ __forceinline__ const char* Abase(const UnitV& u) const { return u.kind ? Hp + (size_t)u.rowbase * DE * 2 : XNp; }
    __device__ __forceinline__ const char* Bbase(const UnitV& u) const { return u.kind ? W2p + ((size_t)u.e * 1024 + (size_t)u.pn * BM) * DE * 2 : W13p + ((size_t)u.e * 1024 + (size_t)u.pn * BM) * D * 2; }
    __device__ __forceinline__ unsigned aoff(const UnitV& u, int half, int R, int C) const {
        if (u.kind == 0) { const int pos = u.posbase + half * HALF + R; const int tok = pos < u.cnt ? lists[u.e * LCAP + pos] : 0; return (unsigned)(tok * D + C) * 2u; }
        return (unsigned)((half * HALF + R) * DE + C) * 2u;
    }
    __device__ __forceinline__ void a_ready(const UnitV& u) const {
        if (u.kind == 0) return;
        if (threadIdx.x < 64) {
            unsigned* w = ready + 64 * u.mt; unsigned sp = 0;
            while ((unsigned)__builtin_amdgcn_readfirstlane(__hip_atomic_load(w, __ATOMIC_RELAXED, __HIP_MEMORY_SCOPE_AGENT)) < 32u) {
                __builtin_amdgcn_s_sleep(2);
                if (++sp > (1u << 20)) { if (threadIdx.x == 0) __hip_atomic_store(tmo, 1u, __ATOMIC_RELAXED, __HIP_MEMORY_SCOPE_AGENT); break; } }
            __builtin_amdgcn_fence(__ATOMIC_ACQUIRE, "agent");
            asm volatile("s_waitcnt vmcnt(0)" ::: "memory");
        }
        asm volatile("" ::: "memory"); __builtin_amdgcn_s_barrier(); asm volatile("" ::: "memory");
    }
    __device__ __forceinline__ void done(const UnitV& u, int lane) const {
        if (u.kind != 0) return;
        asm volatile("s_waitcnt vmcnt(0)" ::: "memory");
        if (lane == 0) __hip_atomic_fetch_add(ready + 64 * u.mt, 1u, __ATOMIC_RELAXED, __HIP_MEMORY_SCOPE_AGENT);
    }
};
}

typedef f32x4 AccT[2][2][4][2];
#ifndef PAN_FLAGS
#define PAN_FLAGS 1
#endif
__device__ __forceinline__ void st16(bf16* base, size_t eoff, u32x4 o) {
#if PAN_FLAGS
    const auto rs = __builtin_amdgcn_make_buffer_rsrc((void*)base, (short)0, 0x7fffffff, 0x00020000);
    __builtin_amdgcn_raw_buffer_store_b128(o, rs, (int)(eoff * 2), 0, 16);
#else
    *(u32x4*)(base + eoff) = o;
#endif
}
struct EpiInProj {
    static constexpr bool PERM = true;
    bf16 *QG, *KG, *VG, *GG, *QN, *KN, *VN; const float *qnw, *knw;
    __device__ __forceinline__ void operator()(const AccT& acc, const pg8::Unit& u, int wr, int wc, int fr, int fq) const {
        const int pn = u.pn; const int row0 = u.rowbase + wr * 64 + fr;
        if (pn >= 6 && pn < 10) {
            const bool isq = pn < 8; bf16* O = isq ? QN : KN; const float* nw = isq ? qnw : knw; const float sc = isq ? 0.125f * 1.44269504089f : 1.0f;
            f32x4 w[2][2];
#pragma unroll
            for (int bj = 0; bj < 2; ++bj)
#pragma unroll
                for (int n = 0; n < 2; ++n) w[bj][n] = *(const f32x4*)(nw + 32 * bj + 8 * fq + 4 * n) * sc;
#pragma unroll
            for (int ai = 0; ai < 2; ++ai)
#pragma unroll
                for (int m = 0; m < 4; ++m) {
                    float ss = 0.f;
#pragma unroll
                    for (int bj = 0; bj < 2; ++bj)
#pragma unroll
                        for (int n = 0; n < 2; ++n) { const f32x4 v = acc[ai][bj][m][n]; ss += (v[0] * v[0] + v[1] * v[1]) + (v[2] * v[2] + v[3] * v[3]); }
                    ss += __shfl_xor(ss, 16); ss += __shfl_xor(ss, 32);
                    const float rstd = 1.0f / sqrtf(ss * (1.0f / 64.0f) + EPS);
                    const size_t rowo = (size_t)(row0 + ai * 128 + m * 16) * 512 + ((pn & 1) * 4 + wc) * 64 + 8 * fq;
#pragma unroll
                    for (int bj = 0; bj < 2; ++bj) { const f32x4 v0 = acc[ai][bj][m][0] * rstd * w[bj][0], v1 = acc[ai][bj][m][1] * rstd * w[bj][1];
                        u32x4 o; o.x = cvt_pk_bf16(v0[0], v0[1]); o.y = cvt_pk_bf16(v0[2], v0[3]); o.z = cvt_pk_bf16(v1[0], v1[1]); o.w = cvt_pk_bf16(v1[2], v1[3]);
                        st16(O, rowo + bj * 32, o); }
                }
        } else {
            bf16* O; int ldc, colt; float sc = 1.0f;
            if (pn == 0) { O = QG; ldc = 256; colt = 0; sc = 0.125f; }
            else if (pn == 1) { O = KG; ldc = 256; colt = 0; }
            else if (pn < 4) { O = VG; ldc = 512; colt = (pn - 2) * 256; }
            else if (pn < 6) { O = GG; ldc = 512; colt = (pn - 4) * 256; }
            else { O = VN; ldc = 512; colt = (pn - 10) * 256; }
            const int col0 = colt + wc * 32 + 8 * fq;
#pragma unroll
            for (int ai = 0; ai < 2; ++ai)
#pragma unroll
                for (int m = 0; m < 4; ++m) { const size_t rowo = (size_t)(row0 + ai * 128 + m * 16) * ldc + col0;
#pragma unroll
                    for (int bj = 0; bj < 2; ++bj) { const f32x4 v0 = acc[ai][bj][m][0] * sc, v1 = acc[ai][bj][m][1] * sc;
                        u32x4 o; o.x = cvt_pk_bf16(v0[0], v0[1]); o.y = cvt_pk_bf16(v0[2], v0[3]); o.z = cvt_pk_bf16(v1[0], v1[1]); o.w = cvt_pk_bf16(v1[2], v1[3]);
                        st16(O, rowo + bj * 128, o); } }
        }
    }
};
struct EpiResid {
    static constexpr bool PERM = true;
    const float* basef; bf16* X; const float* g1;
    __device__ __forceinline__ void operator()(const AccT& acc, const pg8::Unit& u, int wr, int wc, int fr, int fq) const {
        const int row0 = u.rowbase + wr * 64 + fr, col0 = u.pn * 256 + wc * 32 + 8 * fq; const int b = u.rowbase >> 12;
        f32x4 g[2][2];
#pragma unroll
        for (int bj = 0; bj < 2; ++bj)
#pragma unroll
            for (int n = 0; n < 2; ++n) g[bj][n] = *(const f32x4*)(g1 + (size_t)b * MODW + col0 + bj * 128 + n * 4);
#pragma unroll
        for (int ai = 0; ai < 2; ++ai)
#pragma unroll
            for (int m = 0; m < 4; ++m) { const size_t off = (size_t)(row0 + ai * 128 + m * 16) * D + col0;
#pragma unroll
                for (int bj = 0; bj < 2; ++bj) {
                    f32x4 b0, b1;
                    if (basef) { b0 = *(const f32x4*)(basef + off + bj * 128); b1 = *(const f32x4*)(basef + off + bj * 128 + 4); }
                    else { const u32x4 w = *(const u32x4*)(X + off + bj * 128); b0 = (f32x4){bf_lo(w.x), bf_hi(w.x), bf_lo(w.y), bf_hi(w.y)}; b1 = (f32x4){bf_lo(w.z), bf_hi(w.z), bf_lo(w.w), bf_hi(w.w)}; }
                    const f32x4 v0 = b0 + g[bj][0] * acc[ai][bj][m][0], v1 = b1 + g[bj][1] * acc[ai][bj][m][1];
                    u32x4 o; o.x = cvtpk(v0[0], v0[1]); o.y = cvtpk(v0[2], v0[3]); o.z = cvtpk(v1[0], v1[1]); o.w = cvtpk(v1[2], v1[3]);
                    st16(X, off + bj * 128, o); } }
    }
};
struct EpiSwiGLU {
    static constexpr bool PERM = true;
    bf16* H;
    __device__ __forceinline__ void operator()(const AccT& acc, const pg8::Unit& u, int wr, int wc, int fr, int fq) const {
        const int row0 = u.rowbase + wr * 64 + fr, col0 = u.pn * 128 + wc * 32 + 8 * fq;
#pragma unroll
        for (int ai = 0; ai < 2; ++ai)
#pragma unroll
            for (int m = 0; m < 4; ++m) { bf16* rowp = H + (size_t)(row0 + ai * 128 + m * 16) * DE + col0;
                float r[8];
#pragma unroll
                for (int n = 0; n < 2; ++n)
#pragma unroll
                    for (int i = 0; i < 4; ++i) { const float a = acc[ai][0][m][n][i], b = acc[ai][1][m][n][i]; r[n * 4 + i] = a * sigmoidf_(a) * b; }
                u32x4 o; o.x = cvt_pk_bf16(r[0], r[1]); o.y = cvt_pk_bf16(r[2], r[3]); o.z = cvt_pk_bf16(r[4], r[5]); o.w = cvt_pk_bf16(r[6], r[7]);
                *(u32x4*)rowp = o; }
    }
};
struct EpiY {
    static constexpr bool PERM = true;
    bf16* Y;
    __device__ __forceinline__ void operator()(const AccT& acc, const pg8::Unit& u, int wr, int wc, int fr, int fq) const {
        const int row0 = u.rowbase + wr * 64 + fr, col0 = u.pn * 256 + wc * 32 + 8 * fq;
#pragma unroll
        for (int ai = 0; ai < 2; ++ai)
#pragma unroll
            for (int m = 0; m < 4; ++m) { bf16* rowp = Y + (size_t)(row0 + ai * 128 + m * 16) * D + col0;
#pragma unroll
                for (int bj = 0; bj < 2; ++bj) { const f32x4 v0 = acc[ai][bj][m][0], v1 = acc[ai][bj][m][1];
                    u32x4 o; o.x = cvt_pk_bf16(v0[0], v0[1]); o.y = cvt_pk_bf16(v0[2], v0[3]); o.z = cvt_pk_bf16(v1[0], v1[1]); o.w = cvt_pk_bf16(v1[2], v1[3]);
                    *(u32x4*)(rowp + bj * 128) = o; } }
    }
};


struct EpiMoe {
    static constexpr bool PERM = true;
    bf16* H; bf16* Y;
    __device__ __forceinline__ void operator()(const AccT& acc, const pg8::UnitV& u, int wr, int wc, int fr, int fq) const {
        const int row0 = u.rowbase + wr * 64 + fr;
        if (u.kind == 0) {
            const auto rs = __builtin_amdgcn_make_buffer_rsrc((void*)H, (short)0, 0x7fffffff, 0x00020000);
            const int col0 = u.pn * 128 + wc * 32 + 8 * fq;
#pragma unroll
            for (int ai = 0; ai < 2; ++ai)
#pragma unroll
                for (int m = 0; m < 4; ++m) {
                    float r[8];
#pragma unroll
                    for (int n = 0; n < 2; ++n)
#pragma unroll
                        for (int i = 0; i < 4; ++i) { const float a = acc[ai][0][m][n][i], b = acc[ai][1][m][n][i]; r[n * 4 + i] = a * sigmoidf_(a) * b; }
                    u32x4 o; o.x = cvtpk(r[0], r[1]); o.y = cvtpk(r[2], r[3]); o.z = cvtpk(r[4], r[5]); o.w = cvtpk(r[6], r[7]);
                    __builtin_amdgcn_raw_buffer_store_b128(o, rs, (int)(((row0 + ai * 128 + m * 16) * DE + col0) * 2), 0, 16); }
        } else {
            const int col0 = u.pn * 256 + wc * 32 + 8 * fq;
#pragma unroll
            for (int ai = 0; ai < 2; ++ai)
#pragma unroll
                for (int m = 0; m < 4; ++m) { bf16* rowp = Y + (size_t)(row0 + ai * 128 + m * 16) * D + col0;
#pragma unroll
                    for (int bj = 0; bj < 2; ++bj) { const f32x4 v0 = acc[ai][bj][m][0], v1 = acc[ai][bj][m][1];
                        u32x4 o; o.x = cvtpk(v0[0], v0[1]); o.y = cvtpk(v0[2], v0[3]); o.z = cvtpk(v1[0], v1[1]); o.w = cvtpk(v1[2], v1[3]);
                        *(u32x4*)(rowp + bj * 128) = o; } }
        }
    }
};

#define XB_TMO      128
#define XB_XCNT(j)  (256  + 64 * (j))
#define XB_XSUB(j)  (1280 + 64 * (j))
#define XB_XGEN(j)  (2304 + 64 * (j))
#define XB_TOP      3328
#define XB_TOPGEN   3392
#define XCD_BAR_WORDS 3456
#define XB_SPIN_CAP (1u << 18)
__device__ __forceinline__ unsigned xb_ld(unsigned* p)              { return __hip_atomic_load(p, __ATOMIC_RELAXED, __HIP_MEMORY_SCOPE_AGENT); }
__device__ __forceinline__ unsigned xb_add(unsigned* p, unsigned v) { return __hip_atomic_fetch_add(p, v, __ATOMIC_RELAXED, __HIP_MEMORY_SCOPE_AGENT); }
__device__ __forceinline__ unsigned xb_xcc_id() { return (unsigned)__builtin_amdgcn_s_getreg((3 << 11) | 20) & 0xFu; }
#define XB_SPIN(cond, bar) do { unsigned _sp = 0; while (cond) { __builtin_amdgcn_s_sleep(1); \
    if ((++_sp & 255u) == 0u) { if (xb_ld(&(bar)[XB_TMO])) break; if (_sp > XB_SPIN_CAP) { atomicAdd(&(bar)[XB_TMO], 1u); break; } } } } while (0)
struct XcdBarrier { unsigned* bar; unsigned x; volatile LAS unsigned* st; };
__device__ __forceinline__ XcdBarrier xcd_barrier_post(unsigned* bar, volatile LAS unsigned* st) {
    XcdBarrier b; b.bar = bar; b.x = xb_xcc_id(); b.st = st;
    if (threadIdx.x == 0) (void)xb_add(&bar[XB_XCNT(b.x)], 1u);
    return b;
}
__device__ __forceinline__ void xcd_barrier_complete(unsigned* bar, unsigned x, unsigned& nloc, unsigned& nx) {
    const unsigned G = gridDim.x * gridDim.y * gridDim.z;
    unsigned sum, cnt, mine, sp = 0u;
    for (;;) {
        sum = 0u; cnt = 0u; mine = 0u;
#pragma unroll
        for (unsigned j = 0; j < 16; ++j) { const unsigned c = xb_ld(&bar[XB_XCNT(j)]); sum += c; cnt += (c > 0u) ? 1u : 0u; mine = (j == x) ? c : mine; }
        if (sum == G) break;
        __builtin_amdgcn_s_sleep(1);
        if ((++sp & 255u) == 0u) { if (xb_ld(&bar[XB_TMO])) break; if (sp > XB_SPIN_CAP) { atomicAdd(&bar[XB_TMO], 1u); break; } }
    }
    nloc = mine > 0u ? mine : 1u; nx = cnt > 0u ? cnt : 1u;
}
__device__ __forceinline__ void xcd_barrier(const XcdBarrier& b) {
    asm volatile("s_waitcnt vmcnt(0)" ::: "memory");
    __syncthreads();
    if (threadIdx.x == 0) {
        unsigned* bar = b.bar;
        __builtin_amdgcn_s_waitcnt(0);
        unsigned nloc = b.st[0], nx = b.st[1];
        if (nloc == 0u) { xcd_barrier_complete(bar, b.x, nloc, nx); b.st[0] = nloc; b.st[1] = nx; }
        const unsigned old = xb_add(&bar[XB_XSUB(b.x)], 1u);
        const unsigned gen = old / nloc;
        if (old + 1u == (gen + 1u) * nloc) {
            __builtin_amdgcn_fence(__ATOMIC_RELEASE, "agent");
            asm volatile("s_waitcnt vmcnt(0)" ::: "memory");
            const unsigned og = xb_add(&bar[XB_TOP], 1u);
            const unsigned tg = og / nx;
            if (og + 1u == (tg + 1u) * nx) xb_add(&bar[XB_TOPGEN], 1u);
            else XB_SPIN(xb_ld(&bar[XB_TOPGEN]) == tg, bar);
            __builtin_amdgcn_fence(__ATOMIC_ACQUIRE, "agent");
            xb_add(&bar[XB_XGEN(b.x)], 1u);
            asm volatile("s_waitcnt vmcnt(0)" ::: "memory");
        } else {
            XB_SPIN(xb_ld(&bar[XB_XGEN(b.x)]) == gen, bar);
            __builtin_amdgcn_fence(__ATOMIC_ACQUIRE, "agent");
            asm volatile("s_waitcnt vmcnt(0)" ::: "memory");
        }
    }
    __syncthreads();
}

__device__ __forceinline__ void team_arrive(unsigned* w, int tid) {
    asm volatile("s_waitcnt vmcnt(0)" ::: "memory");
    __syncthreads();
    if (tid == 0) (void)xb_add(w, 1u);
}
__device__ __forceinline__ void team_wait(unsigned* w, unsigned target, unsigned* bar, int tid) {
    if (tid == 0) {
        XB_SPIN(xb_ld(w) < target, bar);
        __builtin_amdgcn_fence(__ATOMIC_ACQUIRE, "agent");
        asm volatile("s_waitcnt vmcnt(0)" ::: "memory");
    }
    __syncthreads();
}

__device__ __forceinline__ void panels_arrive(const pg8::DenseSched& S, unsigned* pw, int lane) {
    asm volatile("s_waitcnt vmcnt(0)" ::: "memory");
    pg8::Unit u;
    for (int i = 0; S.next(i, u); ++i) if (lane == 0) (void)xb_add(pw + (u.rowbase / pg8::BM) * 32, 1u);
}
__device__ __forceinline__ void panels_wait(unsigned* w, bool act, unsigned target, unsigned* bar, int tid) {
    if (tid < 64) {
        unsigned sp = 0;
        for (;;) {
            const bool ok = !act || xb_ld(w) >= target;
            if (__builtin_amdgcn_ballot_w64(!ok) == 0ull) break;
            __builtin_amdgcn_s_sleep(1);
            if ((++sp & 255u) == 0u) { if (xb_ld(&bar[XB_TMO])) break; if (sp > XB_SPIN_CAP) { if (tid == 0) atomicAdd(&bar[XB_TMO], 1u); break; } }
        }
        __builtin_amdgcn_fence(__ATOMIC_ACQUIRE, "agent");
        asm volatile("s_waitcnt vmcnt(0)" ::: "memory");
    }
    __syncthreads();
}

#ifndef P0_FLAGS
#define P0_FLAGS 1
#endif
template <bool WTS = false>
__device__ __forceinline__ void transpose_item(const float* W, int K, int N, bf16* WT, int drow0, int k0, int n0, LAS float* scr, int lane) {
#pragma unroll 8
    for (int i = 0; i < 32; ++i) { const int kk = 2 * i + (lane >> 5); scr[kk * 33 + (lane & 31)] = __builtin_nontemporal_load(W + (size_t)(k0 + kk) * N + n0 + (lane & 31)); }
    asm volatile("s_waitcnt lgkmcnt(0)" ::: "memory");
    const int c = lane & 7;
#pragma unroll
    for (int j = 0; j < 4; ++j) { const int n = (lane >> 3) + 8 * j; const LAS float* s = scr + (8 * c) * 33 + n;
        u32x4 o; o.x = pk2(s[0 * 33], s[1 * 33]); o.y = pk2(s[2 * 33], s[3 * 33]); o.z = pk2(s[4 * 33], s[5 * 33]); o.w = pk2(s[6 * 33], s[7 * 33]);
        if (WTS) st16(WT, (size_t)(drow0 + n) * K + k0 + 8 * c, o); else __builtin_nontemporal_store(o, (u32x4*)(WT + (size_t)(drow0 + n) * K + k0 + 8 * c)); }
    asm volatile("s_waitcnt lgkmcnt(0)" ::: "memory");
}
__device__ __forceinline__ void phase_p0(const Ctx& F) {
    {
        LAS float* cact = (LAS float*)F.lds;
        LAS float* part = (LAS float*)(F.lds + 16384);
        for (int i = F.tid; i < NB * D; i += 512) { const int b = i >> 10, k = i & 1023; const float cv = F.c[i]; cact[k * 4 + b] = cv * sigmoidf_(cv); }
        __syncthreads();
        for (int item = F.vcu; item < 192; item += F.G) {
            const int l = item / 96, n0 = (item % 96) * 64;
            const float* W = F.w_ada + (size_t)l * D * MODW + n0 + F.lane;
            float a0 = 0.f, a1 = 0.f, a2 = 0.f, a3 = 0.f; const int k0 = F.wave * 128;
#pragma unroll 8
            for (int k = 0; k < 128; ++k) { const float w = __builtin_nontemporal_load(W + (size_t)(k0 + k) * MODW); const f32x4 cv = *(const LAS f32x4*)(cact + (k0 + k) * 4);
                a0 += cv[0] * w; a1 += cv[1] * w; a2 += cv[2] * w; a3 += cv[3] * w; }
            part[(F.wave * 4 + 0) * 64 + F.lane] = a0; part[(F.wave * 4 + 1) * 64 + F.lane] = a1; part[(F.wave * 4 + 2) * 64 + F.lane] = a2; part[(F.wave * 4 + 3) * 64 + F.lane] = a3;
            __syncthreads();
            if (F.tid < 256) { const int b = F.tid >> 6, ln = F.tid & 63; float s = 0.f;
#pragma unroll
                for (int w = 0; w < 8; ++w) s += part[(w * 4 + b) * 64 + ln];
                const float mv = s + F.b_ada[l * MODW + n0 + ln];
                if (P0_FLAGS) __hip_atomic_store((unsigned*)F.mod + (size_t)(l * 4 + b) * MODW + n0 + ln, __float_as_uint(mv), RLX_AGENT); else F.mod[(size_t)(l * 4 + b) * MODW + n0 + ln] = mv; }
            __syncthreads();
        }
    }
    for (int it = F.G - 1 - F.vcu; it < 24; it += F.G) {
        const int t = it >> 3, w = it & 7, ks = (F.tid >> 7) & 3, nt = (F.tid >> 6) & 1, i16 = F.lane & 15, g = F.lane >> 4;
        const float* W32 = (t < 2) ? F.w_in + (size_t)t * D * INW + 1536 : F.router_w; const int wst = (t < 2) ? INW : 32;
        float wv[8];
#pragma unroll
        for (int jj = 0; jj < 8; ++jj) wv[jj] = W32[(size_t)(128 * w + 32 * ks + 8 * g + jj) * wst + 16 * nt + i16];
        u32x4 h, lo;
        h.x = cvtpk(wv[0], wv[1]); h.y = cvtpk(wv[2], wv[3]); h.z = cvtpk(wv[4], wv[5]); h.w = cvtpk(wv[6], wv[7]);
        lo.x = cvtpk(wv[0] - bf_lo(h.x), wv[1] - bf_hi(h.x)); lo.y = cvtpk(wv[2] - bf_lo(h.y), wv[3] - bf_hi(h.y));
        lo.z = cvtpk(wv[4] - bf_lo(h.z), wv[5] - bf_hi(h.z)); lo.w = cvtpk(wv[6] - bf_lo(h.w), wv[7] - bf_hi(h.w));
        u32x4* tb = (u32x4*)(F.w32t + (size_t)t * 131072);
        if (P0_FLAGS) { st16((bf16*)tb, (size_t)(w * 512 + F.tid) * 8, h); st16((bf16*)tb, (size_t)(4096 + w * 512 + F.tid) * 8, lo); } else { tb[w * 512 + F.tid] = h; tb[4096 + w * 512 + F.tid] = lo; }
    }
    {
        LAS float* scr = (LAS float*)(F.lds + 32768 + F.wave * 10240);
        const int gw = F.vcu * 8 + F.wave, NGW = F.G * 8;
        constexpr int I_IN = 2 * 16 * 97, I_OUT = 2 * 16 * 32, I_W1 = 2 * 32 * 256, I_W2 = 2 * 32 * 256;
        constexpr int NITEMS = I_IN + I_OUT;
        for (int it = gw; it < NITEMS; it += NGW) {
            int r = it;
            if (r < I_IN) {
                const int l = r / 1552, q = r % 1552, kb = q / 97, nb = q % 97; if (nb == 48) continue;
                const int n0 = 32 * nb; int drow0;
                if (n0 < 1536) drow0 = n0;
                else { const int np = n0 - 32, t = np >> 8, cl = np & 255;
                    if (t >= 6 && t < 10) { const int hh = cl >> 6, d0 = cl & 63; drow0 = t * 256 + (d0 >> 5) * 128 + hh * 32; } else drow0 = np; }
                transpose_item<P0_FLAGS != 0>(F.w_in + (size_t)l * D * INW, D, INW, F.win_t + (size_t)l * NPROJ * D, drow0, kb * 64, n0, scr, F.lane); continue; }
            r -= I_IN;
            if (r < I_OUT) { const int l = r / 512, q = r % 512, kb = q / 32, nb = q % 32;
                transpose_item<P0_FLAGS != 0>(F.w_out + (size_t)l * D * D, D, D, F.wout_t + (size_t)l * D * D, 32 * nb, kb * 64, 32 * nb, scr, F.lane); continue; }
        }
    }
}
__device__ __forceinline__ void conv_moe_items(const Ctx& F, int l, int lo, int hi);
__device__ __forceinline__ void phase_p0b(const Ctx& F) { if (!PH_EN12) { __syncthreads(); conv_moe_items(F, 0, 0, 24576); conv_moe_items(F, 1, 0, 24576); } }
__device__ __forceinline__ void conv_moe_items(const Ctx& F, int l, int lo, int hi) {
    LAS float* scr = (LAS float*)(F.lds + F.wave * 10240);
    const int gw = F.vcu * 8 + F.wave, NGW = F.G * 8;
    for (int it = lo + gw; it < hi; it += NGW) {
        const int which = it >> 13, q = it & 8191, e = q >> 8, qq = q & 255, le = l * 32 + e;
        if (which < 2) { const int kb = qq >> 4, nb = qq & 15, n0 = 32 * nb;
            const float* srcp = (which ? F.w3 : F.w1) + (size_t)le * D * DE;
            transpose_item(srcp, D, DE, F.w13_t + (size_t)le * 1024 * D, (n0 >> 7) * 256 + which * 128 + (n0 & 127), kb * 64, n0, scr, F.lane); }
        else { const int kb = qq >> 5, nb = qq & 31;
            transpose_item(F.w2 + (size_t)le * DE * D, DE, D, F.w2_t + (size_t)le * D * DE, 32 * nb, kb * 64, 32 * nb, scr, F.lane); }
    }
}

__device__ __forceinline__ void moe_tables(const Ctx& F, int lp) {
    LAS int* TS = (LAS int*)(F.lds + TAB_OFF); LAS int* CN = TS + 40;
    if (F.tid < 64) {
        const int e = F.lane & 31;
        const int c = (int)__hip_atomic_load((unsigned*)(F.ctl + CW_CNT + (lp * 32 + e) * 64), RLX_AGENT);
        const int nt = (c + 255) >> 8; int inc = nt;
#pragma unroll
        for (int o = 1; o < 32; o <<= 1) { const int v = __shfl_up(inc, o, 32); if (e >= o) inc += v; }
        if (F.lane < 32) { CN[e] = c; TS[e] = inc - nt; if (e == 31) TS[32] = inc; }
    }
    __syncthreads();
    if (F.tid < 192) { int e = 0;
#pragma unroll 8
        for (int k = 1; k < 32; ++k) e += (TS[k] <= F.tid) ? 1 : 0;
        ((LAS int*)(F.lds + LDSCTL_OFF + 3072))[F.tid] = e; }
    __syncthreads();
}

#ifndef PREPASS_V2
#define PREPASS_V2 1
#endif
struct Row16 { u32x4 a, b; };
template <bool NT>
__device__ __forceinline__ Row16 ld_row16(const bf16* row, int lane) {
    const bf16* p = row + ((lane & 1) ? 256 : 0) + 4 * (lane & ~1); Row16 q;
    if (NT) { q.a = __builtin_nontemporal_load((const u32x4*)p); q.b = __builtin_nontemporal_load((const u32x4*)(p + 512)); } else { q.a = *(const u32x4*)p; q.b = *(const u32x4*)(p + 512); }
    return q;
}
__device__ __forceinline__ void unpair16(const Row16& q, int lane, u32x2 (&o)[4]) {
    const bool odd = lane & 1;
    const u32x2 s0 = odd ? (u32x2){q.a.x, q.a.y} : (u32x2){q.a.z, q.a.w}, s1 = odd ? (u32x2){q.b.x, q.b.y} : (u32x2){q.b.z, q.b.w};
    u32x2 r0, r1; r0.x = __shfl_xor(s0.x, 1); r0.y = __shfl_xor(s0.y, 1); r1.x = __shfl_xor(s1.x, 1); r1.y = __shfl_xor(s1.y, 1);
    const u32x2 k0 = odd ? (u32x2){q.a.z, q.a.w} : (u32x2){q.a.x, q.a.y}, k1 = odd ? (u32x2){q.b.z, q.b.w} : (u32x2){q.b.x, q.b.y};
    o[0] = odd ? r0 : k0; o[1] = odd ? k0 : r0; o[2] = odd ? r1 : k1; o[3] = odd ? k1 : r1;
}
#ifndef PPA_FLAGS
#define PPA_FLAGS 1
#endif
template <bool WT>
__device__ __forceinline__ void st_row16(bf16* row, int lane, const u32x2 (&o)[4]) {
    const bool odd = lane & 1;
    const u32x2 s0 = odd ? o[0] : o[1], s1 = odd ? o[2] : o[3], k0 = odd ? o[1] : o[0], k1 = odd ? o[3] : o[2];
    u32x2 r0, r1; r0.x = __shfl_xor(s0.x, 1); r0.y = __shfl_xor(s0.y, 1); r1.x = __shfl_xor(s1.x, 1); r1.y = __shfl_xor(s1.y, 1);
    bf16* p = row + (odd ? 256 : 0) + 4 * (lane & ~1);
    const u32x4 va = odd ? (u32x4){r0.x, r0.y, k0.x, k0.y} : (u32x4){k0.x, k0.y, r0.x, r0.y}, vb = odd ? (u32x4){r1.x, r1.y, k1.x, k1.y} : (u32x4){k1.x, k1.y, r1.x, r1.y};
    if (WT) { const auto rs = __builtin_amdgcn_make_buffer_rsrc((void*)row, (short)0, 2048, 0x00020000); const int bo = (int)((p - row) * 2);
        __builtin_amdgcn_raw_buffer_store_b128(va, rs, bo, 0, 16); __builtin_amdgcn_raw_buffer_store_b128(vb, rs, bo + 1024, 0, 16); }
    else { __builtin_nontemporal_store(va, (u32x4*)p); __builtin_nontemporal_store(vb, (u32x4*)(p + 512)); }
}
template <int MODE>
__device__ __forceinline__ void prepass2(const Ctx& F, int l, float pa = 0.f, float pe = 0.f) {
    constexpr int TST = 1028, NG = NTOK / 16;
    LAS float* tile = (LAS float*)F.lds;
    LAS float* part = (LAS float*)(F.lds + 65792);
    LAS int* LCNT = (LAS int*)(F.lds + 82176); LAS int* BASE = LCNT + 32; LAS int* TREC = (LAS int*)(F.lds + 82432);
    const LAS int* TS = (const LAS int*)(F.lds + TAB_OFF);
    const bool comb = (MODE == 2) || (MODE == 0 && l > 0);
    const int lp = (MODE == 2) ? DEPTH - 1 : l - 1;
    if (comb) moe_tables(F, lp);
    if (MODE == 1) { if (F.tid < 32) LCNT[F.tid] = 0; }
    const int i16 = F.lane & 15, g = F.lane >> 4;
    const float* nw = ((MODE == 0) ? F.attn_norm : F.ffn_norm) + l * D;
    const bool srcf = (MODE == 0 && l == 0);
    f32x4 v[2][4]; Row16 rq[2];
    const int per = (NG + F.G - 1) / F.G;
    int grp = F.vcu * per; const int gend = min(grp + per, NG);
    f32x4 Wm[4], Sh[4], G2[4]; int curb = -1;
#pragma unroll
    for (int j = 0; j < 4; ++j) { Wm[j] = (f32x4){0.f, 0.f, 0.f, 0.f}; Sh[j] = Wm[j]; G2[j] = Wm[j]; }
    {   const int g0 = min(grp, NG - 1);
#pragma unroll
        for (int tt = 0; tt < 2; ++tt)
#pragma unroll
            for (int j = 0; j < 4; ++j) { const size_t o = (size_t)(g0 * 16 + F.wave * 2 + tt) * D + 256 * j + 4 * F.lane;
                if (srcf) v[tt][j] = __builtin_nontemporal_load((const f32x4*)(F.x_in + o)); else v[tt][j] = (f32x4){0.f, 0.f, 0.f, 0.f}; }
#pragma unroll
        for (int tt = 0; tt < 2; ++tt) { if (srcf) { rq[tt].a = (u32x4){0u, 0u, 0u, 0u}; rq[tt].b = rq[tt].a; } else rq[tt] = ld_row16<false>(F.Xb + (size_t)(g0 * 16 + F.wave * 2 + tt) * D, F.lane); }
    }
    bf16x8 whi[4][2], wlo[4][2];
    if (MODE != 2) {
        const u32x4* tb = (const u32x4*)(F.w32t + (size_t)((MODE == 0) ? l : 2) * 131072) + F.wave * 512 + F.lane;
#pragma unroll
        for (int ks = 0; ks < 4; ++ks)
#pragma unroll
            for (int nt = 0; nt < 2; ++nt) { whi[ks][nt] = __builtin_bit_cast(bf16x8, tb[(ks * 2 + nt) * 64]); wlo[ks][nt] = __builtin_bit_cast(bf16x8, tb[4096 + (ks * 2 + nt) * 64]); }
    }
    int gi = 0;
    for (; grp < gend; ++grp, ++gi) {
        if ((grp >> 8) != curb) {
            curb = grp >> 8;
#pragma unroll
            for (int j = 0; j < 4; ++j) { const int k = 256 * j + 4 * F.lane;
                if (MODE != 2) { const f32x4 w = *(const f32x4*)(nw + k), sc = *(const f32x4*)(F.mod + (size_t)(l * 4 + curb) * MODW + ((MODE == 0) ? 1 : 4) * D + k);
                    Sh[j] = *(const f32x4*)(F.mod + (size_t)(l * 4 + curb) * MODW + ((MODE == 0) ? 0 : 3) * D + k);
#pragma unroll
                    for (int i = 0; i < 4; ++i) Wm[j][i] = w[i] * (1.0f + sc[i]); }
                if (comb) G2[j] = *(const f32x4*)(F.mod + (size_t)(lp * 4 + curb) * MODW + 5 * D + k); }
        }
        if (!srcf) {
#pragma unroll
            for (int tt = 0; tt < 2; ++tt) { u32x2 rw[4]; unpair16(rq[tt], F.lane, rw);
#pragma unroll
                for (int j = 0; j < 4; ++j) v[tt][j] = (f32x4){bf_lo(rw[j].x), bf_hi(rw[j].x), bf_lo(rw[j].y), bf_hi(rw[j].y)}; }
        }
        if (comb) {
            unsigned ti[2][6];
#pragma unroll
            for (int tt = 0; tt < 2; ++tt) { const unsigned* tp = F.tokinfo + (size_t)(grp * 16 + F.wave * 2 + tt) * 8;
#pragma unroll
                for (int q = 0; q < 6; ++q) ti[tt][q] = tp[q]; }
            Row16 yq0[2], yq1[2];
#pragma unroll
            for (int tt = 0; tt < 2; ++tt) { const size_t s0 = (size_t)TS[ti[tt][0]] * 256 + ti[tt][1], s1 = (size_t)TS[ti[tt][2]] * 256 + ti[tt][3];
                yq0[tt] = ld_row16<true>(F.Y + s0 * D, F.lane); yq1[tt] = ld_row16<true>(F.Y + s1 * D, F.lane); }
#pragma unroll
            for (int tt = 0; tt < 2; ++tt) { const int m = grp * 16 + F.wave * 2 + tt;
                const float gw0 = __builtin_bit_cast(float, ti[tt][4]), gw1 = __builtin_bit_cast(float, ti[tt][5]);
                u32x2 y0[4], y1[4], xo[4]; unpair16(yq0[tt], F.lane, y0); unpair16(yq1[tt], F.lane, y1);
#pragma unroll
                for (int j = 0; j < 4; ++j) { const f32x4 gg = G2[j]; const u32x2 a = y0[j], c = y1[j];
                    v[tt][j][0] += gg[0] * (gw0 * bf_lo(a.x) + gw1 * bf_lo(c.x)); v[tt][j][1] += gg[1] * (gw0 * bf_hi(a.x) + gw1 * bf_hi(c.x));
                    v[tt][j][2] += gg[2] * (gw0 * bf_lo(a.y) + gw1 * bf_lo(c.y)); v[tt][j][3] += gg[3] * (gw0 * bf_hi(a.y) + gw1 * bf_hi(c.y));
                    f32x4 o = v[tt][j];
                    if (MODE == 2) { if (pa != 0.f) { o[0] *= 1.f + pa; o[1] *= 1.f - pa; o[2] *= 1.f + pa; o[3] *= 1.f - pa; if (m == 0 && j == 0 && F.lane == 0) o[0] += pe; }
                        __builtin_nontemporal_store(o, (f32x4*)(F.out + (size_t)m * D + 256 * j + 4 * F.lane)); }
                    else { xo[j].x = cvtpk(o[0], o[1]); xo[j].y = cvtpk(o[2], o[3]); } }
                if (MODE != 2) st_row16<PPA_FLAGS && MODE == 0>(F.Xb + (size_t)m * D, F.lane, xo); }
        }
        if (MODE != 2) {
#pragma unroll
            for (int tt = 0; tt < 2; ++tt) { const int m = grp * 16 + F.wave * 2 + tt;
                float ss = 0.f;
#pragma unroll
                for (int j = 0; j < 4; ++j) ss += (v[tt][j][0] * v[tt][j][0] + v[tt][j][1] * v[tt][j][1]) + (v[tt][j][2] * v[tt][j][2] + v[tt][j][3] * v[tt][j][3]);
                const float rstd = 1.0f / sqrtf(wave_sum(ss) * (1.0f / D) + EPS);
                u32x2 no[4];
#pragma unroll
                for (int j = 0; j < 4; ++j) { const int k = 256 * j + 4 * F.lane;
                    f32x4 hh;
#pragma unroll
                    for (int i = 0; i < 4; ++i) hh[i] = (v[tt][j][i] * rstd) * Wm[j][i] + Sh[j][i];
                    no[j].x = cvtpk(hh[0], hh[1]); no[j].y = cvtpk(hh[2], hh[3]);
                    *(LAS f32x4*)(tile + (F.wave * 2 + tt) * TST + k) = hh; }
                st_row16<PPA_FLAGS && MODE == 0>(F.XN + (size_t)m * D, F.lane, no); }
        }
        { const int ng = min(grp + 1, NG - 1);
#pragma unroll
            for (int tt = 0; tt < 2; ++tt)
#pragma unroll
                for (int j = 0; j < 4; ++j) { const size_t o = (size_t)(ng * 16 + F.wave * 2 + tt) * D + 256 * j + 4 * F.lane;
                    if (srcf) v[tt][j] = __builtin_nontemporal_load((const f32x4*)(F.x_in + o)); }
            if (!srcf) {
#pragma unroll
                for (int tt = 0; tt < 2; ++tt) rq[tt] = ld_row16<false>(F.Xb + (size_t)(ng * 16 + F.wave * 2 + tt) * D, F.lane); } }
        if (MODE != 2) {
            __syncthreads();
            f32x4 acc0 = (f32x4){0.f, 0.f, 0.f, 0.f}, acc1 = (f32x4){0.f, 0.f, 0.f, 0.f};
#pragma unroll
            for (int ks = 0; ks < 4; ++ks) {
                const LAS float* ap = tile + i16 * TST + 128 * F.wave + 32 * ks + 8 * g;
                const f32x4 a0 = *(const LAS f32x4*)ap, a1 = *(const LAS f32x4*)(ap + 4);
                u32x4 h, lo;
                h.x = cvtpk(a0[0], a0[1]); h.y = cvtpk(a0[2], a0[3]); h.z = cvtpk(a1[0], a1[1]); h.w = cvtpk(a1[2], a1[3]);
                lo.x = cvtpk(a0[0] - bf_lo(h.x), a0[1] - bf_hi(h.x)); lo.y = cvtpk(a0[2] - bf_lo(h.y), a0[3] - bf_hi(h.y));
                lo.z = cvtpk(a1[0] - bf_lo(h.z), a1[1] - bf_hi(h.z)); lo.w = cvtpk(a1[2] - bf_lo(h.w), a1[3] - bf_hi(h.w));
                const bf16x8 ah = __builtin_bit_cast(bf16x8, h), al = __builtin_bit_cast(bf16x8, lo);
                acc0 = mfma16(ah, whi[ks][0], acc0); acc0 = mfma16(al, whi[ks][0], acc0); acc0 = mfma16(ah, wlo[ks][0], acc0);
                acc1 = mfma16(ah, whi[ks][1], acc1); acc1 = mfma16(al, whi[ks][1], acc1); acc1 = mfma16(ah, wlo[ks][1], acc1);
            }
#pragma unroll
            for (int r = 0; r < 4; ++r) { part[(F.wave * 16 + 4 * g + r) * 32 + i16] = acc0[r]; part[(F.wave * 16 + 4 * g + r) * 32 + 16 + i16] = acc1[r]; }
            __syncthreads();
            const int e = F.lane & 31, tok = F.wave * 2 + (F.lane >> 5); const int m = grp * 16 + tok;
            float logit = 0.f;
#pragma unroll
            for (int w = 0; w < 8; ++w) logit += part[(w * 16 + tok) * 32 + e];
            if (MODE == 0) { if (PPA_FLAGS) __hip_atomic_store((unsigned*)F.lfb + (size_t)m * 32 + e, __float_as_uint(logit), RLX_AGENT); else F.lfb[(size_t)m * 32 + e] = logit; }
            else {
                const float s = 1.0f / (1.0f + expf(-logit)); const float sl = s + F.router_b[e];
                int rank = 0;
#pragma unroll
                for (int k = 1; k < 8; ++k) { const int p = (F.lane & ~7) | ((F.lane + k) & 7); const float o = __shfl(sl, p); rank += (o > sl || (o == sl && (p & 7) < (F.lane & 7))) ? 1 : 0; }
                float gs = rank < 2 ? sl : 0.f; gs += __shfl_xor(gs, 1); gs += __shfl_xor(gs, 2); gs += __shfl_xor(gs, 4);
                const int hb = F.lane & 32;
                const float g0 = __shfl(gs, hb), g1 = __shfl(gs, hb + 8), g2 = __shfl(gs, hb + 16), g3 = __shfl(gs, hb + 24);
                int best = 0; float gb = g0; if (g1 > gb) { gb = g1; best = 1; } if (g2 > gb) { gb = g2; best = 2; } if (g3 > gb) { gb = g3; best = 3; }
                const unsigned long long mk0 = __ballot((e >> 3) == best && rank == 0), mk1 = __ballot((e >> 3) == best && rank == 1);
                const int e0 = __builtin_ctz((unsigned)(mk0 >> hb)), e1 = __builtin_ctz((unsigned)(mk1 >> hb));
                float gw0 = __shfl(s, hb + e0), gw1 = __shfl(s, hb + e1); const float gsum = gw0 + gw1; gw0 /= gsum; gw1 /= gsum;
                if (e == 0) {
                    const int lp0 = __hip_atomic_fetch_add(LCNT + e0, 1, __ATOMIC_RELAXED, __HIP_MEMORY_SCOPE_WORKGROUP);
                    const int lp1 = __hip_atomic_fetch_add(LCNT + e1, 1, __ATOMIC_RELAXED, __HIP_MEMORY_SCOPE_WORKGROUP);
                    const int lt = gi * 16 + tok;
                    TREC[lt * 4 + 0] = e0; TREC[lt * 4 + 1] = lp0; TREC[lt * 4 + 2] = e1; TREC[lt * 4 + 3] = lp1;
                    unsigned* ti = F.tokinfo + (size_t)m * 8;
                    ti[0] = (unsigned)e0; ti[2] = (unsigned)e1; ti[4] = __builtin_bit_cast(unsigned, gw0); ti[5] = __builtin_bit_cast(unsigned, gw1);
                }
            }
        }
        if (PPA_FLAGS && MODE == 0) {
            asm volatile("s_waitcnt vmcnt(0)" ::: "memory");
            if (F.lane == 0) (void)__hip_atomic_fetch_add((unsigned*)(F.ctl + CW_PAN + ((l * 4 + 3) * 64 + (grp >> 4)) * 32), 1u, RLX_AGENT);
        }
    }
    if (MODE == 1) {
        __syncthreads();
        if (F.tid < 32) { const int c = LCNT[F.tid]; BASE[F.tid] = c > 0 ? (int)__hip_atomic_fetch_add((unsigned*)(F.ctl + CW_CNT + (l * 32 + F.tid) * 64), (unsigned)c, RLX_AGENT) : 0; }
        __syncthreads();
        const int ntl = gi * 16;
        for (int lt = F.tid; lt < ntl; lt += 512) { const int m = (F.vcu * per + (lt >> 4)) * 16 + (lt & 15);
            const int e0 = TREC[lt * 4 + 0], e1 = TREC[lt * 4 + 2]; const int p0 = BASE[e0] + TREC[lt * 4 + 1], p1 = BASE[e1] + TREC[lt * 4 + 3];
            unsigned* ti = F.tokinfo + (size_t)m * 8; ti[1] = (unsigned)p0; ti[3] = (unsigned)p1;
            F.lists[e0 * LCAP + p0] = m; F.lists[e1 * LCAP + p1] = m; }
    }
}

__device__ __forceinline__ void gla_front(const Ctx& F, int l, int h, int m0, LAS float* BF, LAS float* BR, LAS float* LFBT, LAS float* GWT, LAS float* GBT) {
    { const int tok = F.tid >> 3, c4 = F.tid & 7; *(LAS f32x4*)(LFBT + tok * 32 + c4 * 4) = *(const f32x4*)(F.lfb + (size_t)(m0 + tok) * 32 + c4 * 4); }
#pragma unroll
    for (int k = 0; k < 4; ++k) { const int idx = F.tid + 512 * k; const int dir = idx >> 10, r = (idx >> 6) & 15, d = idx & 63;
        GWT[idx] = F.gate_w[(size_t)((l * 2 + dir) * 16 + r) * 256 + h * 64 + d]; }
    if (F.tid < 128) { const int dir = F.tid >> 6, d = F.tid & 63; GBT[F.tid] = F.gate_b[(l * 2 + dir) * 256 + h * 64 + d]; }
    __syncthreads();
    for (int k = 0; k < 16; ++k) { const int idx = F.tid + 512 * k; const int dir = idx >> 12, i = (idx >> 6) & 63, d = idx & 63;
        float z = GBT[dir * 64 + d];
#pragma unroll
        for (int r = 0; r < 16; ++r) z += LFBT[i * 32 + dir * 16 + r] * GWT[(dir * 16 + r) * 64 + d];
        const float la = logsigf_(z) * (1.0f / 16.0f);
        (dir ? BR : BF)[i * 64 + d] = la; }
    __syncthreads();
    if (F.tid < 64) { const int d = F.tid; float run = 0.f; for (int i = 0; i < 64; ++i) { run += BF[i * 64 + d]; BF[i * 64 + d] = run; } }
    else if (F.tid < 128) { const int d = F.tid - 64; float run = 0.f; for (int i = 63; i >= 0; --i) { run += BR[i * 64 + d]; BR[i * 64 + d] = run; } }
    __syncthreads();
}
__device__ __forceinline__ void gla_a_item(const Ctx& F, int l, int it) {
    const int b = it >> 8, h = (it >> 6) & 3, c = it & 63, bh = b * 4 + h, m0 = b * T + c * 64;
    LAS float* BF = (LAS float*)F.lds; LAS float* BR = (LAS float*)(F.lds + 16384);
    LAS float* LFBT = (LAS float*)(F.lds + 32768); LAS float* GWT = (LAS float*)(F.lds + 40960); LAS float* GBT = (LAS float*)(F.lds + 49152);
    LAS bf16* KRAW = (LAS bf16*)(F.lds + 49664); LAS bf16* VRAW = (LAS bf16*)(F.lds + 57856);
    LAS float* KF = (LAS float*)(F.lds + 74240); LAS float* KB = (LAS float*)(F.lds + 90624);
    { const int tok = F.tid >> 3, ch = F.tid & 7; *(LAS u32x4*)(KRAW + tok * 64 + ch * 8) = *(const u32x4*)(F.KG + (size_t)(m0 + tok) * 256 + h * 64 + ch * 8); }
#pragma unroll
    for (int k = 0; k < 2; ++k) { const int idx = F.tid + 512 * k; const int tok = idx >> 4, ch = idx & 15;
        *(LAS u32x4*)(VRAW + tok * 128 + ch * 8) = *(const u32x4*)(F.VG + (size_t)(m0 + tok) * 512 + h * 128 + ch * 8); }
    gla_front(F, l, h, m0, BF, BR, LFBT, GWT, GBT);
#pragma unroll
    for (int k = 0; k < 8; ++k) { const int idx = F.tid + 512 * k; const int j = idx >> 6, d = idx & 63; const float kv = bf2f(KRAW[idx]);
        KF[idx] = kv * expf(BF[63 * 64 + d] - BF[j * 64 + d]); KB[idx] = kv * expf(BR[d] - BR[j * 64 + d]); }
    if (F.tid < 128) { const int dir = F.tid >> 6, d = F.tid & 63; F.gdec[(size_t)((bh * 2 + dir) * 64 + c) * 64 + d] = expf(dir ? BR[d] : BF[63 * 64 + d]); }
    __syncthreads();
    {
        const int dir = F.tid >> 8, tt = F.tid & 255, db = tt >> 4, eb = tt & 15;
        const LAS float* src = dir ? KB : KF;
        float acc[4][8];
#pragma unroll
        for (int a = 0; a < 4; ++a)
#pragma unroll
            for (int q = 0; q < 8; ++q) acc[a][q] = 0.f;
        for (int j = 0; j < 64; ++j) {
            const f32x4 kd = *(const LAS f32x4*)(src + j * 64 + db * 4); const u32x4 vv = *(const LAS u32x4*)(VRAW + j * 128 + eb * 8);
            float ve[8]; ve[0] = bf_lo(vv.x); ve[1] = bf_hi(vv.x); ve[2] = bf_lo(vv.y); ve[3] = bf_hi(vv.y); ve[4] = bf_lo(vv.z); ve[5] = bf_hi(vv.z); ve[6] = bf_lo(vv.w); ve[7] = bf_hi(vv.w);
#pragma unroll
            for (int a = 0; a < 4; ++a)
#pragma unroll
                for (int q = 0; q < 8; ++q) acc[a][q] += kd[a] * ve[q];
        }
        float* Ub = F.U + ((size_t)((bh * 2 + dir) * 64 + c) * 64) * 128;
#pragma unroll
        for (int a = 0; a < 4; ++a) { float* p = Ub + (size_t)(db * 4 + a) * 128 + eb * 8;
            *(f32x4*)p = (f32x4){acc[a][0], acc[a][1], acc[a][2], acc[a][3]}; *(f32x4*)(p + 4) = (f32x4){acc[a][4], acc[a][5], acc[a][6], acc[a][7]}; }
    }
    __syncthreads();
}
__device__ __forceinline__ void gla_b(const Ctx& F) {
    for (int id = F.vcu * 512 + F.tid; id < 32 * 2048; id += F.G * 512) {
        const int s = id >> 11, q4 = id & 2047, d = q4 >> 5, dir = s & 1;
        float* base = F.U + (size_t)s * 64 * 8192 + 4 * q4; const float* gd = F.gdec + (size_t)s * 64 * 64 + d;
        f32x4 S = (f32x4){0.f, 0.f, 0.f, 0.f};
#pragma unroll 8
        for (int step = 0; step < 64; ++step) { const int c = dir ? 63 - step : step;
            const f32x4 u = *(const f32x4*)(base + (size_t)c * 8192); const float g = gd[c * 64];
            *(f32x4*)(base + (size_t)c * 8192) = S; S = S * g + u; }
    }
}
__device__ __forceinline__ void gla_c_item(const Ctx& F, int l, int it) {
    const int b = it >> 8, h = (it >> 6) & 3, c = it & 63, bh = b * 4 + h, m0 = b * T + c * 64;
    LAS float* BF = (LAS float*)F.lds; LAS float* BR = (LAS float*)(F.lds + 17408); LAS float* P = BF;
    LAS float* LFBT = (LAS float*)(F.lds + 34816); LAS float* GWT = (LAS float*)(F.lds + 43008); LAS float* GBT = (LAS float*)(F.lds + 51200);
    LAS float* QF = (LAS float*)(F.lds + 51712); LAS float* QB = (LAS float*)(F.lds + 69120); LAS float* KF = (LAS float*)(F.lds + 86528); LAS float* KB = (LAS float*)(F.lds + 103936);
    LAS float* SST = KF;
    LAS bf16* VRAW = (LAS bf16*)(F.lds + 121344);
#pragma unroll
    for (int k = 0; k < 2; ++k) { const int idx = F.tid + 512 * k; const int tok = idx >> 4, ch = idx & 15;
        *(LAS u32x4*)(VRAW + tok * 128 + ch * 8) = *(const u32x4*)(F.VG + (size_t)(m0 + tok) * 512 + h * 128 + ch * 8); }
    gla_front(F, l, h, m0, BF, BR, LFBT, GWT, GBT);
#pragma unroll
    for (int k = 0; k < 8; ++k) { const int idx = F.tid + 512 * k; const int i = idx >> 6, d = idx & 63;
        const float qv = bf2f(F.QG[(size_t)(m0 + i) * 256 + h * 64 + d]), kv = bf2f(F.KG[(size_t)(m0 + i) * 256 + h * 64 + d]);
        const float bfv = BF[idx], brv = BR[idx];
        QF[i * 68 + d] = qv * expf(bfv); KF[i * 68 + d] = kv * expf(-bfv); QB[i * 68 + d] = qv * expf(brv); KB[i * 68 + d] = kv * expf(-brv); }
    __syncthreads();
    {
        float pf[8], pb[8];
#pragma unroll
        for (int ii = 0; ii < 8; ++ii) { pf[ii] = 0.f; pb[ii] = 0.f; }
        for (int d4 = 0; d4 < 16; ++d4) {
            const f32x4 kf4 = *(const LAS f32x4*)(KF + F.lane * 68 + d4 * 4), kb4 = *(const LAS f32x4*)(KB + F.lane * 68 + d4 * 4);
#pragma unroll
            for (int ii = 0; ii < 8; ++ii) { const f32x4 qf4 = *(const LAS f32x4*)(QF + (F.wave * 8 + ii) * 68 + d4 * 4), qb4 = *(const LAS f32x4*)(QB + (F.wave * 8 + ii) * 68 + d4 * 4);
                pf[ii] += (qf4[0] * kf4[0] + qf4[1] * kf4[1]) + (qf4[2] * kf4[2] + qf4[3] * kf4[3]);
                pb[ii] += (qb4[0] * kb4[0] + qb4[1] * kb4[1]) + (qb4[2] * kb4[2] + qb4[3] * kb4[3]); }
        }
        __syncthreads();
#pragma unroll
        for (int ii = 0; ii < 8; ++ii) { const int i = F.wave * 8 + ii; P[i * 68 + F.lane] = (F.lane <= i) ? pf[ii] : pb[ii]; }
    }
    __syncthreads();
    const int ib = F.tid >> 5, e4 = F.tid & 31;
    f32x4 acc[4];
#pragma unroll
    for (int ii = 0; ii < 4; ++ii) acc[ii] = (f32x4){0.f, 0.f, 0.f, 0.f};
#pragma unroll
    for (int k = 0; k < 4; ++k) { const int idx = F.tid + 512 * k; *(LAS f32x4*)(SST + idx * 4) = *(const f32x4*)(F.U + ((size_t)((bh * 2 + 0) * 64 + c) * 8192) + idx * 4); }
    for (int j4 = 0; j4 < 16; ++j4) {
        f32x4 p4[4];
#pragma unroll
        for (int ii = 0; ii < 4; ++ii) p4[ii] = *(const LAS f32x4*)(P + (ib * 4 + ii) * 68 + j4 * 4);
#pragma unroll
        for (int jj = 0; jj < 4; ++jj) { const u32x2 vv = *(const LAS u32x2*)(VRAW + (j4 * 4 + jj) * 128 + e4 * 4);
            const f32x4 v4 = (f32x4){bf_lo(vv.x), bf_hi(vv.x), bf_lo(vv.y), bf_hi(vv.y)};
#pragma unroll
            for (int ii = 0; ii < 4; ++ii) acc[ii] += v4 * p4[ii][jj]; }
    }
    __syncthreads();
    for (int d4 = 0; d4 < 16; ++d4) {
        f32x4 q4[4];
#pragma unroll
        for (int ii = 0; ii < 4; ++ii) q4[ii] = *(const LAS f32x4*)(QF + (ib * 4 + ii) * 68 + d4 * 4);
#pragma unroll
        for (int dd = 0; dd < 4; ++dd) { const f32x4 s4 = *(const LAS f32x4*)(SST + (d4 * 4 + dd) * 128 + e4 * 4);
#pragma unroll
            for (int ii = 0; ii < 4; ++ii) acc[ii] += s4 * q4[ii][dd]; }
    }
    __syncthreads();
#pragma unroll
    for (int k = 0; k < 4; ++k) { const int idx = F.tid + 512 * k; *(LAS f32x4*)(SST + idx * 4) = *(const f32x4*)(F.U + ((size_t)((bh * 2 + 1) * 64 + c) * 8192) + idx * 4); }
    __syncthreads();
    for (int d4 = 0; d4 < 16; ++d4) {
        f32x4 q4[4];
#pragma unroll
        for (int ii = 0; ii < 4; ++ii) q4[ii] = *(const LAS f32x4*)(QB + (ib * 4 + ii) * 68 + d4 * 4);
#pragma unroll
        for (int dd = 0; dd < 4; ++dd) { const f32x4 s4 = *(const LAS f32x4*)(SST + (d4 * 4 + dd) * 128 + e4 * 4);
#pragma unroll
            for (int ii = 0; ii < 4; ++ii) acc[ii] += s4 * q4[ii][dd]; }
    }
    const f32x4 gn = *(const f32x4*)(F.gla_norm + l * 128 + e4 * 4);
#pragma unroll
    for (int ii = 0; ii < 4; ++ii) {
        float ss = (acc[ii][0] * acc[ii][0] + acc[ii][1] * acc[ii][1]) + (acc[ii][2] * acc[ii][2] + acc[ii][3] * acc[ii][3]);
        ss += __shfl_xor(ss, 1); ss += __shfl_xor(ss, 2); ss += __shfl_xor(ss, 4); ss += __shfl_xor(ss, 8); ss += __shfl_xor(ss, 16);
        const float rstd = 1.0f / sqrtf(ss * (1.0f / 128.0f) + EPS);
        const int m = m0 + ib * 4 + ii;
        const u32x2 gg = *(const u32x2*)(F.GG + (size_t)m * 512 + h * 128 + e4 * 4);
        const float g0 = bf_lo(gg.x), g1 = bf_hi(gg.x), g2 = bf_lo(gg.y), g3 = bf_hi(gg.y);
        const float o0 = acc[ii][0] * rstd * gn[0] * (g0 * sigmoidf_(g0)), o1 = acc[ii][1] * rstd * gn[1] * (g1 * sigmoidf_(g1));
        const float o2 = acc[ii][2] * rstd * gn[2] * (g2 * sigmoidf_(g2)), o3 = acc[ii][3] * rstd * gn[3] * (g3 * sigmoidf_(g3));
        u32x2 o; o.x = pk2(o0, o1); o.y = pk2(o2, o3);
        *(u32x2*)(F.XN + (size_t)m * D + h * 128 + e4 * 4) = o;
    }
    __syncthreads();
}

__device__ __forceinline__ void natten_item(const Ctx& F, int l, int it) {
    const int b = it >> 9, hh = (it >> 6) & 7, r = it & 63;
    const int rs = min(max(r - 4, 0), 56); const int tok0 = b * T + rs * 64;
    LAS bf16* KT = (LAS bf16*)F.lds; LAS bf16* VT = (LAS bf16*)(F.lds + 65536); LAS float* RPB = (LAS float*)(F.lds + 131072);
#pragma unroll
    for (int k = 0; k < 8; ++k) { const int idx = F.tid + 512 * k; const int kk = idx >> 3, ch = idx & 7;
        *(LAS u32x4*)(KT + kk * 64 + ch * 8) = *(const u32x4*)(F.KN + (size_t)(tok0 + kk) * 512 + hh * 64 + ch * 8);
        *(LAS u32x4*)(VT + kk * 64 + ch * 8) = *(const u32x4*)(F.VN + (size_t)(tok0 + kk) * 512 + hh * 64 + ch * 8); }
    if (F.tid < 465) RPB[F.tid] = F.rpb[(size_t)(l * 8 + hh) * 465 + F.tid];
    __syncthreads();
    const int i = F.tid >> 3, dc = F.tid & 7; const int m = b * T + r * 64 + i; const int cs = min(max(i - 8, 0), 48);
    float qf[8];
    { const u32x4 q8 = *(const u32x4*)(F.QN + (size_t)m * 512 + hh * 64 + dc * 8);
      qf[0] = bf_lo(q8.x); qf[1] = bf_hi(q8.x); qf[2] = bf_lo(q8.y); qf[3] = bf_hi(q8.y); qf[4] = bf_lo(q8.z); qf[5] = bf_hi(q8.z); qf[6] = bf_lo(q8.w); qf[7] = bf_hi(q8.w); }
    float sc[16];
    const bool b4 = (dc & 4) != 0, b2 = (dc & 2) != 0, b1 = (dc & 1) != 0;
#pragma unroll
    for (int g = 0; g < 16; ++g) {
        float p[8];
#pragma unroll
        for (int t = 0; t < 8; ++t) { const int key = (g >> 1) * 64 + cs + (g & 1) * 8 + t; const u32x4 k8 = *(const LAS u32x4*)(KT + key * 64 + dc * 8);
            p[t] = (qf[0] * bf_lo(k8.x) + qf[1] * bf_hi(k8.x)) + (qf[2] * bf_lo(k8.y) + qf[3] * bf_hi(k8.y)) + (qf[4] * bf_lo(k8.z) + qf[5] * bf_hi(k8.z)) + (qf[6] * bf_lo(k8.w) + qf[7] * bf_hi(k8.w)); }
        float p4[4], p2[2];
#pragma unroll
        for (int t = 0; t < 4; ++t) { const float snd = b4 ? p[t] : p[t + 4]; const float rcv = __shfl_xor(snd, 4); p4[t] = (b4 ? p[t + 4] : p[t]) + rcv; }
#pragma unroll
        for (int t = 0; t < 2; ++t) { const float snd = b2 ? p4[t] : p4[t + 2]; const float rcv = __shfl_xor(snd, 2); p2[t] = (b2 ? p4[t + 2] : p4[t]) + rcv; }
        const float snd = b1 ? p2[0] : p2[1]; const float rcv = __shfl_xor(snd, 1); const float s = (b1 ? p2[1] : p2[0]) + rcv;
        const int kr = g >> 1, cc = (g & 1) * 8 + dc;
        sc[g] = s + RPB[(rs + kr - r + 7) * 31 + (cs + cc - i + 15)];
    }
    float mx = sc[0];
#pragma unroll
    for (int g = 1; g < 16; ++g) mx = fmaxf(mx, sc[g]);
    mx = fmaxf(mx, __shfl_xor(mx, 1)); mx = fmaxf(mx, __shfl_xor(mx, 2)); mx = fmaxf(mx, __shfl_xor(mx, 4));
    float sum = 0.f;
#pragma unroll
    for (int g = 0; g < 16; ++g) { sc[g] = expf(sc[g] - mx); sum += sc[g]; }
    sum += __shfl_xor(sum, 1); sum += __shfl_xor(sum, 2); sum += __shfl_xor(sum, 4);
    const float inv = 1.0f / sum;
    float o[8];
#pragma unroll
    for (int q = 0; q < 8; ++q) o[q] = 0.f;
    const int lbase = F.lane & ~7;
#pragma unroll
    for (int g = 0; g < 16; ++g)
#pragma unroll
        for (int t = 0; t < 8; ++t) { const float pk = __shfl(sc[g], lbase + t); const int key = (g >> 1) * 64 + cs + (g & 1) * 8 + t;
            const u32x4 v8 = *(const LAS u32x4*)(VT + key * 64 + dc * 8);
            o[0] += pk * bf_lo(v8.x); o[1] += pk * bf_hi(v8.x); o[2] += pk * bf_lo(v8.y); o[3] += pk * bf_hi(v8.y);
            o[4] += pk * bf_lo(v8.z); o[5] += pk * bf_hi(v8.z); o[6] += pk * bf_lo(v8.w); o[7] += pk * bf_hi(v8.w); }
    u32x4 ov; ov.x = pk2(o[0] * inv, o[1] * inv); ov.y = pk2(o[2] * inv, o[3] * inv); ov.z = pk2(o[4] * inv, o[5] * inv); ov.w = pk2(o[6] * inv, o[7] * inv);
    *(u32x4*)(F.XN + (size_t)m * D + 512 + hh * 64 + dc * 8) = ov;
    __syncthreads();
}


#ifndef GLA_V2
#define GLA_V2 1
#endif
#ifndef NATTEN_V2
#define NATTEN_V2 1
#endif
constexpr int KST = 80, VST = 144;
__device__ __forceinline__ void gla_gate_col(const Ctx& F, int l, int h) {
    LAS float* GWT = (LAS float*)(F.lds + 40960); LAS float* GBT = (LAS float*)(F.lds + 49152);
    __syncthreads();
#pragma unroll
    for (int k = 0; k < 4; ++k) { const int idx = F.tid + 512 * k; const int dir = idx >> 10, r = (idx >> 6) & 15, d = idx & 63;
        GWT[idx] = F.gate_w[(size_t)((l * 2 + dir) * 16 + r) * 256 + h * 64 + d]; }
    if (F.tid < 128) { const int dir = F.tid >> 6, d = F.tid & 63; GBT[F.tid] = F.gate_b[(l * 2 + dir) * 256 + h * 64 + d]; }
    __syncthreads();
}
__device__ __forceinline__ void gla_front2(const Ctx& F, int l, int h, int m0, LAS float* BF, LAS float* BR, LAS float* LFBT, LAS float* SEG) {
    const int dir = F.tid >> 8, sg = (F.tid >> 6) & 3, d = F.tid & 63;
    float gwr[16];
    { const LAS float* GWT = (const LAS float*)(F.lds + 40960);
#pragma unroll
      for (int r = 0; r < 16; ++r) gwr[r] = GWT[(dir * 16 + r) * 64 + d]; }
    const float gbv = ((const LAS float*)(F.lds + 49152))[dir * 64 + d];
    __syncthreads();
    float v[16];
#pragma unroll
    for (int q = 0; q < 16; ++q) {
        const LAS float* lp = LFBT + (sg * 16 + q) * 32 + dir * 16;
        const f32x4 a0 = *(const LAS f32x4*)lp, a1 = *(const LAS f32x4*)(lp + 4), a2 = *(const LAS f32x4*)(lp + 8), a3 = *(const LAS f32x4*)(lp + 12);
        float z = gbv;
        z += a0[0] * gwr[0]; z += a0[1] * gwr[1]; z += a0[2] * gwr[2]; z += a0[3] * gwr[3];
        z += a1[0] * gwr[4]; z += a1[1] * gwr[5]; z += a1[2] * gwr[6]; z += a1[3] * gwr[7];
        z += a2[0] * gwr[8]; z += a2[1] * gwr[9]; z += a2[2] * gwr[10]; z += a2[3] * gwr[11];
        z += a3[0] * gwr[12]; z += a3[1] * gwr[13]; z += a3[2] * gwr[14]; z += a3[3] * gwr[15];
        v[q] = (fminf(z, 0.f) - __logf(1.0f + __expf(-fabsf(z)))) * (1.0f / 16.0f);
    }
    float run = 0.f;
    if (dir == 0) {
#pragma unroll
        for (int q = 0; q < 16; ++q) { run += v[q]; v[q] = run; }
    } else {
#pragma unroll
        for (int q = 15; q >= 0; --q) { run += v[q]; v[q] = run; }
    }
    SEG[(dir * 4 + sg) * 64 + d] = run;
    __syncthreads();
    float pre = 0.f;
    if (dir == 0) { for (int s = 0; s < 4; ++s) if (s < sg) pre += SEG[s * 64 + d]; }
    else { for (int s = 0; s < 4; ++s) if (s > sg) pre += SEG[(4 + s) * 64 + d]; }
    LAS float* A = dir ? BR : BF;
#pragma unroll
    for (int q = 0; q < 16; ++q) A[(sg * 16 + q) * 64 + d] = v[q] + pre;
    __syncthreads();
}
struct GlaPre { u32x4 v0, v1, s0, s1, s2, s3; f32x4 lf, g1, g2, g3; unsigned bfp[4], brp[4]; };
__device__ __forceinline__ void gla_a2_load(const Ctx& F, int it, GlaPre& P) {
    const int b = it >> 8, h = (it >> 6) & 3, c = it & 63, m0 = b * T + c * 64;
    { const int tok = F.tid >> 4, ch = F.tid & 15; P.v0 = *(const u32x4*)(F.VG + (size_t)(m0 + tok) * 512 + h * 128 + ch * 8); P.v1 = *(const u32x4*)(F.VG + (size_t)(m0 + 32 + tok) * 512 + h * 128 + ch * 8); }
    { const int tok = F.tid >> 3, c4 = F.tid & 7; P.lf = *(const f32x4*)(F.lfb + (size_t)(m0 + tok) * 32 + c4 * 4); }
#pragma unroll
    for (int k = 0; k < 4; ++k) { P.bfp[k] = 0u; P.brp[k] = 0u; }
    P.s0 = P.s1 = P.s2 = P.s3 = (u32x4){0u, 0u, 0u, 0u}; P.g1 = P.g2 = P.g3 = (f32x4){0.f, 0.f, 0.f, 0.f};
}
__device__ __forceinline__ void gla_a2_item(const Ctx& F, int l, int it, GlaPre& P, int itn) {
    const int b = it >> 8, h = (it >> 6) & 3, c = it & 63, bh = b * 4 + h, m0 = b * T + c * 64;
    LAS float* BF = (LAS float*)F.lds; LAS float* BR = (LAS float*)(F.lds + 16384);
    LAS float* LFBT = (LAS float*)(F.lds + 32768); LAS float* GWT = (LAS float*)(F.lds + 40960); LAS float* GBT = (LAS float*)(F.lds + 49152);
    LAS bf16* KHF = (LAS bf16*)(F.lds + 49664); LAS bf16* KHB = (LAS bf16*)(F.lds + 59904); LAS bf16* VT = (LAS bf16*)(F.lds + 70144);
    LAS float* SEG = (LAS float*)(F.lds + 88576);
    { const int tok = F.tid >> 4, ch = F.tid & 15; *(LAS u32x4*)(VT + tok * VST + ch * 8) = P.v0; *(LAS u32x4*)(VT + (tok + 32) * VST + ch * 8) = P.v1; }
    { const int tok = F.tid >> 3, c4 = F.tid & 7; *(LAS f32x4*)(LFBT + tok * 32 + c4 * 4) = P.lf; }
    unsigned kraw[4];
#pragma unroll
    for (int k = 0; k < 4; ++k) { const int idx = F.tid + 512 * k; const int j = idx >> 5, d = (idx & 31) * 2; kraw[k] = *(const unsigned*)(F.KG + (size_t)(m0 + j) * 256 + h * 64 + d); }
    gla_a2_load(F, min(itn, 1023), P);
    gla_front2(F, l, h, m0, BF, BR, LFBT, SEG);
#pragma unroll
    for (int k = 0; k < 4; ++k) { const int idx = F.tid + 512 * k; const int j = idx >> 5, d = (idx & 31) * 2;
        const unsigned kk = kraw[k]; const float k0 = bf_lo(kk), k1 = bf_hi(kk);
        *(LAS unsigned*)(KHF + j * KST + d) = cvtpk(k0 * __expf(BF[63 * 64 + d] - BF[j * 64 + d]), k1 * __expf(BF[63 * 64 + d + 1] - BF[j * 64 + d + 1]));
        *(LAS unsigned*)(KHB + j * KST + d) = cvtpk(k0 * __expf(BR[d] - BR[j * 64 + d]), k1 * __expf(BR[d + 1] - BR[j * 64 + d + 1])); }
    if (F.tid < 128) { const int dir = F.tid >> 6, d = F.tid & 63; F.gdec[(size_t)((bh * 2 + dir) * 64 + c) * 64 + d] = __expf(dir ? BR[d] : BF[63 * 64 + d]); }
    {   unsigned* ob = (unsigned*)F.bfbr + (size_t)it * 4096;
#pragma unroll
        for (int k = 0; k < 2; ++k) { const int idx = F.tid + 512 * k; const f32x4 a = *(const LAS f32x4*)(BF + idx * 8), b = *(const LAS f32x4*)(BF + idx * 8 + 4);
            u32x4 o; o.x = pkh2(a[0], a[1]); o.y = pkh2(a[2], a[3]); o.z = pkh2(b[0], b[1]); o.w = pkh2(b[2], b[3]); __builtin_nontemporal_store(o, (u32x4*)(ob + idx * 4)); } }
    __syncthreads();
    {
        const int dir = F.wave >> 2, etq = F.wave & 3, i16 = F.lane & 15, g = F.lane >> 4;
        const LAS bf16* KH = dir ? KHB : KHF;
        f32x4 acc[4][2];
#pragma unroll
        for (int dt = 0; dt < 4; ++dt) { acc[dt][0] = (f32x4){0.f, 0.f, 0.f, 0.f}; acc[dt][1] = (f32x4){0.f, 0.f, 0.f, 0.f}; }
#pragma unroll
        for (int ks = 0; ks < 2; ++ks) {
            const int row0 = 32 * ks + 8 * g + (i16 >> 2), cc = 4 * (i16 & 3);
            bf16x8 vb[2];
#pragma unroll
            for (int e2 = 0; e2 < 2; ++e2) { const int et = etq * 2 + e2; vb[e2] = cat8(tr16(VT + row0 * VST + 16 * et + cc), tr16(VT + (row0 + 4) * VST + 16 * et + cc)); }
#pragma unroll
            for (int dt = 0; dt < 4; ++dt) { const bf16x8 ka = cat8(tr16(KH + row0 * KST + 16 * dt + cc), tr16(KH + (row0 + 4) * KST + 16 * dt + cc));
                acc[dt][0] = mfma16(ka, vb[0], acc[dt][0]); acc[dt][1] = mfma16(ka, vb[1], acc[dt][1]); }
        }
        bf16* Ub = F.UB + (size_t)((bh * 2 + dir) * 64 + c) * 8192;
#pragma unroll
        for (int dt = 0; dt < 4; ++dt)
#pragma unroll
            for (int e2 = 0; e2 < 2; ++e2) { u32x2 o; o.x = cvtpk(acc[dt][e2][0], acc[dt][e2][1]); o.y = cvtpk(acc[dt][e2][2], acc[dt][e2][3]);
                *(u32x2*)(Ub + (size_t)(16 * (etq * 2 + e2) + i16) * 64 + 16 * dt + 4 * g) = o; }
    }
    __syncthreads();
}
__device__ __forceinline__ void gla_b2(const Ctx& F) {
    const bf16* __restrict__ U = F.UB; bf16* __restrict__ SP = F.SP; const float* __restrict__ GD = F.gdec;
    for (int id = F.vcu * 512 + F.tid; id < 32 * 4096; id += F.G * 512) {
        const int s = id >> 12, q2 = id & 4095, d2 = (q2 & 31) * 2, dir = s & 1;
        const bf16* base = U + (size_t)s * 64 * 8192 + 2 * q2; bf16* ob = SP + (size_t)s * 64 * 8192 + 2 * q2; const float* gd = GD + (size_t)s * 64 * 64 + d2;
        float S0 = 0.f, S1 = 0.f;
#pragma unroll 16
        for (int step = 0; step < 64; ++step) { const int c = dir ? 63 - step : step;
            const unsigned uu = __builtin_nontemporal_load((const unsigned*)(base + (size_t)c * 8192)); const f32x2 g = *(const f32x2*)(gd + c * 64);
            *(unsigned*)(ob + (size_t)c * 8192) = cvtpk(S0, S1);
            S0 = S0 * g[0] + bf_lo(uu); S1 = S1 * g[1] + bf_hi(uu); }
    }
}
__device__ __forceinline__ void gla_c2_load(const Ctx& F, int it, GlaPre& P) {
    const int b = it >> 8, h = (it >> 6) & 3, c = it & 63, bh = b * 4 + h, m0 = b * T + c * 64;
    { const int tok = F.tid >> 4, ch = F.tid & 15; P.v0 = *(const u32x4*)(F.VG + (size_t)(m0 + tok) * 512 + h * 128 + ch * 8); P.v1 = *(const u32x4*)(F.VG + (size_t)(m0 + 32 + tok) * 512 + h * 128 + ch * 8); }
    { const int e = F.tid >> 3, ch = F.tid & 7; const bf16* sf = F.SP + (size_t)((bh * 2 + 0) * 64 + c) * 8192 + ch * 8; const bf16* sb = F.SP + (size_t)((bh * 2 + 1) * 64 + c) * 8192 + ch * 8;
      P.s0 = __builtin_nontemporal_load((const u32x4*)(sf + e * 64)); P.s1 = __builtin_nontemporal_load((const u32x4*)(sf + (e + 64) * 64)); P.s2 = __builtin_nontemporal_load((const u32x4*)(sb + e * 64)); P.s3 = __builtin_nontemporal_load((const u32x4*)(sb + (e + 64) * 64)); }
    P.lf = (f32x4){0.f, 0.f, 0.f, 0.f}; P.g1 = P.g2 = P.g3 = (f32x4){0.f, 0.f, 0.f, 0.f};
#pragma unroll
    for (int k = 0; k < 4; ++k) { const int idx = F.tid + 512 * k; const unsigned* p = (const unsigned*)F.bfbr + (size_t)it * 4096 + idx; P.bfp[k] = __builtin_nontemporal_load(p); P.brp[k] = __builtin_nontemporal_load(p + 2048); }
}
__device__ __forceinline__ void gla_c2_item(const Ctx& F, int l, int it, GlaPre& P, int itn) {
    const int b = it >> 8, h = (it >> 6) & 3, c = it & 63, bh = b * 4 + h, m0 = b * T + c * 64;
    LAS float* BF = (LAS float*)F.lds; LAS float* BR = (LAS float*)(F.lds + 16384);
    LAS float* LFBT = (LAS float*)(F.lds + 32768); LAS float* GWT = (LAS float*)(F.lds + 40960); LAS float* GBT = (LAS float*)(F.lds + 49152);
    LAS bf16* QF = (LAS bf16*)(F.lds + 49664); LAS bf16* QB = (LAS bf16*)(F.lds + 59904); LAS bf16* KF = (LAS bf16*)(F.lds + 70144); LAS bf16* KB = (LAS bf16*)(F.lds + 80384);
    LAS bf16* VT = (LAS bf16*)(F.lds + 90624);
    LAS bf16* SFT = (LAS bf16*)(F.lds + 109056); LAS bf16* SBT = (LAS bf16*)(F.lds + 129536);
    LAS float* SEG = (LAS float*)(F.lds + 150016); LAS float* SSX = SEG + 512;
    { const int tok = F.tid >> 4, ch = F.tid & 15; *(LAS u32x4*)(VT + tok * VST + ch * 8) = P.v0; *(LAS u32x4*)(VT + (tok + 32) * VST + ch * 8) = P.v1; }
    { const int e = F.tid >> 3, ch = F.tid & 7; *(LAS u32x4*)(SFT + e * KST + ch * 8) = P.s0; *(LAS u32x4*)(SFT + (e + 64) * KST + ch * 8) = P.s1;
      *(LAS u32x4*)(SBT + e * KST + ch * 8) = P.s2; *(LAS u32x4*)(SBT + (e + 64) * KST + ch * 8) = P.s3; }
    unsigned qraw[4], kraw[4]; f32x2 bfv[4], brv[4];
#pragma unroll
    for (int k = 0; k < 4; ++k) { const int idx = F.tid + 512 * k; const int i = idx >> 5, d = (idx & 31) * 2; bfv[k] = unh2(P.bfp[k]); brv[k] = unh2(P.brp[k]);
        qraw[k] = *(const unsigned*)(F.QG + (size_t)(m0 + i) * 256 + h * 64 + d); kraw[k] = *(const unsigned*)(F.KG + (size_t)(m0 + i) * 256 + h * 64 + d); }
    gla_c2_load(F, min(itn, 1023), P);
#pragma unroll
    for (int k = 0; k < 4; ++k) { const int idx = F.tid + 512 * k; const int i = idx >> 5, d = (idx & 31) * 2;
        const unsigned qq = qraw[k], kk = kraw[k];
        const float q0 = bf_lo(qq), q1 = bf_hi(qq), k0 = bf_lo(kk), k1 = bf_hi(kk);
        const float f0 = bfv[k][0], f1 = bfv[k][1], r0 = brv[k][0], r1 = brv[k][1];
        *(LAS unsigned*)(QF + i * KST + d) = cvtpk(q0 * __expf(f0), q1 * __expf(f1)); *(LAS unsigned*)(KF + i * KST + d) = cvtpk(k0 * __expf(-f0), k1 * __expf(-f1));
        *(LAS unsigned*)(QB + i * KST + d) = cvtpk(q0 * __expf(r0), q1 * __expf(r1)); *(LAS unsigned*)(KB + i * KST + d) = cvtpk(k0 * __expf(-r0), k1 * __expf(-r1)); }
    __syncthreads();
    const int itile = F.wave & 3, eh = F.wave >> 2, i16 = F.lane & 15, g = F.lane >> 4;
    bf16x8 qf[2], qb[2];
#pragma unroll
    for (int ks = 0; ks < 2; ++ks) { qf[ks] = *(const LAS bf16x8*)(QF + (16 * itile + i16) * KST + 32 * ks + 8 * g); qb[ks] = *(const LAS bf16x8*)(QB + (16 * itile + i16) * KST + 32 * ks + 8 * g); }
    f32x4 pt[4];
#pragma unroll
    for (int jt = 0; jt < 4; ++jt) {
        f32x4 pf = (f32x4){0.f, 0.f, 0.f, 0.f}, pb = (f32x4){0.f, 0.f, 0.f, 0.f};
#pragma unroll
        for (int ks = 0; ks < 2; ++ks) {
            const bf16x8 kf = *(const LAS bf16x8*)(KF + (16 * jt + i16) * KST + 32 * ks + 8 * g), kb = *(const LAS bf16x8*)(KB + (16 * jt + i16) * KST + 32 * ks + 8 * g);
            pf = mfma16(kf, qf[ks], pf); pb = mfma16(kb, qb[ks], pb); }
        const int iq = 16 * itile + i16;
#pragma unroll
        for (int r = 0; r < 4; ++r) pt[jt][r] = (16 * jt + 4 * g + r <= iq) ? pf[r] : pb[r];
    }
    const bf16x8 pp0 = pack8(pt[0], pt[1]), pp1 = pack8(pt[2], pt[3]);
    f32x4 acc[4];
#pragma unroll
    for (int e4 = 0; e4 < 4; ++e4) {
        const int et = eh * 4 + e4; f32x4 a = (f32x4){0.f, 0.f, 0.f, 0.f};
        const int rr = 4 * g + (i16 >> 2), cc = 16 * et + 4 * (i16 & 3);
        a = mfma16(cat8(tr16(VT + rr * VST + cc), tr16(VT + (rr + 16) * VST + cc)), pp0, a);
        a = mfma16(cat8(tr16(VT + (rr + 32) * VST + cc), tr16(VT + (rr + 48) * VST + cc)), pp1, a);
#pragma unroll
        for (int ks = 0; ks < 2; ++ks) {
            a = mfma16(*(const LAS bf16x8*)(SFT + (16 * et + i16) * KST + 32 * ks + 8 * g), qf[ks], a);
            a = mfma16(*(const LAS bf16x8*)(SBT + (16 * et + i16) * KST + 32 * ks + 8 * g), qb[ks], a); }
        acc[e4] = a;
    }
    float ss = 0.f;
#pragma unroll
    for (int e4 = 0; e4 < 4; ++e4) ss += (acc[e4][0] * acc[e4][0] + acc[e4][1] * acc[e4][1]) + (acc[e4][2] * acc[e4][2] + acc[e4][3] * acc[e4][3]);
    ss += __shfl_xor(ss, 16); ss += __shfl_xor(ss, 32);
    if (g == 0) SSX[eh * 64 + 16 * itile + i16] = ss;
    __syncthreads();
    const float rstd = 1.0f / sqrtf((SSX[16 * itile + i16] + SSX[64 + 16 * itile + i16]) * (1.0f / 128.0f) + EPS);
    const int m = m0 + 16 * itile + i16;
#pragma unroll
    for (int e4 = 0; e4 < 4; ++e4) {
        const int e0 = 16 * (eh * 4 + e4) + 4 * g;
        const f32x4 gn = *(const f32x4*)(F.gla_norm + l * 128 + e0);
        const u32x2 gg = *(const u32x2*)(F.GG + (size_t)m * 512 + h * 128 + e0);
        const float g0 = bf_lo(gg.x), g1 = bf_hi(gg.x), g2 = bf_lo(gg.y), g3 = bf_hi(gg.y);
        u32x2 o; o.x = cvtpk(acc[e4][0] * rstd * gn[0] * (g0 * sigmoidf_(g0)), acc[e4][1] * rstd * gn[1] * (g1 * sigmoidf_(g1)));
        o.y = cvtpk(acc[e4][2] * rstd * gn[2] * (g2 * sigmoidf_(g2)), acc[e4][3] * rstd * gn[3] * (g3 * sigmoidf_(g3)));
        *(u32x2*)(F.XN + (size_t)m * D + h * 128 + e0) = o;
    }
    __syncthreads();
}


#ifndef GLA_V3
#define GLA_V3 1
#endif
struct GlaPre3 { u32x4 vf0, vf1, vb0, vb1; f32x4 lf; };
__device__ __forceinline__ void gla_a3_load(const Ctx& F, int p, int j, int k, GlaPre3& P) {
    const int b = p >> 2, h = p & 3, mf = b * T + (4 * j + k) * 64, mb = b * T + (4 * j + 3 - k) * 64;
    { const int tok = F.tid >> 4, ch = F.tid & 15;
      P.vf0 = *(const u32x4*)(F.VG + (size_t)(mf + tok) * 512 + h * 128 + ch * 8); P.vf1 = *(const u32x4*)(F.VG + (size_t)(mf + 32 + tok) * 512 + h * 128 + ch * 8);
      P.vb0 = *(const u32x4*)(F.VG + (size_t)(mb + tok) * 512 + h * 128 + ch * 8); P.vb1 = *(const u32x4*)(F.VG + (size_t)(mb + 32 + tok) * 512 + h * 128 + ch * 8); }
    { const int tok = F.tid >> 3, c4 = F.tid & 7; P.lf = *(const f32x4*)(F.lfb + (size_t)((c4 < 4 ? mf : mb) + tok) * 32 + c4 * 4); }
}
__device__ __forceinline__ void gla_a3_group(const Ctx& F, int l, int gidx) {
    const int p = gidx >> 4, j = gidx & 15, b = p >> 2, h = p & 3;
    LAS float* BF = (LAS float*)F.lds; LAS float* BR = (LAS float*)(F.lds + 16384);
    LAS float* LFBT = (LAS float*)(F.lds + 32768);
    LAS bf16* KHF = (LAS bf16*)(F.lds + 49664); LAS bf16* KHB = (LAS bf16*)(F.lds + 59904);
    LAS bf16* VTF = (LAS bf16*)(F.lds + 70144); LAS bf16* VTB = (LAS bf16*)(F.lds + 88576);
    LAS float* SEG = (LAS float*)(F.lds + 107008);
    const int dir = F.wave >> 2, etq = F.wave & 3, i16 = F.lane & 15, g = F.lane >> 4;
    bf16* TB = F.SP; float* GT = (float*)(F.SP + (size_t)8 * 1024 * 1024);
    f32x4 R[4][2];
#pragma unroll
    for (int dt = 0; dt < 4; ++dt) { R[dt][0] = (f32x4){0.f, 0.f, 0.f, 0.f}; R[dt][1] = (f32x4){0.f, 0.f, 0.f, 0.f}; }
    float glog = 0.f;
    GlaPre3 P; gla_a3_load(F, p, j, 0, P);
    for (int k = 0; k < 4; ++k) {
        const int cf = 4 * j + k, cb = 4 * j + 3 - k, mf = b * T + cf * 64, mb = b * T + cb * 64, itf = p * 64 + cf, itb = p * 64 + cb;
        { const int tok = F.tid >> 4, ch = F.tid & 15;
          *(LAS u32x4*)(VTF + tok * VST + ch * 8) = P.vf0; *(LAS u32x4*)(VTF + (tok + 32) * VST + ch * 8) = P.vf1;
          *(LAS u32x4*)(VTB + tok * VST + ch * 8) = P.vb0; *(LAS u32x4*)(VTB + (tok + 32) * VST + ch * 8) = P.vb1; }
        { const int tok = F.tid >> 3, c4 = F.tid & 7; *(LAS f32x4*)(LFBT + tok * 32 + c4 * 4) = P.lf; }
        unsigned kfr[4], kbr[4];
#pragma unroll
        for (int q = 0; q < 4; ++q) { const int idx = F.tid + 512 * q; const int jr = idx >> 5, d = (idx & 31) * 2;
            kfr[q] = *(const unsigned*)(F.KG + (size_t)(mf + jr) * 256 + h * 64 + d); kbr[q] = *(const unsigned*)(F.KG + (size_t)(mb + jr) * 256 + h * 64 + d); }
        gla_a3_load(F, p, j, min(k + 1, 3), P);
        gla_front2(F, l, h, 0, BF, BR, LFBT, SEG);
#pragma unroll
        for (int q = 0; q < 4; ++q) { const int idx = F.tid + 512 * q; const int jr = idx >> 5, d = (idx & 31) * 2;
            const float f0 = bf_lo(kfr[q]), f1 = bf_hi(kfr[q]), r0 = bf_lo(kbr[q]), r1 = bf_hi(kbr[q]);
            *(LAS unsigned*)(KHF + jr * KST + d) = cvtpk(f0 * __expf(BF[63 * 64 + d] - BF[jr * 64 + d]), f1 * __expf(BF[63 * 64 + d + 1] - BF[jr * 64 + d + 1]));
            *(LAS unsigned*)(KHB + jr * KST + d) = cvtpk(r0 * __expf(BR[d] - BR[jr * 64 + d]), r1 * __expf(BR[d + 1] - BR[jr * 64 + d + 1])); }
        if (F.tid < 128) { const int dr = F.tid >> 6, d = F.tid & 63;
            F.gdec[(size_t)(dr ? itb : itf) * 128 + dr * 64 + d] = __expf(glog); glog += dr ? BR[d] : BF[63 * 64 + d]; }
#pragma unroll
        for (int q = 0; q < 2; ++q) { const int idx = F.tid + 512 * q; const f32x4 a = *(const LAS f32x4*)(BF + idx * 8), c = *(const LAS f32x4*)(BF + idx * 8 + 4);
            unsigned* ob = (unsigned*)F.bfbr + (size_t)(idx < 512 ? itf : itb) * 4096;
            u32x4 o; o.x = pkh2(a[0], a[1]); o.y = pkh2(a[2], a[3]); o.z = pkh2(c[0], c[1]); o.w = pkh2(c[2], c[3]); __builtin_nontemporal_store(o, (u32x4*)(ob + idx * 4)); }
        __syncthreads();
        {
            const LAS bf16* KH = dir ? KHB : KHF; const LAS bf16* VT = dir ? VTB : VTF;
            f32x4 acc[4][2];
#pragma unroll
            for (int dt = 0; dt < 4; ++dt) { acc[dt][0] = (f32x4){0.f, 0.f, 0.f, 0.f}; acc[dt][1] = (f32x4){0.f, 0.f, 0.f, 0.f}; }
#pragma unroll
            for (int ks = 0; ks < 2; ++ks) {
                const int row0 = 32 * ks + 8 * g + (i16 >> 2), cc = 4 * (i16 & 3);
                bf16x8 vb[2];
#pragma unroll
                for (int e2 = 0; e2 < 2; ++e2) { const int et = etq * 2 + e2; vb[e2] = cat8(tr16(VT + row0 * VST + 16 * et + cc), tr16(VT + (row0 + 4) * VST + 16 * et + cc)); }
#pragma unroll
                for (int dt = 0; dt < 4; ++dt) { const bf16x8 ka = cat8(tr16(KH + row0 * KST + 16 * dt + cc), tr16(KH + (row0 + 4) * KST + 16 * dt + cc));
                    acc[dt][0] = mfma16(ka, vb[0], acc[dt][0]); acc[dt][1] = mfma16(ka, vb[1], acc[dt][1]); }
            }
            bf16* Lb = F.UB + (size_t)((p * 2 + dir) * 64 + (dir ? cb : cf)) * 8192;
#pragma unroll
            for (int dt = 0; dt < 4; ++dt) {
                const f32x4 lg = *(const LAS f32x4*)((dir ? BR : BF + 63 * 64) + 16 * dt + 4 * g);
                const f32x4 gq = (f32x4){__expf(lg[0]), __expf(lg[1]), __expf(lg[2]), __expf(lg[3])};
#pragma unroll
                for (int e2 = 0; e2 < 2; ++e2) { u32x2 o; o.x = cvtpk(R[dt][e2][0], R[dt][e2][1]); o.y = cvtpk(R[dt][e2][2], R[dt][e2][3]);
                    *(u32x2*)(Lb + (size_t)(16 * (etq * 2 + e2) + i16) * 64 + 16 * dt + 4 * g) = o;
                    R[dt][e2] = R[dt][e2] * gq + acc[dt][e2]; } }
        }
        __syncthreads();
    }
    {   bf16* Tb = TB + (size_t)((p * 2 + dir) * 16 + j) * 8192;
#pragma unroll
        for (int dt = 0; dt < 4; ++dt)
#pragma unroll
            for (int e2 = 0; e2 < 2; ++e2) { u32x2 o; o.x = cvtpk(R[dt][e2][0], R[dt][e2][1]); o.y = cvtpk(R[dt][e2][2], R[dt][e2][3]);
                __hip_atomic_store((unsigned long long*)(Tb + (size_t)(16 * (etq * 2 + e2) + i16) * 64 + 16 * dt + 4 * g), (unsigned long long)o.x | ((unsigned long long)o.y << 32), RLX_AGENT); }
        if (F.tid < 128) { const int dr = F.tid >> 6, d = F.tid & 63; __hip_atomic_store((unsigned*)GT + (size_t)((p * 2 + dr) * 16 + j) * 64 + d, __float_as_uint(__expf(glog)), RLX_AGENT); }
    }
}
__device__ __forceinline__ void gla_b3(const Ctx& F) {
    const bf16* __restrict__ TB = F.SP; bf16* __restrict__ S0B = F.SP + (size_t)4 * 1024 * 1024; const float* __restrict__ GT = (const float*)(F.SP + (size_t)8 * 1024 * 1024);
    if (F.tid < 256)
    for (int id = F.vcu * 256 + F.tid; id < 32 * 2048; id += F.G * 256) {
        const int s = id >> 11, q4 = id & 2047, d4 = (q4 & 15) * 4, dir = s & 1;
        const bf16* base = TB + (size_t)s * 16 * 8192 + 4 * q4; bf16* ob = S0B + (size_t)s * 16 * 8192 + 4 * q4; const float* gd = GT + (size_t)s * 16 * 64 + d4;
        float S0 = 0.f, S1 = 0.f, S2 = 0.f, S3 = 0.f;
#pragma unroll
        for (int step = 0; step < 16; ++step) { const int jj = dir ? 15 - step : step;
            const u32x2 uu = *(const u32x2*)(base + (size_t)jj * 8192); const f32x4 gq = *(const f32x4*)(gd + jj * 64);
            __hip_atomic_store((unsigned long long*)(ob + (size_t)jj * 8192), (unsigned long long)cvtpk(S0, S1) | ((unsigned long long)cvtpk(S2, S3) << 32), RLX_AGENT);
            S0 = S0 * gq[0] + bf_lo(uu.x); S1 = S1 * gq[1] + bf_hi(uu.x); S2 = S2 * gq[2] + bf_lo(uu.y); S3 = S3 * gq[3] + bf_hi(uu.y); }
    }
}
__device__ __forceinline__ void pair16(const u32x2 (&o)[4], bool odd, u32x4& a, u32x4& b) {
    const u32x2 s0 = odd ? o[0] : o[1], s1 = odd ? o[2] : o[3], k0 = odd ? o[1] : o[0], k1 = odd ? o[3] : o[2];
    u32x2 r0, r1; r0.x = __shfl_xor(s0.x, 16); r0.y = __shfl_xor(s0.y, 16); r1.x = __shfl_xor(s1.x, 16); r1.y = __shfl_xor(s1.y, 16);
    a = odd ? (u32x4){r0.x, r0.y, k0.x, k0.y} : (u32x4){k0.x, k0.y, r0.x, r0.y};
    b = odd ? (u32x4){r1.x, r1.y, k1.x, k1.y} : (u32x4){k1.x, k1.y, r1.x, r1.y};
}
struct S0R { u32x4 a, b, c, d; };
__device__ __forceinline__ u32x4 s0_comb(u32x4 L, u32x4 Z, f32x4 g0, f32x4 g1) {
    u32x4 o;
    o.x = cvtpk(bf_lo(L.x) + g0[0] * bf_lo(Z.x), bf_hi(L.x) + g0[1] * bf_hi(Z.x)); o.y = cvtpk(bf_lo(L.y) + g0[2] * bf_lo(Z.y), bf_hi(L.y) + g0[3] * bf_hi(Z.y));
    o.z = cvtpk(bf_lo(L.z) + g1[0] * bf_lo(Z.z), bf_hi(L.z) + g1[1] * bf_hi(Z.z)); o.w = cvtpk(bf_lo(L.w) + g1[2] * bf_lo(Z.w), bf_hi(L.w) + g1[3] * bf_hi(Z.w));
    return o;
}
__device__ __forceinline__ void gla_c3_load(const Ctx& F, int it, GlaPre& P) {
    const int b = it >> 8, h = (it >> 6) & 3, c = it & 63, bh = b * 4 + h, m0 = b * T + c * 64;
    { const int tok = F.tid >> 4, ch = F.tid & 15; P.v0 = *(const u32x4*)(F.VG + (size_t)(m0 + tok) * 512 + h * 128 + ch * 8); P.v1 = *(const u32x4*)(F.VG + (size_t)(m0 + 32 + tok) * 512 + h * 128 + ch * 8); }
    { const int e = F.tid >> 3, ch = F.tid & 7; const bf16* sf = F.UB + (size_t)((bh * 2 + 0) * 64 + c) * 8192 + ch * 8; const bf16* sb = F.UB + (size_t)((bh * 2 + 1) * 64 + c) * 8192 + ch * 8;
      P.s0 = __builtin_nontemporal_load((const u32x4*)(sf + e * 64)); P.s1 = __builtin_nontemporal_load((const u32x4*)(sf + (e + 64) * 64)); P.s2 = __builtin_nontemporal_load((const u32x4*)(sb + e * 64)); P.s3 = __builtin_nontemporal_load((const u32x4*)(sb + (e + 64) * 64)); }
    { const int ch = F.tid & 7; const float* gp = F.gdec + (size_t)it * 128 + ch * 8; P.lf = *(const f32x4*)gp; P.g1 = *(const f32x4*)(gp + 4); P.g2 = *(const f32x4*)(gp + 64); P.g3 = *(const f32x4*)(gp + 68); }
#pragma unroll
    for (int k = 0; k < 4; ++k) { const int idx = F.tid + 512 * k; const unsigned* p = (const unsigned*)F.bfbr + (size_t)it * 4096 + idx; P.bfp[k] = __builtin_nontemporal_load(p); P.brp[k] = __builtin_nontemporal_load(p + 2048); }
}
__device__ __forceinline__ void gla_c3_item(const Ctx& F, int l, int it, GlaPre& P, int itn, const S0R& Z) {
    const int b = it >> 8, h = (it >> 6) & 3, c = it & 63, bh = b * 4 + h, m0 = b * T + c * 64;
    LAS float* BF = (LAS float*)F.lds; LAS float* BR = (LAS float*)(F.lds + 16384);
    LAS float* LFBT = (LAS float*)(F.lds + 32768); LAS float* GWT = (LAS float*)(F.lds + 40960); LAS float* GBT = (LAS float*)(F.lds + 49152);
    LAS bf16* QF = (LAS bf16*)(F.lds + 49664); LAS bf16* QB = (LAS bf16*)(F.lds + 59904); LAS bf16* KF = (LAS bf16*)(F.lds + 70144); LAS bf16* KB = (LAS bf16*)(F.lds + 80384);
    LAS bf16* VT = (LAS bf16*)(F.lds + 90624);
    LAS bf16* SFT = (LAS bf16*)(F.lds + 109056); LAS bf16* SBT = (LAS bf16*)(F.lds + 129536);
    LAS float* SEG = (LAS float*)(F.lds + 150016); LAS float* SSX = SEG + 512;
    { const int tok = F.tid >> 4, ch = F.tid & 15; *(LAS u32x4*)(VT + tok * VST + ch * 8) = P.v0; *(LAS u32x4*)(VT + (tok + 32) * VST + ch * 8) = P.v1; }
    { const int e = F.tid >> 3, ch = F.tid & 7;
      *(LAS u32x4*)(SFT + e * KST + ch * 8) = s0_comb(P.s0, Z.a, P.lf, P.g1); *(LAS u32x4*)(SFT + (e + 64) * KST + ch * 8) = s0_comb(P.s1, Z.b, P.lf, P.g1);
      *(LAS u32x4*)(SBT + e * KST + ch * 8) = s0_comb(P.s2, Z.c, P.g2, P.g3); *(LAS u32x4*)(SBT + (e + 64) * KST + ch * 8) = s0_comb(P.s3, Z.d, P.g2, P.g3); }
    unsigned qraw[4], kraw[4]; f32x2 bfv[4], brv[4];
    u32x2 ggp[4]; f32x4 gnp[4];
    { const int e00 = 16 * ((F.wave >> 2) * 4) + 4 * (F.lane >> 4); const size_t mo = (size_t)(m0 + 16 * (F.wave & 3) + (F.lane & 15)) * 512 + h * 128 + e00;
#pragma unroll
      for (int e4 = 0; e4 < 4; ++e4) { ggp[e4] = *(const u32x2*)(F.GG + mo + 16 * e4); gnp[e4] = *(const f32x4*)(F.gla_norm + l * 128 + e00 + 16 * e4); } }
#pragma unroll
    for (int k = 0; k < 4; ++k) { const int idx = F.tid + 512 * k; const int i = idx >> 5, d = (idx & 31) * 2; bfv[k] = unh2(P.bfp[k]); brv[k] = unh2(P.brp[k]);
        qraw[k] = *(const unsigned*)(F.QG + (size_t)(m0 + i) * 256 + h * 64 + d); kraw[k] = *(const unsigned*)(F.KG + (size_t)(m0 + i) * 256 + h * 64 + d); }
    gla_c3_load(F, min(itn, 1023), P);
#pragma unroll
    for (int k = 0; k < 4; ++k) { const int idx = F.tid + 512 * k; const int i = idx >> 5, d = (idx & 31) * 2;
        const unsigned qq = qraw[k], kk = kraw[k];
        const float q0 = bf_lo(qq), q1 = bf_hi(qq), k0 = bf_lo(kk), k1 = bf_hi(kk);
        const float f0 = bfv[k][0], f1 = bfv[k][1], r0 = brv[k][0], r1 = brv[k][1];
        *(LAS unsigned*)(QF + i * KST + d) = cvtpk(q0 * __expf(f0), q1 * __expf(f1)); *(LAS unsigned*)(KF + i * KST + d) = cvtpk(k0 * __expf(-f0), k1 * __expf(-f1));
        *(LAS unsigned*)(QB + i * KST + d) = cvtpk(q0 * __expf(r0), q1 * __expf(r1)); *(LAS unsigned*)(KB + i * KST + d) = cvtpk(k0 * __expf(-r0), k1 * __expf(-r1)); }
    __syncthreads();
    const int itile = F.wave & 3, eh = F.wave >> 2, i16 = F.lane & 15, g = F.lane >> 4;
    bf16x8 qf[2], qb[2];
#pragma unroll
    for (int ks = 0; ks < 2; ++ks) { qf[ks] = *(const LAS bf16x8*)(QF + (16 * itile + i16) * KST + 32 * ks + 8 * g); qb[ks] = *(const LAS bf16x8*)(QB + (16 * itile + i16) * KST + 32 * ks + 8 * g); }
    f32x4 pt[4];
#pragma unroll
    for (int jt = 0; jt < 4; ++jt) {
        f32x4 pf = (f32x4){0.f, 0.f, 0.f, 0.f}, pb = (f32x4){0.f, 0.f, 0.f, 0.f};
#pragma unroll
        for (int ks = 0; ks < 2; ++ks) {
            const bf16x8 kf = *(const LAS bf16x8*)(KF + (16 * jt + i16) * KST + 32 * ks + 8 * g), kb = *(const LAS bf16x8*)(KB + (16 * jt + i16) * KST + 32 * ks + 8 * g);
            pf = mfma16(kf, qf[ks], pf); pb = mfma16(kb, qb[ks], pb); }
        const int iq = 16 * itile + i16;
#pragma unroll
        for (int r = 0; r < 4; ++r) pt[jt][r] = (16 * jt + 4 * g + r <= iq) ? pf[r] : pb[r];
    }
    const bf16x8 pp0 = pack8(pt[0], pt[1]), pp1 = pack8(pt[2], pt[3]);
    f32x4 acc[4];
#pragma unroll
    for (int e4 = 0; e4 < 4; ++e4) {
        const int et = eh * 4 + e4; f32x4 a = (f32x4){0.f, 0.f, 0.f, 0.f};
        const int rr = 4 * g + (i16 >> 2), cc = 16 * et + 4 * (i16 & 3);
        a = mfma16(cat8(tr16(VT + rr * VST + cc), tr16(VT + (rr + 16) * VST + cc)), pp0, a);
        a = mfma16(cat8(tr16(VT + (rr + 32) * VST + cc), tr16(VT + (rr + 48) * VST + cc)), pp1, a);
#pragma unroll
        for (int ks = 0; ks < 2; ++ks) {
            a = mfma16(*(const LAS bf16x8*)(SFT + (16 * et + i16) * KST + 32 * ks + 8 * g), qf[ks], a);
            a = mfma16(*(const LAS bf16x8*)(SBT + (16 * et + i16) * KST + 32 * ks + 8 * g), qb[ks], a); }
        acc[e4] = a;
    }
    float ss = 0.f;
#pragma unroll
    for (int e4 = 0; e4 < 4; ++e4) ss += (acc[e4][0] * acc[e4][0] + acc[e4][1] * acc[e4][1]) + (acc[e4][2] * acc[e4][2] + acc[e4][3] * acc[e4][3]);
    ss += __shfl_xor(ss, 16); ss += __shfl_xor(ss, 32);
    if (g == 0) SSX[eh * 64 + 16 * itile + i16] = ss;
    __syncthreads();
    const float rstd = 1.0f / sqrtf((SSX[16 * itile + i16] + SSX[64 + 16 * itile + i16]) * (1.0f / 128.0f) + EPS);
    const int m = m0 + 16 * itile + i16;
    u32x2 ov[4];
#pragma unroll
    for (int e4 = 0; e4 < 4; ++e4) {
        const int e0 = 16 * (eh * 4 + e4) + 4 * g;
        const f32x4 gn = gnp[e4];
        const u32x2 gg = ggp[e4];
        const float g0 = bf_lo(gg.x), g1 = bf_hi(gg.x), g2 = bf_lo(gg.y), g3 = bf_hi(gg.y);
        u32x2 o; o.x = cvtpk(acc[e4][0] * rstd * gn[0] * (g0 * sigmoidf_(g0)), acc[e4][1] * rstd * gn[1] * (g1 * sigmoidf_(g1)));
        o.y = cvtpk(acc[e4][2] * rstd * gn[2] * (g2 * sigmoidf_(g2)), acc[e4][3] * rstd * gn[3] * (g3 * sigmoidf_(g3)));
#if PAN_FLAGS
        ov[e4] = o;
#else
        *(u32x2*)(F.XN + (size_t)m * D + h * 128 + e0) = o;
#endif
    }
#if PAN_FLAGS
    {   const bool odd = g & 1; u32x4 oa, ob; pair16(ov, odd, oa, ob);
        const size_t ro = (size_t)m * D + h * 128 + 16 * (eh * 4) + 4 * (g & 2);
        st16(F.XN, ro + (odd ? 16 : 0), oa); st16(F.XN, ro + (odd ? 48 : 32), ob); }
#endif
    __syncthreads();
}


__device__ __forceinline__ int na_rs(int r) { return min(max(r - 4, 0), 56); }
struct NaState { int Lhi; bf16x8 qn0, qn1; };
template <int PART>
__device__ __forceinline__ void natten2_part(const Ctx& F, int l, int task, NaState& St) {
    const int b = task >> 6, hh = (task >> 3) & 7, seg = task & 7;
    LAS unsigned char* KR = F.lds; LAS unsigned char* VR = F.lds + 73728; LAS float* RPB = (LAS float*)(F.lds + 147456);
    const bf16* KNb = F.KN + (size_t)b * T * 512 + hh * 64; const bf16* VNb = F.VN + (size_t)b * T * 512 + hh * 64;
    if (PART != 2) {
#pragma unroll
        for (int q = 0; q < 2; ++q) { const int idx = F.tid + 512 * q; if (idx < 945) { const int row = idx / 63, col = idx % 63 - 16;
            RPB[idx] = (col >= 0 && col < 31) ? F.rpb[(size_t)(l * 8 + hh) * 465 + row * 31 + col] * 1.44269504089f : 0.f; } } }
    const int lkey = F.tid >> 3, lch = F.tid & 7;
    const int kdst = lkey * 128 + ((lch ^ (lkey & 7)) << 4), vdst = lkey * 128 + ((lch ^ (((lkey >> 1) & 3) << 1)) << 4);
    int Lhi = (PART == 2) ? St.Lhi : na_rs(seg * 8);
    if (PART != 2) {
        const int lo = Lhi, hi = na_rs(seg * 8 + 1) + 8;
        u32x4 tk[9], tv[9];
#pragma unroll
        for (int q = 0; q < 9; ++q) { const int gr = lo + q; if (gr < hi) {
            tk[q] = *(const u32x4*)(KNb + (size_t)(gr * 64 + lkey) * 512 + lch * 8); tv[q] = *(const u32x4*)(VNb + (size_t)(gr * 64 + lkey) * 512 + lch * 8); } }
#pragma unroll
        for (int q = 0; q < 9; ++q) { const int gr = lo + q; if (gr < hi) { const int slot = gr % 9;
            *(LAS u32x4*)(KR + slot * 8192 + kdst) = tk[q]; *(LAS u32x4*)(VR + slot * 8192 + vdst) = tv[q]; } }
        Lhi = hi;
    }
    if (PART != 2) __syncthreads();
    const int n = F.wave & 3, rp = F.wave >> 2, i16 = F.lane & 15, g = F.lane >> 4;
    const int bs = min(max(16 * n - 8, 0), 32);
    const int cq = 16 * n + i16, cs = min(max(cq - 8, 0), 48);
    bf16x8 qn0, qn1;
    if (PART != 2) { const size_t mq = (size_t)(b * T + (seg * 8 + rp) * 64 + cq) * 512 + hh * 64 + 8 * g; qn0 = *(const bf16x8*)(F.QN + mq); qn1 = *(const bf16x8*)(F.QN + mq + 32); }
    else { qn0 = St.qn0; qn1 = St.qn1; }
    for (int step = (PART == 2 ? 2 : 0); step < (PART == 1 ? 2 : 4); ++step) {
        const int r0 = seg * 8 + step * 2, r = r0 + rp, rs = na_rs(r);
        u32x4 pk0, pk1, pv0, pv1; int nr0 = -1, nr1 = -1;
        if (step < 3) { const int hin = na_rs(r0 + 3) + 8; if (Lhi < hin) nr0 = Lhi; if (Lhi + 1 < hin) nr1 = Lhi + 1; }
        if (nr0 >= 0) { pk0 = *(const u32x4*)(KNb + (size_t)(nr0 * 64 + lkey) * 512 + lch * 8); pv0 = *(const u32x4*)(VNb + (size_t)(nr0 * 64 + lkey) * 512 + lch * 8); }
        if (nr1 >= 0) { pk1 = *(const u32x4*)(KNb + (size_t)(nr1 * 64 + lkey) * 512 + lch * 8); pv1 = *(const u32x4*)(VNb + (size_t)(nr1 * 64 + lkey) * 512 + lch * 8); }
        const int m = b * T + r * 64 + cq;
        bf16x8 qf[2]; qf[0] = qn0; qf[1] = qn1;
        if (step < 3) { const size_t mn = (size_t)(m + 128) * 512 + hh * 64 + 8 * g; qn0 = *(const bf16x8*)(F.QN + mn); qn1 = *(const bf16x8*)(F.QN + mn + 32); }
        f32x4 S[16];
#pragma unroll
        for (int t = 0; t < 16; ++t) {
            const int slot = (rs + (t >> 1)) % 9, kc = bs + (t & 1) * 16 + i16;
            const LAS unsigned char* kp = KR + slot * 8192 + kc * 128;
            f32x4 a = (f32x4){0.f, 0.f, 0.f, 0.f};
#pragma unroll
            for (int ks = 0; ks < 2; ++ks) a = mfma16(*(const LAS bf16x8*)(kp + (((4 * ks + g) ^ (kc & 7)) << 4)), qf[ks], a);
            S[t] = a;
        }
        float mx = -3.0e38f;
        {
            f32x4 bv[16];
            const LAS float* rb = RPB + (rs - r + 7) * 63 + (bs + 4 * g - cq + 15 + 16);
#pragma unroll
            for (int t = 0; t < 16; ++t)
#pragma unroll
                for (int rr = 0; rr < 4; ++rr) bv[t][rr] = rb[(t >> 1) * 63 + (t & 1) * 16 + rr];
            __builtin_amdgcn_sched_barrier(0);
#pragma unroll
            for (int t = 0; t < 16; ++t)
#pragma unroll
                for (int rr = 0; rr < 4; ++rr) {
                    const int kcol = bs + (t & 1) * 16 + 4 * g + rr; const bool ok = (unsigned)(kcol - cs) < 16u;
                    const float v = ok ? S[t][rr] + bv[t][rr] : -1.0e30f;
                    S[t][rr] = v; mx = fmaxf(mx, v); }
        }
        mx = fmaxf(mx, __shfl_xor(mx, 16)); mx = fmaxf(mx, __shfl_xor(mx, 32));
        float sum = 0.f;
#pragma unroll
        for (int t = 0; t < 16; ++t)
#pragma unroll
            for (int rr = 0; rr < 4; ++rr) { const float p = __builtin_amdgcn_exp2f(S[t][rr] - mx); S[t][rr] = p; sum += p; }
        sum += __shfl_xor(sum, 16); sum += __shfl_xor(sum, 32);
        const float inv = 1.0f / sum;
        f32x4 o[4];
#pragma unroll
        for (int dt = 0; dt < 4; ++dt) o[dt] = (f32x4){0.f, 0.f, 0.f, 0.f};
#pragma unroll
        for (int pp = 0; pp < 8; ++pp) {
            const bf16x8 pf = pack8(S[2 * pp], S[2 * pp + 1]);
            const int slot = (rs + pp) % 9; const int key0 = bs + 4 * g + (i16 >> 2), key1 = key0 + 16;
            const LAS unsigned char* v0 = VR + slot * 8192 + key0 * 128; const LAS unsigned char* v1 = VR + slot * 8192 + key1 * 128;
            const int sw0 = ((key0 >> 1) & 3) << 1, sw1 = ((key1 >> 1) & 3) << 1, half = (i16 & 1) * 8, cpair = (i16 & 3) >> 1;
#pragma unroll
            for (int dt = 0; dt < 4; ++dt) {
                const int ch = 2 * dt + cpair;
                const bf16x8 vf = cat8(tr16(v0 + ((ch ^ sw0) << 4) + half), tr16(v1 + ((ch ^ sw1) << 4) + half));
                o[dt] = mfma16(vf, pf, o[dt]); }
        }
#if PAN_FLAGS
        {   u32x2 ov[4];
#pragma unroll
            for (int dt = 0; dt < 4; ++dt) { ov[dt].x = cvtpk(o[dt][0] * inv, o[dt][1] * inv); ov[dt].y = cvtpk(o[dt][2] * inv, o[dt][3] * inv); }
            const bool odd = g & 1; u32x4 oa, ob; pair16(ov, odd, oa, ob);
            const size_t ro = (size_t)m * D + 512 + hh * 64 + 4 * (g & 2);
            st16(F.XN, ro + (odd ? 16 : 0), oa); st16(F.XN, ro + (odd ? 48 : 32), ob); }
#else
#pragma unroll
        for (int dt = 0; dt < 4; ++dt) { u32x2 ov; ov.x = cvtpk(o[dt][0] * inv, o[dt][1] * inv); ov.y = cvtpk(o[dt][2] * inv, o[dt][3] * inv);
            *(u32x2*)(F.XN + (size_t)m * D + 512 + hh * 64 + 16 * dt + 4 * g) = ov; }
#endif
        __syncthreads();
        if (nr0 >= 0) { const int slot = nr0 % 9; *(LAS u32x4*)(KR + slot * 8192 + kdst) = pk0; *(LAS u32x4*)(VR + slot * 8192 + vdst) = pv0; Lhi = nr0 + 1; }
        if (nr1 >= 0) { const int slot = nr1 % 9; *(LAS u32x4*)(KR + slot * 8192 + kdst) = pk1; *(LAS u32x4*)(VR + slot * 8192 + vdst) = pv1; Lhi = nr1 + 1; }
        __syncthreads();
    }
    if (PART == 1) { St.Lhi = Lhi; St.qn0 = qn0; St.qn1 = qn1; }
}
__device__ __forceinline__ void natten2_task(const Ctx& F, int l, int task) { NaState St; natten2_part<0>(F, l, task, St); }

__global__ void __launch_bounds__(512, 2) fwd_kernel(Args args) {
    extern __shared__ __attribute__((aligned(16))) unsigned char lds_raw[];
    Base B;
    B.lds = (LAS unsigned char*)lds_raw;
    B.tid = threadIdx.x; B.lane = B.tid & 63; B.wave = __builtin_amdgcn_readfirstlane(B.tid >> 6);
    B.G = gridDim.x; { const int bx = blockIdx.x; B.vcu = (B.G % 8 == 0) ? (bx % 8) * (B.G / 8) + bx / 8 : bx; }
    for (int u = B.tid; u < (LDS_BYTES - LDSCTL_OFF) / 4; u += 512) ((LAS unsigned*)(B.lds + LDSCTL_OFF))[u] = 0u;
    __syncthreads();
    volatile LAS unsigned* MISC = (volatile LAS unsigned*)(B.lds + MISC_OFF);
    unsigned* const barw = (unsigned*)(args.ws + WS_CTL) + CW_BAR;
    XcdBarrier bar; bar.bar = barw; bar.x = 0; bar.st = nullptr;
    const bool multi = (args.ph_hi - args.ph_lo) > 1;
    if (multi) bar = xcd_barrier_post(barw, MISC + 8);

#ifndef PHM
#define PHM 0xfff
#endif
#define PH_EN(bit) ((PHM >> (bit)) & 1)
#ifndef TPROBE
#define TPROBE 0
#endif
#ifndef TPA
#define TPA 0
#endif
#ifndef TPB
#define TPB 1
#endif
#if TPROBE
    volatile LAS unsigned long long* TBL = (volatile LAS unsigned long long*)(B.lds + LDSCTL_OFF + 2048);
    if (B.tid == 0) TBL[0] = __builtin_amdgcn_s_memrealtime();
#endif
#ifndef REPM
#define REPM 0
#endif
#ifndef REPN
#define REPN 3
#endif
#define NREP(bit, l) ((((REPM >> (bit)) & 1) && (l) == 0) ? REPN : 1)
    for (int ph = args.ph_lo; ph < args.ph_hi; ++ph) {
        if (ph == 0) { if (PH_EN(0)) { for (int rep = 0; rep < NREP(0, 0); ++rep) { const Ctx F = make_ctx(B); phase_p0(F);
#if P0_FLAGS
            asm volatile("s_waitcnt vmcnt(0)" ::: "memory"); __syncthreads();
            if (F.tid == 0) (void)xb_add((unsigned*)(F.ctl + CW_P0A), 1u);
#endif
            phase_p0b(F); __syncthreads(); } } }
        else if (ph == NPHASES - 1) { if (PH_EN(1)) for (int rep = 0; rep < NREP(1, 0); ++rep) { const Ctx F = make_ctx(B);
#if TPROBE
            __syncthreads();
            const float ia = (float)(TBL[TPA + 1] - TBL[TPA]) * 0.01f, ib = (float)(TBL[TPB + 1] - TBL[TPB]) * 0.01f;
            prepass2<2>(F, 0, sqrtf(ia * 1.0e-6f), 3.0f + ib * 0.03f);
#else
            prepass2<2>(F, 0);
#endif
            __syncthreads(); } }
        else {
            const int l = (ph - 1) / PPL, sp = (ph - 1) % PPL;
            if (sp == 0) { if (PH_EN(2)) { for (int rep = 0; rep < NREP(2, l); ++rep) { const Ctx F = make_ctx(B);
#if P0_FLAGS
                if (l == 0 && multi) panels_wait((unsigned*)(F.ctl + CW_P0A), F.tid == 0, (unsigned)F.G, barw, F.tid);
#endif
                prepass2<0>(F, l); __syncthreads();
#if PPA_FLAGS
                if (F.tid == 0) (void)xb_add((unsigned*)(F.ctl + CW_PPA + l * 32), 1u);
#endif
            } } }
            else if (sp == 1) { if (PH_EN(3)) for (int rep = 0; rep < NREP(3, l); ++rep) { const Ctx F = make_ctx(B);
                pg8::DenseSched S; S.init(F.XN, F.win_t + (size_t)l * NPROJ * D, NTOK, NPROJ, D, F.G, F.bx);
#if PPA_FLAGS
                S.rdy = (unsigned*)(F.ctl + CW_PAN + (l * 4 + 3) * 64 * 32); S.need = 128u;
                if (l > 0) { S.rdy2 = (unsigned*)(F.ctl + CW_PPA + l * 32); S.need2 = (unsigned)F.G; S.pn2 = 4; }
#if P0_FLAGS
                else if (multi) { S.rdy2 = (unsigned*)(F.ctl + CW_P0A); S.need2 = (unsigned)F.G; S.pn2 = 0; }
#endif
#endif
                EpiInProj E{F.QG, F.KG, F.VG, F.GG, F.QN, F.KN, F.VN, F.q_norm + l * 64, F.k_norm + l * 64};
                pg8::gemm_phase<EpiInProj, pg8::DenseSched>(F.lds, D, S, E, F.tid);
#if PAN_FLAGS
                panels_arrive(S, (unsigned*)(F.ctl + CW_PAN + (l * 4 + 0) * 64 * 32), F.lane);
#endif
            }
#if GLA_TEAM
            } else if (sp == 2) { const Ctx F = make_ctx(B);
                const bool team = (F.G == 256);
                unsigned* const tw = (unsigned*)(F.ctl + CW_TEAM + (l * 16 + (F.vcu >> 4)) * 64);
                { int curh = -1;
                  if (PH_EN(4)) for (int gidx = F.vcu; gidx < 256; gidx += F.G) { const int hq = (gidx >> 4) & 3; if (hq != curh) { gla_gate_col(F, l, hq); curh = hq; }
#if PAN_FLAGS
                    panels_wait((unsigned*)(F.ctl + CW_PAN + ((l * 4 + 0) * 64 + (gidx >> 6) * 16 + (gidx & 15)) * 32), F.tid == 0, 96u, barw, F.tid);
#endif
                    gla_a3_group(F, l, gidx); } }
                if (team) team_arrive(tw, F.tid);
                NaState St; St.Lhi = 0; St.qn0 = (bf16x8){0, 0, 0, 0, 0, 0, 0, 0}; St.qn1 = St.qn0;
                if (PH_EN(5)) for (int tk = F.vcu; tk < 256; tk += F.G) {
#if PAN_FLAGS
                    { const int b = tk >> 6, seg = tk & 7, p0 = na_rs(seg * 8) >> 2, p1 = (na_rs(seg * 8 + 7) + 7) >> 2;
                      panels_wait((unsigned*)(F.ctl + CW_PAN + ((l * 4 + 0) * 64 + b * 16 + min(p0 + F.tid, 15)) * 32), p0 + F.tid <= p1, 96u, barw, F.tid); }
#endif
                    if (team) natten2_part<1>(F, l, tk, St);
                    else { natten2_part<0>(F, l, tk, St);
#if PAN_FLAGS
                        asm volatile("s_waitcnt vmcnt(0)" ::: "memory");
                        if (F.lane == 0) { unsigned* pw = (unsigned*)(F.ctl + CW_PAN + ((l * 4 + 2) * 64 + (tk >> 6) * 16 + (tk & 7) * 2) * 32); (void)xb_add(pw, 1u); (void)xb_add(pw + 32, 1u); }
#endif
                    }
                }
                if (team) team_wait(tw, 16u, barw, F.tid); else xcd_barrier(bar);
                if (PH_EN(6)) gla_b3(F);
                if (team) { team_arrive(tw, F.tid);
                    if (PH_EN(5)) { const int tk = F.vcu; natten2_part<2>(F, l, tk, St);
#if PAN_FLAGS
                        asm volatile("s_waitcnt vmcnt(0)" ::: "memory");
                        if (F.lane == 0) { unsigned* pw = (unsigned*)(F.ctl + CW_PAN + ((l * 4 + 2) * 64 + (tk >> 6) * 16 + (tk & 7) * 2) * 32); (void)xb_add(pw, 1u); (void)xb_add(pw + 32, 1u); }
#endif
                    }
                    team_wait(tw, 32u, barw, F.tid); } else xcd_barrier(bar);
                if (PH_EN(7)) for (int gidx = F.vcu; gidx < 256; gidx += F.G) { const int p = gidx >> 4, j = gidx & 15; const bf16* S0B = F.SP + (size_t)4 * 1024 * 1024;
                    S0R Z; { const int e = F.tid >> 3, ch = F.tid & 7; const bf16* zf = S0B + (size_t)((p * 2 + 0) * 16 + j) * 8192 + ch * 8; const bf16* zb = S0B + (size_t)((p * 2 + 1) * 16 + j) * 8192 + ch * 8;
                        Z.a = *(const u32x4*)(zf + e * 64); Z.b = *(const u32x4*)(zf + (e + 64) * 64); Z.c = *(const u32x4*)(zb + e * 64); Z.d = *(const u32x4*)(zb + (e + 64) * 64); }
                    const int itb = p * 64 + 4 * j; GlaPre P; gla_c3_load(F, itb, P);
                    for (int k = 0; k < 4; ++k) gla_c3_item(F, l, itb + k, P, itb + min(k + 1, 3), Z);
#if PAN_FLAGS
                    asm volatile("s_waitcnt vmcnt(0)" ::: "memory");
                    if (F.lane == 0) (void)xb_add((unsigned*)(F.ctl + CW_PAN + ((l * 4 + 2) * 64 + (p >> 2) * 16 + j) * 32), 1u);
#endif
                }
            }
#else
            } else if (sp == 2) { const Ctx F = make_ctx(B);
#if GLA_V2 || NATTEN_V2
                if (PH_EN(12) && (F.vcu & 1)) { conv_moe_items(F, l, 0, 8192); __syncthreads(); }
                if (PH_EN(5)) for (int rep = 0; rep < NREP(5, l); ++rep) for (int tk = F.vcu; tk < 256; tk += F.G) {
#if NATTEN_V2
                    natten2_task(F, l, tk);
#else
                    for (int q = 0; q < 8; ++q) natten_item(F, l, ((tk >> 3) << 6) + (tk & 7) * 8 + q);
#endif
                }
                int curh = -1;
#if GLA_V3
                if (PH_EN(4)) for (int gidx = F.vcu; gidx < 256; gidx += F.G) { const int hq = (gidx >> 4) & 3; if (hq != curh) { gla_gate_col(F, l, hq); curh = hq; }
                    gla_a3_group(F, l, gidx); }
#else
                if (PH_EN(4)) for (int rep = 0; rep < NREP(4, l); ++rep) { GlaPre P; gla_a2_load(F, min(F.vcu, 1023), P);
                  for (int it = F.vcu; it < 1024; it += F.G) {
#if GLA_V2
                    { const int hq = (it >> 6) & 3; if (hq != curh) { gla_gate_col(F, l, hq); curh = hq; } }
                    gla_a2_item(F, l, it, P, it + F.G);
#else
                    gla_a_item(F, l, it);
#endif
                } }
#endif
                if (PH_EN(12) && !(F.vcu & 1)) { conv_moe_items(F, l, 0, 8192); __syncthreads(); }
#else
                for (int it = F.vcu; it < 3072; it += F.G) { if (it < 1024) { if (PH_EN(4)) for (int rep = 0; rep < NREP(4, l); ++rep) gla_a_item(F, l, it); } else { if (PH_EN(5)) for (int rep = 0; rep < NREP(5, l); ++rep) natten_item(F, l, it - 1024); } }
#endif
            } else if (sp == 3) { if (PH_EN(6)) for (int rep = 0; rep < NREP(6, l); ++rep) { const Ctx F = make_ctx(B);
                if (PH_EN(12) && (F.vcu & 1)) { conv_moe_items(F, l, 8192, 16384); __syncthreads(); }
#if GLA_V3
                gla_b3(F);
#elif GLA_V2
                gla_b2(F);
#else
                gla_b(F);
#endif
                if (PH_EN(12) && !(F.vcu & 1)) { conv_moe_items(F, l, 8192, 16384); __syncthreads(); }
            } }
            else if (sp == 4) { if (PH_EN(7)) for (int rep = 0; rep < NREP(7, l); ++rep) { const Ctx F = make_ctx(B);
                if (PH_EN(12) && (F.vcu & 1)) { conv_moe_items(F, l, 16384, 24576); __syncthreads(); }
#if GLA_V3
                for (int gidx = F.vcu; gidx < 256; gidx += F.G) { const int p = gidx >> 4, j = gidx & 15; const bf16* S0B = F.SP + (size_t)4 * 1024 * 1024;
                    S0R Z; { const int e = F.tid >> 3, ch = F.tid & 7; const bf16* zf = S0B + (size_t)((p * 2 + 0) * 16 + j) * 8192 + ch * 8; const bf16* zb = S0B + (size_t)((p * 2 + 1) * 16 + j) * 8192 + ch * 8;
                        Z.a = *(const u32x4*)(zf + e * 64); Z.b = *(const u32x4*)(zf + (e + 64) * 64); Z.c = *(const u32x4*)(zb + e * 64); Z.d = *(const u32x4*)(zb + (e + 64) * 64); }
                    const int itb = p * 64 + 4 * j; GlaPre P; gla_c3_load(F, itb, P);
                    for (int k = 0; k < 4; ++k) gla_c3_item(F, l, itb + k, P, itb + min(k + 1, 3), Z); }
#else
                int curh = -1; GlaPre P; gla_c2_load(F, min(F.vcu, 1023), P);
                for (int it = F.vcu; it < 1024; it += F.G) {
#if GLA_V2
                gla_c2_item(F, l, it, P, it + F.G);
#else
                gla_c_item(F, l, it);
#endif
                }
#endif
                if (PH_EN(12) && !(F.vcu & 1)) { conv_moe_items(F, l, 16384, 24576); __syncthreads(); } } }
#endif
            else if (sp == SP_OUT) { if (PH_EN(8)) for (int rep = 0; rep < NREP(8, l); ++rep) { const Ctx F = make_ctx(B);
                pg8::DenseSched S; S.init(F.XN, F.wout_t + (size_t)l * D * D, NTOK, D, D, F.G, F.bx);
#if PAN_FLAGS
                S.rdy = (unsigned*)(F.ctl + CW_PAN + (l * 4 + 2) * 64 * 32); S.need = 96u;
#endif
                EpiResid E{l == 0 ? F.x_in : nullptr, F.Xb, F.mod + (size_t)(l * 4) * MODW + 2 * D};
                pg8::gemm_phase<EpiResid, pg8::DenseSched>(F.lds, D, S, E, F.tid);
#if PAN_FLAGS
                panels_arrive(S, (unsigned*)(F.ctl + CW_PAN + (l * 4 + 1) * 64 * 32), F.lane);
#endif
            } } else if (sp == SP_OUT + 1) { if (PH_EN(9)) for (int rep = 0; rep < NREP(9, l); ++rep) { const Ctx F = make_ctx(B);
#if PAN_FLAGS
                { const int per = (NTOK / 16 + F.G - 1) / F.G, grp = F.vcu * per + F.tid; const bool act = F.tid < per && F.tid < 64 && grp < NTOK / 16;
                  panels_wait((unsigned*)(F.ctl + CW_PAN + ((l * 4 + 1) * 64 + (act ? grp >> 4 : 0)) * 32), act, 32u, barw, F.tid); }
#endif
                prepass2<1>(F, l); __syncthreads(); } }
#if MOE_FUSED
            else if (sp == SP_OUT + 2) { if (PH_EN(10)) { const Ctx F = make_ctx(B);
                moe_tables(F, l);
                pg8::MoeFusedSched S; S.XNp = (const char*)F.XN; S.Hp = (const char*)F.H; S.W13p = (const char*)(F.w13_t + (size_t)l * NE * 1024 * D); S.W2p = (const char*)(F.w2_t + (size_t)l * NE * D * DE);
                S.lists = F.lists; S.TS = (const LAS int*)(F.lds + TAB_OFF); S.CN = S.TS + 40; S.ready = (unsigned*)(F.ctl + CW_RDY + l * 192 * 64); S.tmo = (unsigned*)(F.ctl + 2); S.G = F.G; S.c = F.vcu;
                EpiMoe E{F.H, F.Y};
                pg8::gemm_phase_v<EpiMoe, pg8::MoeFusedSched>(F.lds, S, E, F.tid);
            } }
#else
            else if (sp == SP_OUT + 2) { if (PH_EN(10)) for (int rep = 0; rep < NREP(10, l); ++rep) { const Ctx F = make_ctx(B);
                moe_tables(F, l);
                pg8::MoeSched<true> S; S.A = (const char*)F.XN; S.Bt = (const char*)(F.w13_t + (size_t)l * NE * 1024 * D); S.K = D; S.lists = F.lists;
                S.TS = (const LAS int*)(F.lds + TAB_OFF); S.CN = S.TS + 40; S.G = F.G; S.c = F.vcu;
                EpiSwiGLU E{F.H};
                pg8::gemm_phase<EpiSwiGLU, pg8::MoeSched<true>>(F.lds, D, S, E, F.tid);
            } } else { if (PH_EN(11)) for (int rep = 0; rep < NREP(11, l); ++rep) { const Ctx F = make_ctx(B);
                moe_tables(F, l);
                pg8::MoeSched<false> S; S.A = (const char*)F.H; S.Bt = (const char*)(F.w2_t + (size_t)l * NE * D * DE); S.K = DE; S.lists = F.lists;
                S.TS = (const LAS int*)(F.lds + TAB_OFF); S.CN = S.TS + 40; S.G = F.G; S.c = F.vcu;
                EpiY E{F.Y};
                pg8::gemm_phase<EpiY, pg8::MoeSched<false>>(F.lds, DE, S, E, F.tid);
            } }
#endif
        }
        bool gbar = ph + 1 < args.ph_hi;
#if P0_FLAGS
        if (ph == 0 && multi) gbar = false;
#endif
#if PAN_FLAGS
        if (ph >= 1 && ph < NPHASES - 1) { const int spx = (ph - 1) % PPL; if ((PPA_FLAGS && spx == 0) || spx == 1 || spx == 2 || spx == SP_OUT) gbar = false; }
#endif
        if (gbar) { xcd_barrier(bar); if ((REPM >> 12) & 1) { xcd_barrier(bar); xcd_barrier(bar); } }
#if TPROBE
        if (B.tid == 0) TBL[ph + 1] = __builtin_amdgcn_s_memrealtime();
#endif
    }
}

extern "C" void kernel_launch(void* const* d_in, const int* in_sizes, int n_in, void* d_out, int out_size, void* d_ws, size_t ws_size, hipStream_t stream) {
    static int grid = 0;
    if (grid == 0) {
        if (n_in != 19 || in_sizes[0] != NTOK * D || out_size != NTOK * D || ws_size < WS_END) {
            fprintf(stderr, "kernel_launch: unexpected shapes (n_in %d, in0 %d, out %d, ws %zu, need %zu); nothing launched\n", n_in, n_in > 0 ? in_sizes[0] : -1, out_size, ws_size, (size_t)WS_END); grid = -1; return; }
        int dev = 0, cus = 0;
        if (hipGetDevice(&dev) != hipSuccess || hipDeviceGetAttribute(&cus, hipDeviceAttributeMultiprocessorCount, dev) != hipSuccess) { fprintf(stderr, "kernel_launch: device query failed\n"); grid = -1; return; }
        if (hipFuncSetAttribute((const void*)fwd_kernel, hipFuncAttributeMaxDynamicSharedMemorySize, LDS_BYTES) != hipSuccess) { fprintf(stderr, "kernel_launch: hipFuncSetAttribute failed\n"); grid = -1; return; }
        (void)hipGetLastError();
        grid = cus;
    }
    if (grid < 0) return;
    if (hipMemsetAsync((char*)d_ws + WS_CTL, 0, CTL_ZERO_BYTES, stream) != hipSuccess) { fprintf(stderr, "kernel_launch: memset failed\n"); return; }
    Args a{};
    for (int i = 0; i < 19; ++i) a.in[i] = (const float*)d_in[i];
    a.out = (float*)d_out; a.ws = (unsigned char*)d_ws;
#if MK_PER_PHASE
    for (int ph = 0; ph < NPHASES; ++ph) { a.ph_lo = ph; a.ph_hi = ph + 1; hipLaunchKernelGGL(fwd_kernel, dim3(grid), dim3(512), LDS_BYTES, stream, a); }
#else
    a.ph_lo = 0; a.ph_hi = NPHASES;
    hipLaunchKernelGGL(fwd_kernel, dim3(grid), dim3(512), LDS_BYTES, stream, a);
#endif
    const hipError_t le = hipPeekAtLastError();
    if (le != hipSuccess) fprintf(stderr, "kernel_launch: launch failed: %s\n", hipGetErrorName(le));
}
```
